# Optimizing an MI355X kernel written in HIP

```python
import math
import jax, jax.numpy as jnp
from jax import lax
import numpy as np

D_MODEL = 2048
BATCH = 2
SEQ = 8192
DEPTH = 1

CTX_LEN = 256
GRID_W = 64
MIX_WIDTH = D_MODEL
MLSTM_HEAD_DIM = 128
MLSTM_HEADS = (MIX_WIDTH // 2) // MLSTM_HEAD_DIM
MLSTM_WIDTH = MLSTM_HEADS * MLSTM_HEAD_DIM
MLSTM_CHUNK = 128
DIFF_V_DIM = 128
DIFF_QK_DIM = DIFF_V_DIM // 2
DIFF_HEADS = (MIX_WIDTH - MLSTM_WIDTH) // DIFF_V_DIM
DIFF_WIDTH = DIFF_HEADS * DIFF_V_DIM
ROPE_FREQS = DIFF_QK_DIM // 4
ROPE_BASE = 10000.0
Q_BLOCK = 128
D_FF = 5632
CONV_W = 3
N_MOD = 6
EPS = 1e-6

OFF_MQ = 0
OFF_MK = MLSTM_WIDTH
OFF_MV = 2 * MLSTM_WIDTH
OFF_MO = 3 * MLSTM_WIDTH
OFF_MG = 4 * MLSTM_WIDTH
OFF_DQ = OFF_MG + 4 * MLSTM_HEADS
OFF_DK = OFF_DQ + DIFF_HEADS * 2 * DIFF_QK_DIM
OFF_DV = OFF_DK + DIFF_HEADS * 2 * DIFF_QK_DIM
IN_COLS = OFF_DV + DIFF_WIDTH

kernel_name = "hybrid_mlstm_diffattn_convffn_dit_block"


def rmsnorm(a, g):
    a32 = a.astype(jnp.float32)
    y = a32 * lax.rsqrt(jnp.mean(a32 * a32, axis=-1, keepdims=True) + EPS)
    return (y * g.astype(jnp.float32)).astype(a.dtype)


def modulate(h, shift, scale):
    return h * (1 + scale) + shift


def dwconv3(a, w, b):
    ap = jnp.pad(a, ((0, 0), (1, 1), (0, 0)))
    return ap[:, :-2] * w[0] + ap[:, 1:-1] * w[1] + ap[:, 2:] * w[2] + b


def axial_rope_tables(rows, n_lat):
    row = jnp.broadcast_to(jnp.arange(rows, dtype=jnp.float32)[:, None], (rows, GRID_W)).reshape(-1)
    col = jnp.broadcast_to(jnp.arange(GRID_W, dtype=jnp.float32)[None, :], (rows, GRID_W)).reshape(-1)
    inv_freq = ROPE_BASE ** (-jnp.arange(ROPE_FREQS, dtype=jnp.float32) / ROPE_FREQS)
    ang = jnp.stack([row[:, None] * inv_freq, col[:, None] * inv_freq], axis=1)
    ang = jnp.stack([ang, ang], axis=2).reshape(n_lat, 4 * ROPE_FREQS)
    return jnp.cos(ang), jnp.sin(ang)


def rope_2d(x, cos, sin):
    xr = x.reshape(*x.shape[:-1], 2, 2, ROPE_FREQS)
    rot = jnp.stack([-xr[..., 1, :], xr[..., 0, :]], axis=-2).reshape(x.shape)
    return x * cos[:, None, None, :] + rot * sin[:, None, None, :]


def to_mlstm_heads(a):
    B, T, _ = a.shape
    return a.reshape(B, T, MLSTM_HEADS, MLSTM_HEAD_DIM).transpose(0, 2, 1, 3).astype(jnp.float32)


def mlstm_project(p, conv_w, conv_b, b_gate):
    B, T, _ = p.shape
    qk = jax.nn.silu(dwconv3(p[..., OFF_MQ:OFF_MV], conv_w, conv_b))
    q = to_mlstm_heads(qk[..., :MLSTM_WIDTH])
    k = to_mlstm_heads(qk[..., MLSTM_WIDTH:]) * (MLSTM_HEAD_DIM ** -0.5)
    v = to_mlstm_heads(p[..., OFF_MV:OFF_MO])
    g = (p[..., OFF_MG:OFF_DQ].reshape(B, T, 4, MLSTM_HEADS) + b_gate).astype(jnp.float32)
    g = jnp.transpose(g, (2, 0, 3, 1))
    return q, k, v, g[0], jax.nn.log_sigmoid(g[1]), g[2], jax.nn.log_sigmoid(g[3])


def mlstm_chunkwise(q, k, v, i_pre, log_f, state):
    B, H, T, Dh = q.shape
    nc = T // MLSTM_CHUNK

    def to_chunks(a):
        return jnp.moveaxis(a.reshape(B, H, nc, MLSTM_CHUNK, *a.shape[3:]), 2, 0)

    xs = (to_chunks(q), to_chunks(k), to_chunks(v), to_chunks(i_pre), to_chunks(log_f))
    causal = jnp.tril(jnp.ones((MLSTM_CHUNK, MLSTM_CHUNK), dtype=bool))

    def step(carry, inp):
        C, n, m = carry
        qc, kc, vc, ic, fc = inp
        b = jnp.cumsum(fc, axis=-1)
        d_log = jnp.where(causal, b[..., :, None] - b[..., None, :] + ic[..., None, :], -jnp.inf)
        m_inter = b + m[..., None]
        m_t = jnp.maximum(m_inter, jnp.max(d_log, axis=-1))
        w_intra = jnp.exp(d_log - m_t[..., None])
        w_inter = jnp.exp(m_inter - m_t)
        s = jnp.einsum('bhld,bhsd->bhls', qc, kc) * w_intra
        num = w_inter[..., None] * jnp.einsum('bhld,bhde->bhle', qc, C) + jnp.einsum('bhls,bhse->bhle', s, vc)
        den = w_inter * jnp.einsum('bhld,bhd->bhl', qc, n) + jnp.sum(s, axis=-1)
        h = num / jnp.maximum(jnp.abs(den), jnp.exp(-m_t))[..., None]
        b_last = b[..., -1]
        log_w = b_last[..., None] - b + ic
        m_new = jnp.maximum(b_last + m, jnp.max(log_w, axis=-1))
        w_s = jnp.exp(log_w - m_new[..., None])
        decay = jnp.exp(b_last + m - m_new)
        C_new = decay[..., None, None] * C + jnp.einsum('bhs,bhsd,bhse->bhde', w_s, kc, vc)
        n_new = decay[..., None] * n + jnp.einsum('bhs,bhsd->bhd', w_s, kc)
        return (C_new, n_new, m_new), h

    state, hs = lax.scan(step, state, xs)
    return jnp.moveaxis(hs, 0, 2).reshape(B, H, T, Dh), state


def mlstm_output(h, p, g_norm):
    B, H, T, Dh = h.shape
    h = rmsnorm(h.transpose(0, 2, 1, 3), g_norm.reshape(H, Dh)).reshape(B, T, H * Dh)
    return h * jax.nn.sigmoid(p[..., OFF_MO:OFF_MG].astype(jnp.float32))


def mlstm_group(p_lat, p_ctx, conv_w, conv_b, b_gate, g_norm, need_ctx):
    ql, kl, vl, ifl, lfl, ibl, lbl = mlstm_project(p_lat, conv_w, conv_b, b_gate)
    qc, kc, vc, ifc, lfc, ibc, lbc = mlstm_project(p_ctx, conv_w, conv_b, b_gate)
    B = p_lat.shape[0]
    zero = (jnp.zeros((B, MLSTM_HEADS, MLSTM_HEAD_DIM, MLSTM_HEAD_DIM), jnp.float32),
            jnp.zeros((B, MLSTM_HEADS, MLSTM_HEAD_DIM), jnp.float32),
            jnp.zeros((B, MLSTM_HEADS), jnp.float32))

    def rev(*arrs):
        return tuple(jnp.flip(a, axis=2) for a in arrs)

    hc_f, st_f = mlstm_chunkwise(qc, kc, vc, ifc, lfc, zero)
    hl_f, _ = mlstm_chunkwise(ql, kl, vl, ifl, lfl, st_f)
    hc_b, st_b = mlstm_chunkwise(*rev(qc, kc, vc, ibc, lbc), zero)
    hl_b, _ = mlstm_chunkwise(*rev(ql, kl, vl, ibl, lbl), st_b)
    out_lat = mlstm_output(hl_f + jnp.flip(hl_b, axis=2), p_lat, g_norm)
    out_ctx = mlstm_output(hc_f + jnp.flip(hc_b, axis=2), p_ctx, g_norm) if need_ctx else None
    return out_lat, out_ctx


def diff_split(p):
    B, T, _ = p.shape
    q = p[..., OFF_DQ:OFF_DK].reshape(B, T, DIFF_HEADS, 2, DIFF_QK_DIM)
    k = p[..., OFF_DK:OFF_DV].reshape(B, T, DIFF_HEADS, 2, DIFF_QK_DIM)
    v = p[..., OFF_DV:IN_COLS].reshape(B, T, DIFF_HEADS, DIFF_V_DIM)
    return q, k, v


def diff_attend(q, k, v, lam):
    B, Tq = q.shape[:2]
    qb = jnp.moveaxis(q.astype(jnp.float32).reshape(B, Tq // Q_BLOCK, Q_BLOCK, *q.shape[2:]), 1, 0)
    k32 = k.astype(jnp.float32)
    v32 = v.astype(jnp.float32)
    scale = DIFF_QK_DIM ** -0.5

    def one_block(qblk):
        s = jnp.einsum('bqhcd,bkhcd->bhcqk', qblk, k32) * scale
        pr = jax.nn.softmax(s, axis=-1)
        pd = pr[:, :, 0] - lam * pr[:, :, 1]
        return jnp.einsum('bhqk,bkhe->bqhe', pd, v32)

    o = lax.map(one_block, qb)
    return jnp.moveaxis(o, 0, 1).reshape(B, Tq, DIFF_HEADS, DIFF_V_DIM)


def diff_output(o, g_norm, lam_init):
    B, T = o.shape[:2]
    return (rmsnorm(o, g_norm) * (1.0 - lam_init)).reshape(B, T, DIFF_WIDTH)


def diff_group(p_lat, p_ctx, cos, sin, lam, lam_init, g_norm, need_ctx):
    ql, kl, vl = diff_split(p_lat)
    qc, kc, vc = diff_split(p_ctx)
    ql = rope_2d(ql, cos, sin)
    kl = rope_2d(kl, cos, sin)
    k_all = jnp.concatenate([kc.astype(jnp.float32), kl.astype(jnp.float32)], axis=1)
    v_all = jnp.concatenate([vc, vl], axis=1)
    out_lat = diff_output(diff_attend(ql, k_all, v_all, lam), g_norm, lam_init)
    out_ctx = diff_output(diff_attend(qc, kc, vc, lam), g_norm, lam_init) if need_ctx else None
    return out_lat, out_ctx


def conv_ffn(h, w_up, conv_w, conv_b, w_down):
    u = dwconv3(h @ w_up, conv_w, conv_b)
    gate, val = jnp.split(u, 2, axis=-1)
    return (jax.nn.silu(gate) * val) @ w_down


def setup_inputs(seed: int = 0) -> dict:
    key = jax.random.key(seed)
    ks = jax.random.split(key, 32)
    f32 = jnp.float32

    def nrm(k, shape, s):
        return jax.random.normal(k, shape, f32) * s

    x = nrm(ks[0], (BATCH, SEQ, D_MODEL), 1.0)
    c = nrm(ks[1], (BATCH, D_MODEL), 1.0)
    ctx = nrm(ks[2], (BATCH, CTX_LEN, D_MODEL), 1.0)
    c_ctx = nrm(ks[3], (D_MODEL,), 1.0)
    w_mod = nrm(ks[4], (DEPTH, D_MODEL, N_MOD * D_MODEL), 0.5 * D_MODEL ** -0.5)
    b_mod = nrm(ks[5], (DEPTH, N_MOD * D_MODEL), 0.02)
    g_pre_mix = 1.0 + nrm(ks[6], (DEPTH, D_MODEL), 0.05)
    g_post_mix = 1.0 + nrm(ks[7], (DEPTH, D_MODEL), 0.05)
    w_in = nrm(ks[8], (DEPTH, D_MODEL, IN_COLS), D_MODEL ** -0.5)
    i_bias = nrm(ks[9], (DEPTH, 2, MLSTM_HEADS), 0.1)
    f_bias = 3.0 + 3.0 * jax.random.uniform(ks[10], (DEPTH, 2, MLSTM_HEADS), f32)
    b_gate = jnp.stack([i_bias[:, 0], f_bias[:, 0], i_bias[:, 1], f_bias[:, 1]], axis=1)
    conv_qk_w = nrm(ks[11], (DEPTH, CONV_W, 2 * MLSTM_WIDTH), CONV_W ** -0.5)
    conv_qk_b = nrm(ks[12], (DEPTH, 2 * MLSTM_WIDTH), 0.02)
    g_mlstm = 1.0 + nrm(ks[13], (DEPTH, MLSTM_WIDTH), 0.05)
    lambda_q1 = nrm(ks[14], (DEPTH, DIFF_QK_DIM), 0.1)
    lambda_k1 = nrm(ks[15], (DEPTH, DIFF_QK_DIM), 0.1)
    lambda_q2 = nrm(ks[16], (DEPTH, DIFF_QK_DIM), 0.1)
    lambda_k2 = nrm(ks[17], (DEPTH, DIFF_QK_DIM), 0.1)
    g_diff = 1.0 + nrm(ks[18], (DEPTH, DIFF_V_DIM), 0.05)
    w_out = nrm(ks[19], (DEPTH, MIX_WIDTH, D_MODEL), MIX_WIDTH ** -0.5)
    g_pre_ffn = 1.0 + nrm(ks[20], (DEPTH, D_MODEL), 0.05)
    g_post_ffn = 1.0 + nrm(ks[21], (DEPTH, D_MODEL), 0.05)
    w_up = nrm(ks[22], (DEPTH, D_MODEL, 2 * D_FF), D_MODEL ** -0.5)
    conv_ffn_w = nrm(ks[23], (DEPTH, CONV_W, 2 * D_FF), CONV_W ** -0.5)
    conv_ffn_b = nrm(ks[24], (DEPTH, 2 * D_FF), 0.02)
    w_down = nrm(ks[25], (DEPTH, D_FF, D_MODEL), D_FF ** -0.5)
    return {"x": x, "c": c, "ctx": ctx, "c_ctx": c_ctx, "w_mod": w_mod, "b_mod": b_mod,
            "g_pre_mix": g_pre_mix, "g_post_mix": g_post_mix, "w_in": w_in, "b_gate": b_gate,
            "conv_qk_w": conv_qk_w, "conv_qk_b": conv_qk_b, "g_mlstm": g_mlstm,
            "lambda_q1": lambda_q1, "lambda_k1": lambda_k1, "lambda_q2": lambda_q2, "lambda_k2": lambda_k2,
            "g_diff": g_diff, "w_out": w_out, "g_pre_ffn": g_pre_ffn, "g_post_ffn": g_post_ffn,
            "w_up": w_up, "conv_ffn_w": conv_ffn_w, "conv_ffn_b": conv_ffn_b, "w_down": w_down}


def reference(x, c, ctx, c_ctx, w_mod, b_mod, g_pre_mix, g_post_mix, w_in, b_gate,
              conv_qk_w, conv_qk_b, g_mlstm, lambda_q1, lambda_k1, lambda_q2, lambda_k2,
              g_diff, w_out, g_pre_ffn, g_post_ffn, w_up, conv_ffn_w, conv_ffn_b, w_down):
    n_lat = x.shape[1]
    ROWS = n_lat // GRID_W
    cos, sin = axial_rope_tables(ROWS, n_lat)
    for l in range(DEPTH):
        need_ctx = l < DEPTH - 1
        mod = jax.nn.silu(c) @ w_mod[l] + b_mod[l]
        sh1, sc1, ga1, sh2, sc2, ga2 = jnp.split(mod[:, None, :], N_MOD, axis=-1)
        cmod = jax.nn.silu(c_ctx) @ w_mod[l] + b_mod[l]
        csh1, csc1, cga1, csh2, csc2, cga2 = jnp.split(cmod, N_MOD, axis=-1)

        p_lat = modulate(rmsnorm(x, g_pre_mix[l]), sh1, sc1) @ w_in[l]
        p_ctx = modulate(rmsnorm(ctx, g_pre_mix[l]), csh1, csc1) @ w_in[l]
        m_lat, m_ctx = mlstm_group(p_lat, p_ctx, conv_qk_w[l], conv_qk_b[l], b_gate[l], g_mlstm[l], need_ctx)
        lam_init = 0.8 - 0.6 * math.exp(-0.3 * l)
        lam = (jnp.exp(jnp.sum(lambda_q1[l].astype(jnp.float32) * lambda_k1[l].astype(jnp.float32)))
               - jnp.exp(jnp.sum(lambda_q2[l].astype(jnp.float32) * lambda_k2[l].astype(jnp.float32)))
               + lam_init)
        d_lat, d_ctx = diff_group(p_lat, p_ctx, cos, sin, lam, lam_init, g_diff[l], need_ctx)
        y_lat = jnp.concatenate([m_lat, d_lat], axis=-1).astype(x.dtype) @ w_out[l]
        x = x + ga1 * rmsnorm(y_lat, g_post_mix[l])

        h_lat = modulate(rmsnorm(x, g_pre_ffn[l]), sh2, sc2)
        x = x + ga2 * rmsnorm(conv_ffn(h_lat, w_up[l], conv_ffn_w[l], conv_ffn_b[l], w_down[l]), g_post_ffn[l])

        if need_ctx:
            y_ctx = jnp.concatenate([m_ctx, d_ctx], axis=-1).astype(ctx.dtype) @ w_out[l]
            ctx = ctx + cga1 * rmsnorm(y_ctx, g_post_mix[l])
            h_ctx = modulate(rmsnorm(ctx, g_pre_ffn[l]), csh2, csc2)
            ctx = ctx + cga2 * rmsnorm(conv_ffn(h_ctx, w_up[l], conv_ffn_w[l], conv_ffn_b[l], w_down[l]), g_post_ffn[l])
    return x
```

```cpp
#include <hip/hip_runtime.h>
#include <hip/hip_bf16.h>
#include <cstdio>
#include <cstdint>
#include <cmath>

namespace pg8 {
#define PG8_LAS __attribute__((address_space(3)))
typedef unsigned short bf16_t;
typedef short bf16x8 __attribute__((ext_vector_type(8)));
typedef float f32x4 __attribute__((ext_vector_type(4)));
typedef unsigned u32x4 __attribute__((ext_vector_type(4)));
constexpr int BM = 256, BK = 64, HALF = 128, HTB = HALF * BK * 2  , STAGE_BYTES = 8 * HTB, NXCD = 8, WGM = 8;

__host__ __device__ __forceinline__ int lds_byte(int r, int c) { const int st = (r >> 4) * 2 + (c >> 5), rr = r & 15, cc = c & 31, ob = rr * 64 + cc * 2; return st * 1024 + (ob ^ (((ob >> 9) & 1) << 5)); }
__host__ __device__ __forceinline__ void stage_rc(int b, int& R, int& C) { const int st = b / 1024, sb = b % 1024, swz = sb ^ (((sb >> 9) & 1) << 5); R = (st >> 1) * 16 + swz / 64; C = (st & 1) * 32 + (swz % 64) / 2; }
__host__ __device__ __forceinline__ int perm32(int rho) { const int n = rho >> 4, i = rho & 15; return 8 * (i >> 2) + 4 * n + (i & 3); }

struct Unit { int pm, pn; };
struct Gemm { const bf16_t* A; const bf16_t* Bt; int M, N, K; };

struct StaticOrder {
    int nM, nN, nwg, G, c;
    __host__ __device__ void init(int M, int N, int G_, int c_) { nM = M / BM; nN = N / BM; nwg = nM * nN; G = G_; c = c_; }
    __host__ __device__ bool next(int i, Unit& u) const {
        const long L = (long)i * G + c; if (L >= nwg) return false;
        int wgid = (int)L; { const int q = nwg / NXCD, r = nwg % NXCD, xcd = wgid % NXCD, off = wgid / NXCD; wgid = (xcd < r ? xcd * (q + 1) : r * (q + 1) + (xcd - r) * q) + off; }
        const int nig = WGM * nN, gid = wgid / nig, fm = gid * WGM, gsz = (nM - fm) < WGM ? (nM - fm) : WGM;
        u.pm = fm + ((wgid % nig) % gsz); u.pn = (wgid % nig) / gsz; return true;
    }
    __device__ __forceinline__ void a_ready(const Unit&) const {}
    __device__ __forceinline__ void done(const Unit&) const {}
};


__device__ __forceinline__ unsigned cvt_pk_bf16(float lo, float hi) { unsigned r; asm volatile("v_cvt_pk_bf16_f32 %0, %1, %2" : "=v"(r) : "v"(lo), "v"(hi)); return r; }

struct EpiBf16 {
    static constexpr bool PERM = true, AFTER_DRAIN = false;
    bf16_t* O; int ldc; float* gates; int gate_tile;
    __device__ __forceinline__ void operator()(const f32x4 (&acc)[2][2][4][2], const Unit& u, int wr, int wc, int fr, int fq) const {
        const int row0 = u.pm * BM + wr * 64 + fr;
        if (u.pn == gate_tile) {
            if (wc == 0) {
#pragma unroll
                for (int ai = 0; ai < 2; ++ai)
#pragma unroll
                    for (int m = 0; m < 4; ++m) { float* g = gates + (size_t)(row0 + ai * HALF + m * 16) * 32 + 8 * fq;
                        *(f32x4*)(g) = acc[ai][0][m][0]; *(f32x4*)(g + 4) = acc[ai][0][m][1]; }
            }
            return;
        }
        const int col0 = u.pn * BM + wc * 32 + 8 * fq;
#pragma unroll
        for (int ai = 0; ai < 2; ++ai)
#pragma unroll
            for (int m = 0; m < 4; ++m) { bf16_t* rowp = O + (size_t)(row0 + ai * HALF + m * 16) * ldc + col0;
#pragma unroll
                for (int bj = 0; bj < 2; ++bj) { const f32x4 v0 = acc[ai][bj][m][0], v1 = acc[ai][bj][m][1];
                    u32x4 w; w.x = cvt_pk_bf16(v0[0], v0[1]); w.y = cvt_pk_bf16(v0[2], v0[3]); w.z = cvt_pk_bf16(v1[0], v1[1]); w.w = cvt_pk_bf16(v1[2], v1[3]);
                    *(u32x4*)(rowp + bj * HALF) = w; } }
    }
};
struct EpiF32 {
    static constexpr bool PERM = false, AFTER_DRAIN = false;
    float* O; int ldc;
    __device__ __forceinline__ void operator()(const f32x4 (&acc)[2][2][4][2], const Unit& u, int wr, int wc, int fr, int fq) const {
        const int row0 = u.pm * BM + wr * 64 + fr, col0 = u.pn * BM + wc * 32 + 4 * fq;
#pragma unroll
        for (int ai = 0; ai < 2; ++ai)
#pragma unroll
            for (int m = 0; m < 4; ++m) { float* rowp = O + (size_t)(row0 + ai * HALF + m * 16) * ldc + col0;
#pragma unroll
                for (int bj = 0; bj < 2; ++bj)
#pragma unroll
                    for (int n = 0; n < 2; ++n) *(f32x4*)(rowp + bj * HALF + n * 16) = acc[ai][bj][m][n]; }
    }
};

template <class Epi, class Sched, bool ALIGN_EPI = false, bool SP2 = false>
__device__ __forceinline__ void gemm_phase(PG8_LAS unsigned char* lds, const Gemm g, const Sched& S, const Epi& E) {
    const int tid = threadIdx.x, wid = __builtin_amdgcn_readfirstlane(tid >> 6), lane = tid & 63, wr = wid >> 2, wc = wid & 3, fr = lane & 15, fq = lane >> 4;
    const int K = g.K, nt = K / BK;
    unsigned voffA[2], voffB[2];
#pragma unroll
    for (int i = 0; i < 2; ++i) { int R, C; stage_rc(tid * 16 + i * 8192, R, C); const int Rb = Epi::PERM ? ((R & ~31) + perm32(R & 31)) : R;
        voffA[i] = (unsigned)(R * K + C) * 2u; voffB[i] = (unsigned)(Rb * K + C) * 2u; }
    const size_t kstep = (size_t)(BK * 2);
    const size_t hstep = (size_t)HALF * K * 2;
    const size_t tstep = 2 * hstep;
    const unsigned ldsw = (unsigned)wid * 1024u;
    const int aoff = lds_byte(wr * 64 + fr, fq * 8), boff = lds_byte(wc * 32 + fr, fq * 8);
#define PG8_SA(b, h) (((b) * 2 + (h)) * HTB)
#define PG8_SB(b, h) ((4 + (b) * 2 + (h)) * HTB)
#define PG8_STAGE(bufoff, gbase, voff) do { _Pragma("unroll") for (int _i = 0; _i < 2; ++_i) \
        __builtin_amdgcn_global_load_lds((const unsigned*)((const char*)(gbase) + (voff)[_i]), (PG8_LAS unsigned*)(lds + (bufoff) + ldsw + _i * 8192), 16, 0, 0); } while (0)
#define PG8_LDA(dst, b, h) do { _Pragma("unroll") for (int m = 0; m < 4; ++m) _Pragma("unroll") for (int k = 0; k < 2; ++k) dst[m][k] = *(const PG8_LAS bf16x8*)(lds + PG8_SA(b, h) + aoff + m * 2048 + k * 1024); } while (0)
#define PG8_LDB(dst, b, h) do { _Pragma("unroll") for (int n = 0; n < 2; ++n) _Pragma("unroll") for (int k = 0; k < 2; ++k) dst[n][k] = *(const PG8_LAS bf16x8*)(lds + PG8_SB(b, h) + boff + n * 2048 + k * 1024); } while (0)
#define PG8_MMA(ai, bj, At, Bt) do { __builtin_amdgcn_s_setprio(1); _Pragma("unroll") for (int m = 0; m < 4; ++m) _Pragma("unroll") for (int n = 0; n < 2; ++n) _Pragma("unroll") for (int k = 0; k < 2; ++k) \
        acc[ai][bj][m][n] = __builtin_amdgcn_mfma_f32_16x16x32_bf16(Bt[n][k], At[m][k], acc[ai][bj][m][n], 0, 0, 0); __builtin_amdgcn_s_setprio(0); } while (0)
#define PG8_WAIT_V(n) asm volatile("s_waitcnt vmcnt(" #n ")" ::: "memory")
#define PG8_WAIT_L(n) asm volatile("s_waitcnt lgkmcnt(" #n ")" ::: "memory")
#define PG8_BAR __builtin_amdgcn_s_barrier()
#define PG8_SCHED __builtin_amdgcn_sched_barrier(0)
    Unit cur, nxt; int ui = 0;
    if (!S.next(0, cur)) return;
    f32x4 acc[2][2][4][2];
#pragma unroll
    for (int a = 0; a < 2; ++a)
#pragma unroll
        for (int b = 0; b < 2; ++b)
#pragma unroll
            for (int m = 0; m < 4; ++m)
#pragma unroll
                for (int n = 0; n < 2; ++n) acc[a][b][m][n] = (f32x4){0.f, 0.f, 0.f, 0.f};
    bf16x8 At[4][2], B0[2][2], B1[2][2];
    const char* cA = (const char*)g.A + (size_t)cur.pm * tstep; const char* cB = (const char*)g.Bt + (size_t)cur.pn * tstep;
    S.a_ready(cur);
    if constexpr (SP2) {
        PG8_STAGE(PG8_SB(0, 0), cB, voffB); PG8_STAGE(PG8_SB(0, 1), cB + hstep, voffB); PG8_STAGE(PG8_SA(0, 0), cA, voffA); PG8_STAGE(PG8_SA(0, 1), cA + hstep, voffA);
        if (wr == 1) PG8_BAR;
        PG8_WAIT_V(2); PG8_BAR;
        PG8_STAGE(PG8_SB(1, 0), cB + kstep, voffB); PG8_STAGE(PG8_SA(1, 0), cA + kstep, voffA); PG8_STAGE(PG8_SB(1, 1), cB + hstep + kstep, voffB);
        PG8_WAIT_V(6); PG8_BAR;
    } else {
        PG8_STAGE(PG8_SB(0, 0), cB, voffB); PG8_STAGE(PG8_SA(0, 0), cA, voffA); PG8_STAGE(PG8_SB(0, 1), cB + hstep, voffB); PG8_STAGE(PG8_SA(0, 1), cA + hstep, voffA);
        if (wr == 1) PG8_BAR;
        PG8_WAIT_V(4); PG8_BAR;
        PG8_STAGE(PG8_SB(1, 0), cB + kstep, voffB); PG8_STAGE(PG8_SA(1, 0), cA + kstep, voffA); PG8_STAGE(PG8_SB(1, 1), cB + hstep + kstep, voffB);
        PG8_WAIT_V(6); PG8_BAR;
    }
    for (;;) {
        const bool has_next = S.next(ui + 1, nxt);
        const char* nA = has_next ? (const char*)g.A + (size_t)nxt.pm * tstep : cA; const char* nB = has_next ? (const char*)g.Bt + (size_t)nxt.pn * tstep : cB;
        for (int t = 0; t < nt; t += 2) {
            const bool last = (t == nt - 2);
            const char* a1 = cA + (size_t)(t + 1) * kstep;
            const char* a2 = last ? nA : cA + (size_t)(t + 2) * kstep; const char* b2 = last ? nB : cB + (size_t)(t + 2) * kstep;
            const char* a3 = a2 + kstep; const char* b3 = b2 + kstep;
            if (last && has_next) S.a_ready(nxt);
            if constexpr (SP2) {
            PG8_LDB(B0, 0, 0); PG8_LDB(B1, 0, 1); PG8_SCHED; PG8_LDA(At, 0, 0); PG8_STAGE(PG8_SA(1, 1), a1 + hstep, voffA);
            PG8_WAIT_V(8); PG8_WAIT_L(0); PG8_BAR; PG8_MMA(0, 0, At, B0); PG8_MMA(0, 1, At, B1); PG8_BAR; PG8_SCHED;
            PG8_LDA(At, 0, 1); PG8_STAGE(PG8_SB(0, 0), b2, voffB); PG8_STAGE(PG8_SB(0, 1), b2 + hstep, voffB); PG8_STAGE(PG8_SA(0, 0), a2, voffA);
            PG8_WAIT_V(8); PG8_WAIT_L(0); PG8_BAR; PG8_MMA(1, 0, At, B0); PG8_MMA(1, 1, At, B1); PG8_BAR; PG8_SCHED;
            PG8_LDB(B0, 1, 0); PG8_LDB(B1, 1, 1); PG8_SCHED; PG8_LDA(At, 1, 0); PG8_STAGE(PG8_SA(0, 1), a2 + hstep, voffA);
            PG8_WAIT_V(8); PG8_WAIT_L(0); PG8_BAR; PG8_MMA(0, 0, At, B0); PG8_MMA(0, 1, At, B1); PG8_BAR; PG8_SCHED;
            PG8_LDA(At, 1, 1); PG8_STAGE(PG8_SB(1, 0), b3, voffB); PG8_STAGE(PG8_SB(1, 1), b3 + hstep, voffB); PG8_STAGE(PG8_SA(1, 0), a3, voffA);
            PG8_WAIT_V(8); PG8_WAIT_L(0); PG8_BAR; PG8_MMA(1, 0, At, B0); PG8_MMA(1, 1, At, B1); PG8_BAR; PG8_SCHED;
            } else {
            PG8_LDB(B0, 0, 0); PG8_SCHED; PG8_LDA(At, 0, 0); PG8_STAGE(PG8_SA(1, 1), a1 + hstep, voffA);
            PG8_WAIT_L(8); PG8_BAR; PG8_WAIT_L(0); PG8_MMA(0, 0, At, B0); PG8_BAR; PG8_SCHED;
            PG8_LDB(B1, 0, 1); PG8_STAGE(PG8_SB(0, 0), b2, voffB);
            PG8_BAR; PG8_WAIT_L(0); PG8_MMA(0, 1, At, B1); PG8_BAR;
            PG8_LDA(At, 0, 1); PG8_STAGE(PG8_SA(0, 0), a2, voffA);
            PG8_BAR; PG8_WAIT_L(0); PG8_MMA(1, 0, At, B0); PG8_BAR; PG8_SCHED;
            PG8_STAGE(PG8_SB(0, 1), b2 + hstep, voffB);
            PG8_WAIT_V(6); PG8_BAR; PG8_MMA(1, 1, At, B1); PG8_BAR;
            PG8_LDB(B0, 1, 0); PG8_SCHED; PG8_LDA(At, 1, 0); PG8_STAGE(PG8_SA(0, 1), a2 + hstep, voffA);
            PG8_WAIT_L(8); PG8_BAR; PG8_WAIT_L(0); PG8_MMA(0, 0, At, B0); PG8_BAR; PG8_SCHED;
            PG8_LDB(B1, 1, 1); PG8_STAGE(PG8_SB(1, 0), b3, voffB);
            PG8_BAR; PG8_WAIT_L(0); PG8_MMA(0, 1, At, B1); PG8_BAR;
            PG8_LDA(At, 1, 1); PG8_STAGE(PG8_SA(1, 0), a3, voffA);
            PG8_BAR; PG8_WAIT_L(0); PG8_MMA(1, 0, At, B0); PG8_BAR; PG8_SCHED;
            PG8_STAGE(PG8_SB(1, 1), b3 + hstep, voffB);
            PG8_WAIT_V(6); PG8_BAR; PG8_MMA(1, 1, At, B1); PG8_BAR;
            }
        }
        if constexpr (ALIGN_EPI) { if (wr == 0) PG8_BAR; }
        if constexpr (!Epi::AFTER_DRAIN) { E(acc, cur, wr, wc, fr, fq); S.done(cur); }
        if (!has_next) break;
#pragma unroll
        for (int a = 0; a < 2; ++a)
#pragma unroll
            for (int b = 0; b < 2; ++b)
#pragma unroll
                for (int m = 0; m < 4; ++m)
#pragma unroll
                    for (int n = 0; n < 2; ++n) acc[a][b][m][n] = (f32x4){0.f, 0.f, 0.f, 0.f};
        cur = nxt; cA = nA; cB = nB; ++ui;
        if constexpr (ALIGN_EPI) { if (wr == 1) PG8_BAR; }
    }
    PG8_WAIT_V(0);
    if constexpr (!ALIGN_EPI) { if (wr == 0) PG8_BAR; }
    PG8_BAR;
    if constexpr (Epi::AFTER_DRAIN) { E.fused(acc, cur, wr, wc, fr, fq, lds, wid, lane); S.done(cur); }
#undef PG8_SA
#undef PG8_SB
#undef PG8_STAGE
#undef PG8_LDA
#undef PG8_LDB
#undef PG8_MMA
#undef PG8_WAIT_V
#undef PG8_WAIT_L
#undef PG8_BAR
#undef PG8_SCHED
}
}


namespace attn {
using bf16x8 = __attribute__((ext_vector_type(8))) short;
using s16x4  = __attribute__((ext_vector_type(4))) short;
using f32x16 = __attribute__((ext_vector_type(16))) float;
using u32x4  = __attribute__((ext_vector_type(4))) unsigned;
typedef unsigned short bf16;
constexpr int NW = 8, QBLK = 32, KVBLK = 64;
constexpr float SCALE = 0.125f;
constexpr float THR = 8.f;
constexpr int SHM_V = KVBLK * 128 * 2, SHM_K = KVBLK * 64 * 2, SHM_ATTN = 2 * SHM_V + 2 * SHM_K + NW * 64 * 4;
#define KSWZ64(row, ch) ((row) * 128 + ((((ch) ^ (((row) >> 1) & 7))) << 4))
#define SBAR() __builtin_amdgcn_sched_barrier(0)
__device__ __forceinline__ int crow(int r, int hi) { return (r & 3) + 8 * (r >> 2) + 4 * hi; }
__device__ __forceinline__ unsigned cvtpk(float lo, float hi) { unsigned r; asm volatile("v_cvt_pk_bf16_f32 %0, %1, %2" : "=v"(r) : "v"(lo), "v"(hi)); return r; }

__device__ __forceinline__ void partialSM(f32x16& p0, f32x16& p1, float& m_reg, float& mn, float& alpha) {
  constexpr float C = SCALE * 1.4426950408889634f;
  float pmax = p0[0];
#pragma unroll
  for (int r = 1; r < 16; ++r) pmax = fmaxf(pmax, p0[r]);
#pragma unroll
  for (int r = 0; r < 16; ++r) pmax = fmaxf(pmax, p1[r]);
  { auto rr = __builtin_amdgcn_permlane32_swap(__float_as_uint(pmax), __float_as_uint(pmax), false, false);
    pmax = fmaxf(__uint_as_float(rr[0]), __uint_as_float(rr[1])); }
  if (__builtin_expect(__all(pmax - m_reg <= THR / SCALE), 1)) { mn = m_reg; alpha = 1.f; }
  else { mn = fmaxf(m_reg, pmax); alpha = __builtin_amdgcn_exp2f((m_reg - mn) * C); m_reg = mn; }
  float mnC = -mn * C;
#pragma unroll
  for (int r = 0; r < 16; ++r) p0[r] = fmaf(p0[r], C, mnC);
#pragma unroll
  for (int r = 0; r < 16; ++r) p1[r] = fmaf(p1[r], C, mnC);
#pragma unroll
  for (int r = 0; r < 16; ++r) p0[r] = __builtin_amdgcn_exp2f(p0[r]);
}
__device__ __forceinline__ void finishSM(f32x16& p0, f32x16& p1, float alpha, float& l_reg, bf16x8& pa0, bf16x8& pa1, bf16x8& pa2, bf16x8& pa3) {
#pragma unroll
  for (int r = 0; r < 16; ++r) p1[r] = __builtin_amdgcn_exp2f(p1[r]);
  float ps = 0;
#pragma unroll
  for (int r = 0; r < 16; ++r) ps += p0[r];
#pragma unroll
  for (int r = 0; r < 16; ++r) ps += p1[r];
  { auto rr = __builtin_amdgcn_permlane32_swap(__float_as_uint(ps), __float_as_uint(ps), false, false);
    ps = __uint_as_float(rr[0]) + __uint_as_float(rr[1]); }
  l_reg = l_reg * alpha + ps;
#define PK4(P, BASE, OUT) do { unsigned a0 = cvtpk(P[BASE + 0], P[BASE + 1]), a1 = cvtpk(P[BASE + 2], P[BASE + 3]);   \
    unsigned b0 = cvtpk(P[BASE + 4], P[BASE + 5]), b1 = cvtpk(P[BASE + 6], P[BASE + 7]);                              \
    auto r0 = __builtin_amdgcn_permlane32_swap(a0, b0, false, false); auto r1 = __builtin_amdgcn_permlane32_swap(a1, b1, false, false); \
    u32x4 w = {r0[0], r1[0], r0[1], r1[1]}; OUT = *reinterpret_cast<bf16x8*>(&w); } while (0)
  PK4(p0, 0, pa0); PK4(p0, 8, pa1); PK4(p1, 0, pa2); PK4(p1, 8, pa3);
#undef PK4
}
__device__ __forceinline__ void qkt(f32x16& p0, f32x16& p1, const char* Ks, const bf16x8* qr, int r32, int hi) {
  p0 = f32x16{}; p1 = f32x16{};
#pragma unroll
  for (int d0 = 0; d0 < 4; ++d0) { const int ch = 2 * d0 + hi;
    bf16x8 b0 = *reinterpret_cast<const bf16x8*>(Ks + KSWZ64(r32, ch));
    bf16x8 b1 = *reinterpret_cast<const bf16x8*>(Ks + KSWZ64(32 + r32, ch));
    p0 = __builtin_amdgcn_mfma_f32_32x32x16_bf16(b0, qr[d0], p0, 0, 0, 0);
    p1 = __builtin_amdgcn_mfma_f32_32x32x16_bf16(b1, qr[d0], p1, 0, 0, 0); }
}
__device__ __forceinline__ int v_st(int k, int c) { const int kk = (k & ~0xC) | ((k & 4) << 1) | ((k & 8) >> 1); return ((kk >> 3) * 4 + (c >> 5)) * 512 + ((kk & 7) * 32 + (c & 31)) * 2; }
__device__ __forceinline__ int v_rd_base(int lane) { return ((lane & 3) << 3) | (((lane >> 2) & 3) << 6) | (((lane >> 4) & 1) << 5) | (((lane >> 5) & 1) << 8); }
constexpr int v_rd_off(int d0, int ks, int half) { return d0 * 512 + ks * 4096 + half * 2048; }
template <int OFF> __device__ __forceinline__ s16x4 tr_read(int vb) {
  s16x4 r; asm volatile("ds_read_b64_tr_b16 %0, %1 offset:%2" : "=&v"(r) : "v"(vb), "i"(OFF) : "memory"); return r;
}
template <int D0> __device__ __forceinline__ void pv_one(f32x16& od, int vb, bf16x8 pa0, bf16x8 pa1, bf16x8 pa2, bf16x8 pa3) {
  const s16x4 l0 = tr_read<v_rd_off(D0, 0, 0)>(vb), h0 = tr_read<v_rd_off(D0, 0, 1)>(vb), l1 = tr_read<v_rd_off(D0, 1, 0)>(vb), h1 = tr_read<v_rd_off(D0, 1, 1)>(vb);
  const s16x4 l2 = tr_read<v_rd_off(D0, 2, 0)>(vb), h2 = tr_read<v_rd_off(D0, 2, 1)>(vb), l3 = tr_read<v_rd_off(D0, 3, 0)>(vb), h3 = tr_read<v_rd_off(D0, 3, 1)>(vb);
  asm volatile("s_waitcnt lgkmcnt(0)" ::: "memory"); SBAR();
#define PK(L, H) (bf16x8){L[0], L[1], L[2], L[3], H[0], H[1], H[2], H[3]}
  od = __builtin_amdgcn_mfma_f32_32x32x16_bf16(pa0, PK(l0, h0), od, 0, 0, 0);
  od = __builtin_amdgcn_mfma_f32_32x32x16_bf16(pa1, PK(l1, h1), od, 0, 0, 0);
  od = __builtin_amdgcn_mfma_f32_32x32x16_bf16(pa2, PK(l2, h2), od, 0, 0, 0);
  od = __builtin_amdgcn_mfma_f32_32x32x16_bf16(pa3, PK(l3, h3), od, 0, 0, 0);
#undef PK
}
__device__ __forceinline__ void pv_d0(f32x16* o, int vb, bf16x8 pa0, bf16x8 pa1, bf16x8 pa2, bf16x8 pa3) {
  pv_one<0>(o[0], vb, pa0, pa1, pa2, pa3); pv_one<1>(o[1], vb, pa0, pa1, pa2, pa3); pv_one<2>(o[2], vb, pa0, pa1, pa2, pa3); pv_one<3>(o[3], vb, pa0, pa1, pa2, pa3);
}

template <int LD>
__device__ __forceinline__ void attn_sub(const bf16* __restrict__ Qb, const bf16* __restrict__ Kh, const bf16* __restrict__ Vh, int NT, char* lds, f32x16 (&o)[4], float (&rli)[16]) {
  const int tid = threadIdx.x, wid = tid >> 6, lane = tid & 63, r32 = lane & 31, hi = lane >> 5;
  char* V_lds = lds; char* K_lds = lds + 2 * SHM_V;
  float* ws = (float*)(lds + 2 * SHM_V + 2 * SHM_K) + wid * 64; float* li_l = ws; float* al_l = ws + 32;
  float m_reg = -1e30f, l_reg = 0; bf16x8 qr[4];
#pragma unroll
  for (int d = 0; d < 4; ++d) o[d] = f32x16{};
  const bf16* Qw = Qb + (long)(wid * QBLK + r32) * LD + hi * 8;
#pragma unroll
  for (int d0 = 0; d0 < 4; ++d0) qr[d0] = *reinterpret_cast<const bf16x8*>(Qw + d0 * 16);
  const int sr = tid >> 4, sc = (tid & 15) * 8, vst0 = v_st(sr, sc), vst1 = v_st(32 + sr, sc);
  const int kr = tid >> 3, kc = tid & 7, kst = KSWZ64(kr, kc);
  const int vb0 = (int)(uintptr_t)V_lds + v_rd_base(lane);
  struct { bf16x8 vs0, vs1, ks0; } sr_[2];
#define SLOAD(i, k0) do { sr_[i].vs0 = *reinterpret_cast<const bf16x8*>(&Vh[(long)((k0) + sr) * LD + sc]); sr_[i].vs1 = *reinterpret_cast<const bf16x8*>(&Vh[(long)((k0) + 32 + sr) * LD + sc]); \
    sr_[i].ks0 = *reinterpret_cast<const bf16x8*>(&Kh[(long)((k0) + kr) * LD + kc * 8]); } while (0)
#define SWRITE(b, i) do { *(bf16x8*)(V_lds + (b) * SHM_V + vst0) = sr_[i].vs0; *(bf16x8*)(V_lds + (b) * SHM_V + vst1) = sr_[i].vs1; \
    *(bf16x8*)(K_lds + (b) * SHM_K + kst) = sr_[i].ks0; } while (0)
#define SWAIT() asm volatile("s_waitcnt vmcnt(3)" ::: "memory")
#define RESC(a) do { if (__any((a) < 1.f)) { if (hi == 0) al_l[r32] = (a); asm volatile("s_waitcnt lgkmcnt(0)" ::: "memory"); \
    _Pragma("unroll") for (int d = 0; d < 4; ++d) _Pragma("unroll") for (int r = 0; r < 16; ++r) o[d][r] *= al_l[crow(r, hi)]; } } while (0)
  f32x16 pA0, pA1, pB0, pB1; float mnA, mnB, alA, alB; bf16x8 pa0, pa1, pa2, pa3;
  constexpr int SE = 0, SO = 1;
  SLOAD(SE, 0); asm volatile("s_waitcnt vmcnt(0)" ::: "memory"); SWRITE(0, SE); __syncthreads();
  qkt(pA0, pA1, K_lds, qr, r32, hi); partialSM(pA0, pA1, m_reg, mnA, alA);
  SLOAD(SO, KVBLK); if (2 < NT) SLOAD(SE, 2 * KVBLK);
  SWAIT(); SWRITE(1, SO); __syncthreads();
  for (int j = 1; j + 1 < NT; j += 2) {
    SBAR(); qkt(pB0, pB1, K_lds + SHM_K, qr, r32, hi);
    finishSM(pA0, pA1, alA, l_reg, pa0, pa1, pa2, pa3); SBAR();
    SLOAD(SO, (j + 2) * KVBLK); SBAR();
    pv_d0(o, vb0, pa0, pa1, pa2, pa3); partialSM(pB0, pB1, m_reg, mnB, alB);
    __syncthreads(); SWAIT(); SWRITE(0, SE);
    RESC(alB); __syncthreads();
    SBAR(); qkt(pA0, pA1, K_lds, qr, r32, hi);
    finishSM(pB0, pB1, alB, l_reg, pa0, pa1, pa2, pa3); SBAR();
    if (j + 3 < NT) SLOAD(SE, (j + 3) * KVBLK); SBAR();
    pv_d0(o, vb0 + SHM_V, pa0, pa1, pa2, pa3); partialSM(pA0, pA1, m_reg, mnA, alA);
    __syncthreads(); SWAIT(); SWRITE(1, SO);
    RESC(alA); __syncthreads();
  }
  SBAR(); qkt(pB0, pB1, K_lds + SHM_K, qr, r32, hi);
  finishSM(pA0, pA1, alA, l_reg, pa0, pa1, pa2, pa3); SBAR();
  pv_d0(o, vb0, pa0, pa1, pa2, pa3); partialSM(pB0, pB1, m_reg, mnB, alB);
  __syncthreads(); RESC(alB);
  finishSM(pB0, pB1, alB, l_reg, pa0, pa1, pa2, pa3); SBAR();
  pv_d0(o, vb0 + SHM_V, pa0, pa1, pa2, pa3);
  if (hi == 0) li_l[r32] = l_reg; asm volatile("s_waitcnt lgkmcnt(0)" ::: "memory");
#pragma unroll
  for (int r = 0; r < 16; ++r) rli[r] = __builtin_amdgcn_rcpf(li_l[crow(r, hi)]);
  __syncthreads();
#undef SLOAD
#undef SWRITE
#undef SWAIT
#undef RESC
}
#undef SBAR
}

constexpr int BATCH = 2, SEQ = 8192, DM = 2048, CTX = 256;
constexpr int UROWS_B = CTX + SEQ;
constexpr int UROWS = BATCH * UROWS_B;
constexpr int LROWS = BATCH * SEQ;
constexpr int IN_COLS = 7200, NPAD = 7424, LDP = 7168;
constexpr int DFF = 5632, NUP = 2 * DFF;
constexpr int NMOD = 6 * DM;
constexpr int PC_MQ = 0, PC_MK = 1024, PC_MV = 2048, PC_MO = 3072, PC_DQ = 4096, PC_DK = 5120, PC_DV = 6144;
constexpr float EPS = 1e-6f;
constexpr int KSL = 8;

constexpr size_t MiB = 1u << 20;
constexpr size_t WS_CTL = 0, CTL_ZERO_BYTES = 1 * MiB;
constexpr size_t WS_MODP = 1 * MiB;
constexpr size_t WS_GATES = 3 * MiB;
constexpr size_t WS_WUP = 6 * MiB;
constexpr size_t WS_WDN = 50 * MiB;
constexpr size_t WS_XN = 72 * MiB;
constexpr size_t WS_ARENA = 138 * MiB;
constexpr size_t WS_WIN = WS_ARENA;
constexpr size_t WS_WOUT = WS_ARENA + 29 * MiB;
constexpr size_t WS_P = WS_ARENA + 37 * MiB;
constexpr size_t WS_MIX = WS_ARENA + 268 * MiB;
constexpr size_t WS_ASCR = WS_ARENA + 332 * MiB;
constexpr size_t WS_Y = WS_P;
constexpr size_t WS_U = WS_ARENA;
constexpr size_t WS_HMID = WS_ARENA + 176 * MiB;
constexpr size_t WS_Y2 = WS_ARENA;
constexpr size_t WS_END = WS_ARENA + 364 * MiB;
static_assert(WS_HMID + (size_t)LROWS * DFF * 2 <= WS_END && WS_ASCR + 32 * MiB <= WS_END && WS_MIX >= WS_P + (size_t)UROWS * LDP * 2, "ws map");

constexpr int RING_BYTES = 131072, LDS_BYTES = 147456;
constexpr int NWAVES = 8;

#define LAS __attribute__((address_space(3)))
typedef unsigned short bf16;
typedef unsigned v4u __attribute__((ext_vector_type(4)));
typedef unsigned v2u __attribute__((ext_vector_type(2)));
typedef float f32x4 __attribute__((ext_vector_type(4)));
typedef short bf16x8 __attribute__((ext_vector_type(8)));

__device__ __forceinline__ unsigned f2bf(float f) { unsigned u = __builtin_bit_cast(unsigned, f); return (u + 0x7fffu + ((u >> 16) & 1u)) >> 16; }
__device__ __forceinline__ unsigned pk2(float lo, float hi) { return f2bf(lo) | (f2bf(hi) << 16); }
__device__ __forceinline__ float bf2f(unsigned short b) { return __builtin_bit_cast(float, (unsigned)b << 16); }
__device__ __forceinline__ float bflo(unsigned w) { return __builtin_bit_cast(float, w << 16); }
__device__ __forceinline__ float bfhi(unsigned w) { return __builtin_bit_cast(float, w & 0xffff0000u); }
__device__ __forceinline__ float wave_sum(float v) {
#pragma unroll
    for (int o = 1; o < 64; o <<= 1) v += __shfl_xor(v, o);
    return v;
}
__device__ __forceinline__ float silu_f(float x) { return x / (1.f + __expf(-x)); }
__device__ __forceinline__ float sigmoid_f(float x) { return 1.f / (1.f + __expf(-x)); }
__device__ __forceinline__ float logsigmoid_f(float x) { return fminf(x, 0.f) - log1pf(__expf(-fabsf(x))); }

struct Frame {
    unsigned char* lds;
    int tid, lane, wave, vcu, G;
    const float *x, *c, *ctx, *c_ctx, *w_mod, *b_mod, *g_pre_mix, *g_post_mix, *w_in, *b_gate, *conv_qk_w, *conv_qk_b, *g_mlstm,
                *lq1, *lk1, *lq2, *lk2, *g_diff, *w_out, *g_pre_ffn, *g_post_ffn, *w_up, *conv_ffn_w, *conv_ffn_b, *w_down;
    float* out; unsigned char* ws;
};

__device__ __forceinline__ void transpose_item(const float* W, int K, int N, bf16* WT, int dst_row0, int k0, int n0, float* scr, int lane) {
#pragma unroll 8
    for (int i = 0; i < 32; ++i) { const int kk = 2 * i + (lane >> 5); scr[kk * 33 + (lane & 31)] = W[(size_t)(k0 + kk) * N + n0 + (lane & 31)]; }
    asm volatile("s_waitcnt lgkmcnt(0)" ::: "memory");
    const int c = lane & 7;
#pragma unroll
    for (int j = 0; j < 4; ++j) { const int n = (lane >> 3) + 8 * j; const float* s = scr + (8 * c) * 33 + n;
        v4u o; o.x = pk2(s[0 * 33], s[1 * 33]); o.y = pk2(s[2 * 33], s[3 * 33]); o.z = pk2(s[4 * 33], s[5 * 33]); o.w = pk2(s[6 * 33], s[7 * 33]);
        *(v4u*)(WT + (size_t)(dst_row0 + n) * K + k0 + 8 * c) = o; }
    asm volatile("s_waitcnt lgkmcnt(0)" ::: "memory");
}
__device__ __forceinline__ int win_dst_row(int nb) { return nb < 128 ? 32 * nb : (nb == 128 ? 7168 : 4096 + 32 * (nb - 129)); }

constexpr int MOD_BLOCKS = 48;
__device__ __forceinline__ void p0_prologue(Frame& F) {
    const int blk = blockIdx.x;
    if (blk < MOD_BLOCKS) {
        const int id = blk * 512 + F.tid;
        const int jq = id % 3072, ks = id / 3072;
        f32x4 a0 = {0, 0, 0, 0}, a1 = a0, a2 = a0;
        const float* wp = F.w_mod + (size_t)(ks * 256) * NMOD + 4 * jq;
#pragma unroll 8
        for (int k = 0; k < 256; ++k) {
            const f32x4 w = *(const f32x4*)(wp + (size_t)k * NMOD);
            const int kk = ks * 256 + k;
            const float s0 = silu_f(F.c[kk]), s1 = silu_f(F.c[DM + kk]), s2 = silu_f(F.c_ctx[kk]);
            a0 += w * s0; a1 += w * s1; a2 += w * s2;
        }
        float* mp = (float*)(F.ws + WS_MODP);
        *(f32x4*)(mp + (size_t)(ks * 3 + 0) * NMOD + 4 * jq) = a0;
        *(f32x4*)(mp + (size_t)(ks * 3 + 1) * NMOD + 4 * jq) = a1;
        *(f32x4*)(mp + (size_t)(ks * 3 + 2) * NMOD + 4 * jq) = a2;
        return;
    }
    float* scr = (float*)(F.lds) + F.wave * 2112;
    const int gw = (blk - MOD_BLOCKS) * NWAVES + F.wave, NGW = (F.G - MOD_BLOCKS) * NWAVES;
    constexpr int I_IN = (DM / 64) * (IN_COLS / 32), I_OUT = (DM / 64) * (DM / 32), I_UP = (DM / 64) * (NUP / 32), I_DN = (DFF / 64) * (DM / 32);
    bf16* win_t = (bf16*)(F.ws + WS_WIN); bf16* wout_t = (bf16*)(F.ws + WS_WOUT); bf16* wup_t = (bf16*)(F.ws + WS_WUP); bf16* wdn_t = (bf16*)(F.ws + WS_WDN);
    for (int it = gw; it < I_IN + I_OUT + I_UP + I_DN; it += NGW) {
        int r = it;
        if (r < I_IN) { const int nblk = IN_COLS / 32, kb = r / nblk, nb = r % nblk; transpose_item(F.w_in, DM, IN_COLS, win_t, win_dst_row(nb), 64 * kb, 32 * nb, scr, F.lane); continue; } r -= I_IN;
        if (r < I_OUT) { const int nblk = DM / 32, kb = r / nblk, nb = r % nblk; transpose_item(F.w_out, DM, DM, wout_t, 32 * nb, 64 * kb, 32 * nb, scr, F.lane); continue; } r -= I_OUT;
        if (r < I_UP) { const int nblk = NUP / 32, kb = r / nblk, nb = r % nblk; transpose_item(F.w_up, DM, NUP, wup_t, 32 * nb, 64 * kb, 32 * nb, scr, F.lane); continue; } r -= I_UP;
        { const int nblk = DM / 32, kb = r / nblk, nb = r % nblk; transpose_item(F.w_down, DFF, DM, wdn_t, 32 * nb, 64 * kb, 32 * nb, scr, F.lane); }
    }
    { v4u* z = (v4u*)(win_t + (size_t)7200 * DM); const int n16 = 224 * DM * 2 / 16; const v4u zero = {0, 0, 0, 0};
      for (int i = (blk - MOD_BLOCKS) * 512 + F.tid; i < n16; i += (F.G - MOD_BLOCKS) * 512) z[i] = zero; }
}

__device__ __forceinline__ void load_mod(Frame& F, float* dst, int v, int col0, int n) {
    const float* mp = (const float*)(F.ws + WS_MODP);
    for (int j = F.tid; j < n; j += 512) { float s = F.b_mod[col0 + j];
#pragma unroll
        for (int ks = 0; ks < KSL; ++ks) s += mp[(size_t)(ks * 3 + v) * NMOD + col0 + j];
        dst[j] = s; }
}

__device__ __forceinline__ void p1_xn(Frame& F) {
    float* modl = (float*)F.lds;
    for (int v = 0; v < 3; ++v) load_mod(F, modl + v * 4096, v, 0, 4096);
    __syncthreads();
    bf16* XN = (bf16*)(F.ws + WS_XN);
    const int gw = F.vcu * NWAVES + F.wave, NGW = F.G * NWAVES;
    for (int row = gw; row < UROWS; row += NGW) {
        const int b = row / UROWS_B, s = row % UROWS_B;
        const float* src = s < CTX ? F.ctx + ((size_t)b * CTX + s) * DM : F.x + ((size_t)b * SEQ + (s - CTX)) * DM;
        const float* mv = modl + (s < CTX ? 2 : b) * 4096;
        const f32x4* xr = (const f32x4*)src + F.lane;
        f32x4 v[8]; float ss = 0.f;
#pragma unroll
        for (int j = 0; j < 8; ++j) { v[j] = xr[64 * j]; ss += (v[j].x * v[j].x + v[j].y * v[j].y) + (v[j].z * v[j].z + v[j].w * v[j].w); }
        const float rstd = rsqrtf(wave_sum(ss) * (1.f / DM) + EPS);
        v2u* o8 = (v2u*)(XN + (size_t)row * DM) + F.lane;
#pragma unroll
        for (int j = 0; j < 8; ++j) { const int c0 = 4 * (64 * j + F.lane);
            const f32x4 g = *(const f32x4*)(F.g_pre_mix + c0), sh = *(const f32x4*)(mv + c0), sc = *(const f32x4*)(mv + 2048 + c0);
            const f32x4 y = (v[j] * rstd * g) * (sc + 1.f) + sh;
            v2u w; w.x = pk2(y.x, y.y); w.y = pk2(y.z, y.w); o8[64 * j] = w; }
    }
}

__device__ __forceinline__ void p3_rope(Frame& F) {
    float* ct = (float*)F.lds; float* st = ct + 2048;
    for (int i = F.tid; i < 2048; i += 512) { const int pos = i >> 4, f = i & 15; const float inv = powf(10000.f, -(float)f / 16.f); const float ang = (float)pos * inv; ct[i] = cosf(ang); st[i] = sinf(ang); }
    __syncthreads();
    bf16* P = (bf16*)(F.ws + WS_P);
    const int gw = F.vcu * NWAVES + F.wave, NGW = F.G * NWAVES;
    for (int lr = gw; lr < LROWS; lr += NGW) {
        const int b = lr / SEQ, t = lr % SEQ;
        const int pos = (F.lane & 1) ? (t & 63) : (t >> 6);
        bf16* p = P + (size_t)(b * UROWS_B + CTX + t) * LDP + PC_DQ + 32 * F.lane;
        v4u w[4];
#pragma unroll
        for (int i = 0; i < 4; ++i) w[i] = *(const v4u*)(p + 8 * i);
        v4u o[4];
#pragma unroll
        for (int q = 0; q < 2; ++q)
#pragma unroll
            for (int e = 0; e < 4; ++e) { const int f = 8 * q + 2 * e; const unsigned a = w[q][e], bb = w[2 + q][e];
                const float c0 = ct[pos * 16 + f], s0 = st[pos * 16 + f], c1 = ct[pos * 16 + f + 1], s1 = st[pos * 16 + f + 1];
                const float x0l = bflo(a), x0h = bfhi(a), x1l = bflo(bb), x1h = bfhi(bb);
                o[q][e] = pk2(x0l * c0 - x1l * s0, x0h * c1 - x1h * s1);
                o[2 + q][e] = pk2(x1l * c0 + x0l * s0, x1h * c1 + x0h * s1); }
#pragma unroll
        for (int i = 0; i < 4; ++i) *(v4u*)(p + 8 * i) = o[i];
    }
}

__device__ __forceinline__ void p4_mlstm_simple(Frame& F) {
    if (blockIdx.x >= BATCH * 8) return;
    const int b = blockIdx.x >> 3, h = blockIdx.x & 7, tid = F.tid;
    float* qs = (float*)F.lds; float* ks = qs + 4096; float* vs = ks + 4096; float* tot = vs + 4096;
    float* gi = tot + 4096; float* gf = gi + 32; float* pnum = gf + 32; float* den = pnum + 512;
    const bf16* P = (const bf16*)(F.ws + WS_P); const float* GT = (const float*)(F.ws + WS_GATES);
    float* HF = (float*)(F.ws + WS_XN); bf16* MIX = (bf16*)(F.ws + WS_MIX);
    for (int dir = 0; dir < 2; ++dir) {
        float C[64]; float n0 = 0.f, n1 = 0.f, m = 0.f;
#pragma unroll
        for (int i = 0; i < 64; ++i) C[i] = 0.f;
        for (int seg = 0; seg < 2; ++seg) {
            const int len = seg ? SEQ : CTX, rowbase = b * UROWS_B + (seg ? CTX : 0);
            for (int jb = 0; jb < len / 32; ++jb) {
                __syncthreads();
#pragma unroll 4
                for (int i = 0; i < 16; ++i) { const int idx = tid + 512 * i, tau = idx >> 8, ch = idx & 255, qk = ch >> 7, d = ch & 127;
                    const int pos = dir ? len - 1 - (jb * 32 + tau) : jb * 32 + tau;
                    const int col = (qk ? PC_MK : PC_MQ) + h * 128 + d, cw = qk * 1024 + h * 128 + d;
                    const float rm = pos > 0 ? bf2f(P[(size_t)(rowbase + pos - 1) * LDP + col]) : 0.f, r0 = bf2f(P[(size_t)(rowbase + pos) * LDP + col]),
                                rp = pos < len - 1 ? bf2f(P[(size_t)(rowbase + pos + 1) * LDP + col]) : 0.f;
                    float val = silu_f(F.conv_qk_w[cw] * rm + F.conv_qk_w[2048 + cw] * r0 + F.conv_qk_w[4096 + cw] * rp + F.conv_qk_b[cw]);
                    if (qk) { ks[tau * 128 + d] = val * 0.08838834764831845f; } else { qs[tau * 128 + d] = val; } }
#pragma unroll 4
                for (int i = 0; i < 8; ++i) { const int idx = tid + 512 * i, tau = idx >> 7, e = idx & 127; const int pos = dir ? len - 1 - (jb * 32 + tau) : jb * 32 + tau;
                    vs[tau * 128 + e] = bf2f(P[(size_t)(rowbase + pos) * LDP + PC_MV + h * 128 + e]); }
                if (tid < 32) { const int pos = dir ? len - 1 - (jb * 32 + tid) : jb * 32 + tid; const float* g = GT + (size_t)(rowbase + pos) * 32;
                    gi[tid] = g[(dir * 2) * 8 + h] + F.b_gate[(dir * 2) * 8 + h];
                    gf[tid] = logsigmoid_f(g[(dir * 2 + 1) * 8 + h] + F.b_gate[(dir * 2 + 1) * 8 + h]); }
                __syncthreads();
                for (int tau = 0; tau < 32; ++tau) {
                    const float ig = gi[tau], lf = gf[tau]; const float mn = fmaxf(lf + m, ig); const float fdec = __expf(lf + m - mn), iw = __expf(ig - mn); m = mn;
                    const int par = tau & 1;
                    if (tid < 256) { const int e = tid & 127, dh = tid >> 7; const float ve = vs[tau * 128 + e] * iw; float pn = 0.f;
                        const f32x4* k4 = (const f32x4*)(ks + tau * 128 + dh * 64); const f32x4* q4 = (const f32x4*)(qs + tau * 128 + dh * 64);
#pragma unroll
                        for (int d4 = 0; d4 < 16; ++d4) { const f32x4 kk = k4[d4], qq = q4[d4];
                            C[4 * d4 + 0] = fdec * C[4 * d4 + 0] + ve * kk.x; pn += qq.x * C[4 * d4 + 0];
                            C[4 * d4 + 1] = fdec * C[4 * d4 + 1] + ve * kk.y; pn += qq.y * C[4 * d4 + 1];
                            C[4 * d4 + 2] = fdec * C[4 * d4 + 2] + ve * kk.z; pn += qq.z * C[4 * d4 + 2];
                            C[4 * d4 + 3] = fdec * C[4 * d4 + 3] + ve * kk.w; pn += qq.w * C[4 * d4 + 3]; }
                        pnum[(par * 2 + dh) * 128 + e] = pn;
                    } else if (F.wave == 4) { const int l = F.lane;
                        n0 = fdec * n0 + iw * ks[tau * 128 + 2 * l]; n1 = fdec * n1 + iw * ks[tau * 128 + 2 * l + 1];
                        const float dp = wave_sum(qs[tau * 128 + 2 * l] * n0 + qs[tau * 128 + 2 * l + 1] * n1);
                        if (l == 0) den[par] = dp; }
                    __syncthreads();
                    if (seg == 1 && tid < 128) { const float num = pnum[(par * 2) * 128 + tid] + pnum[(par * 2 + 1) * 128 + tid]; const float dn = den[par];
                        const float hv = num / fmaxf(fabsf(dn), __expf(-m));
                        const int pos = dir ? len - 1 - (jb * 32 + tau) : jb * 32 + tau; float* hp = HF + (size_t)(b * SEQ + pos) * 1024 + h * 128 + tid;
                        if (dir == 0) *hp = hv; else tot[tau * 128 + tid] = *hp + hv; }
                }
                if (seg == 1 && dir == 1) {
                    __syncthreads();
                    for (int q = 0; q < 4; ++q) { const int tau = F.wave * 4 + q, pos = len - 1 - (jb * 32 + tau);
                        const float t0 = tot[tau * 128 + F.lane], t1 = tot[tau * 128 + 64 + F.lane];
                        const float r = rsqrtf(wave_sum(t0 * t0 + t1 * t1) * (1.f / 128.f) + EPS);
                        const bf16* og = P + (size_t)(rowbase + pos) * LDP + PC_MO + h * 128; bf16* mo = MIX + (size_t)(b * SEQ + pos) * DM + h * 128;
                        mo[F.lane] = (bf16)f2bf(t0 * r * F.g_mlstm[h * 128 + F.lane] * sigmoid_f(bf2f(og[F.lane])));
                        mo[64 + F.lane] = (bf16)f2bf(t1 * r * F.g_mlstm[h * 128 + 64 + F.lane] * sigmoid_f(bf2f(og[64 + F.lane]))); }
                }
            }
        }
    }
}

__device__ __forceinline__ void p5_attn(Frame& F) {
    using namespace attn;
    float lam;
    { float s1 = 0.f, s2 = 0.f; for (int i = 0; i < 64; ++i) { s1 += F.lq1[i] * F.lk1[i]; s2 += F.lq2[i] * F.lk2[i]; } lam = expf(s1) - expf(s2) + 0.2f; }
    const attn::bf16* P = (const attn::bf16*)(F.ws + WS_P); ::bf16* MIX = (::bf16*)(F.ws + WS_MIX);
    float* scr0 = F.out;
    const int tid = F.tid, wid = tid >> 6, lane = tid & 63, r32 = lane & 31, hi = lane >> 5;
#pragma unroll 1
    for (int u = blockIdx.x; u < BATCH * 8 * (SEQ / 256); u += F.G) {
        const int qb = u % (SEQ / 256), bh = u / (SEQ / 256), b = bh >> 3, h = bh & 7;
        const attn::bf16* Pb = P + (size_t)(b * UROWS_B) * LDP;
#pragma unroll 1
        for (int c = 0; c < 2; ++c) {
            f32x16 o[4]; float rli[16];
            attn_sub<LDP>(Pb + (size_t)(CTX + qb * 256) * LDP + PC_DQ + h * 128 + c * 64, Pb + PC_DK + h * 128 + c * 64, Pb + PC_DV + h * 128, UROWS_B / 64, (char*)F.lds, o, rli);
            for (int d0 = 0; d0 < 4; ++d0) for (int r = 0; r < 16; ++r) scr0[(d0 * 16 + r) * 512 + tid + blockIdx.x * 65536 + c * 32768] = o[d0][r] * rli[r];
        }
        const float* s1p = scr0 + (size_t)blockIdx.x * 65536 + tid; const float* s2p = s1p + 32768;
        ::bf16* mo = MIX + (size_t)(b * SEQ + qb * 256 + wid * 32) * DM + 1024 + h * 128 + r32;
        const float g0 = F.g_diff[r32] * 0.8f, g1 = F.g_diff[32 + r32] * 0.8f, g2 = F.g_diff[64 + r32] * 0.8f, g3 = F.g_diff[96 + r32] * 0.8f;
#pragma unroll 2
        for (int r = 0; r < 16; ++r) {
            const float v0 = s1p[(0 * 16 + r) * 512] - lam * s2p[(0 * 16 + r) * 512], v1 = s1p[(1 * 16 + r) * 512] - lam * s2p[(1 * 16 + r) * 512],
                        v2 = s1p[(2 * 16 + r) * 512] - lam * s2p[(2 * 16 + r) * 512], v3 = s1p[(3 * 16 + r) * 512] - lam * s2p[(3 * 16 + r) * 512];
            float ss = (v0 * v0 + v1 * v1) + (v2 * v2 + v3 * v3);
#pragma unroll
            for (int off = 1; off < 32; off <<= 1) ss += __shfl_xor(ss, off);
            const float rs = rsqrtf(ss * (1.f / 128.f) + EPS);
            ::bf16* mr = mo + (size_t)((r & 3) + 8 * (r >> 2) + 4 * hi) * DM;
            mr[0] = (::bf16)f2bf(v0 * rs * g0); mr[32] = (::bf16)f2bf(v1 * rs * g1); mr[64] = (::bf16)f2bf(v2 * rs * g2); mr[96] = (::bf16)f2bf(v3 * rs * g3);
        }
    }
}

__device__ __forceinline__ void p7_x1(Frame& F) {
    float* modl = (float*)F.lds;
    for (int b = 0; b < 2; ++b) { load_mod(F, modl + (b * 3 + 0) * 2048, b, 2 * DM, 2048); load_mod(F, modl + (b * 3 + 1) * 2048, b, 3 * DM, 2048); load_mod(F, modl + (b * 3 + 2) * 2048, b, 4 * DM, 2048); }
    __syncthreads();
    const float* Y = (const float*)(F.ws + WS_Y); bf16* XN2 = (bf16*)(F.ws + WS_XN);
    const int gw = F.vcu * NWAVES + F.wave, NGW = F.G * NWAVES;
    for (int row = gw; row < LROWS; row += NGW) {
        const int b = row / SEQ; const float* mv = modl + b * 3 * 2048;
        const f32x4* yr = (const f32x4*)(Y + (size_t)row * DM) + F.lane; const f32x4* xr = (const f32x4*)(F.x + (size_t)row * DM) + F.lane;
        f32x4 v[8]; float ss = 0.f;
#pragma unroll
        for (int j = 0; j < 8; ++j) { v[j] = yr[64 * j]; ss += (v[j].x * v[j].x + v[j].y * v[j].y) + (v[j].z * v[j].z + v[j].w * v[j].w); }
        const float rstd = rsqrtf(wave_sum(ss) * (1.f / DM) + EPS);
        float s2 = 0.f; f32x4* orow = (f32x4*)(F.out + (size_t)row * DM) + F.lane;
#pragma unroll
        for (int j = 0; j < 8; ++j) { const int c0 = 4 * (64 * j + F.lane);
            const f32x4 g = *(const f32x4*)(F.g_post_mix + c0), ga = *(const f32x4*)(mv + c0);
            v[j] = xr[64 * j] + ga * (v[j] * rstd * g); orow[64 * j] = v[j];
            s2 += (v[j].x * v[j].x + v[j].y * v[j].y) + (v[j].z * v[j].z + v[j].w * v[j].w); }
        const float rstd2 = rsqrtf(wave_sum(s2) * (1.f / DM) + EPS);
        v2u* o8 = (v2u*)(XN2 + (size_t)row * DM) + F.lane;
#pragma unroll
        for (int j = 0; j < 8; ++j) { const int c0 = 4 * (64 * j + F.lane);
            const f32x4 g = *(const f32x4*)(F.g_pre_ffn + c0), sh = *(const f32x4*)(mv + 2048 + c0), sc = *(const f32x4*)(mv + 4096 + c0);
            const f32x4 y = (v[j] * rstd2 * g) * (sc + 1.f) + sh;
            v2u w; w.x = pk2(y.x, y.y); w.y = pk2(y.z, y.w); o8[64 * j] = w; }
    }
}

__device__ __forceinline__ void p9_convact(Frame& F, int b) {
    const bf16* U = (const bf16*)(F.ws + WS_U); bf16* HM = (bf16*)(F.ws + WS_HMID) + (size_t)b * SEQ * DFF;
    const int nj = DFF / 8;
    for (long it = (long)blockIdx.x * 512 + F.tid; it < (long)SEQ * nj; it += (long)F.G * 512) {
        const int t = (int)(it / nj), j0 = (int)(it % nj) * 8;
        float accg[8], accv[8];
#pragma unroll
        for (int e = 0; e < 8; ++e) { accg[e] = F.conv_ffn_b[j0 + e]; accv[e] = F.conv_ffn_b[DFF + j0 + e]; }
#pragma unroll
        for (int dt = 0; dt < 3; ++dt) { const int tt = t + dt - 1; if (tt < 0 || tt >= SEQ) continue;
            const v4u g = *(const v4u*)(U + (size_t)tt * NUP + j0), v = *(const v4u*)(U + (size_t)tt * NUP + DFF + j0);
            const float* wg = F.conv_ffn_w + (size_t)dt * NUP + j0; const float* wv = wg + DFF;
#pragma unroll
            for (int e = 0; e < 4; ++e) { accg[2 * e] += wg[2 * e] * bflo(g[e]); accg[2 * e + 1] += wg[2 * e + 1] * bfhi(g[e]); accv[2 * e] += wv[2 * e] * bflo(v[e]); accv[2 * e + 1] += wv[2 * e + 1] * bfhi(v[e]); } }
        v4u o;
#pragma unroll
        for (int e = 0; e < 4; ++e) o[e] = pk2(silu_f(accg[2 * e]) * accv[2 * e], silu_f(accg[2 * e + 1]) * accv[2 * e + 1]);
        *(v4u*)(HM + (size_t)t * DFF + j0) = o;
    }
}

__device__ __forceinline__ void p13_final(Frame& F) {
    float* modl = (float*)F.lds;
    for (int b = 0; b < 2; ++b) load_mod(F, modl + b * 2048, b, 5 * DM, 2048);
    __syncthreads();
    const float* Y2 = (const float*)(F.ws + WS_Y2);
    const int gw = F.vcu * NWAVES + F.wave, NGW = F.G * NWAVES;
    for (int row = gw; row < LROWS; row += NGW) {
        const int b = row / SEQ; const float* mv = modl + b * 2048;
        const f32x4* yr = (const f32x4*)(Y2 + (size_t)row * DM) + F.lane; f32x4* orow = (f32x4*)(F.out + (size_t)row * DM) + F.lane;
        f32x4 v[8]; float ss = 0.f;
#pragma unroll
        for (int j = 0; j < 8; ++j) { v[j] = yr[64 * j]; ss += (v[j].x * v[j].x + v[j].y * v[j].y) + (v[j].z * v[j].z + v[j].w * v[j].w); }
        const float rstd = rsqrtf(wave_sum(ss) * (1.f / DM) + EPS);
#pragma unroll
        for (int j = 0; j < 8; ++j) { const int c0 = 4 * (64 * j + F.lane);
            const f32x4 g = *(const f32x4*)(F.g_post_ffn + c0), ga = *(const f32x4*)(mv + c0);
            orow[64 * j] = orow[64 * j] + ga * (v[j] * rstd * g); }
    }
}

constexpr int N_PHASES = 14;
struct Args { const float* in[25]; float* out; unsigned char* ws; int ph_lo, ph_hi; };
template <int PH_LO, int PH_HI>
__global__ void __launch_bounds__(NWAVES * 64, 2) fwd_kernel(Args args) {
    extern __shared__ __attribute__((aligned(16))) unsigned char lds[];
    Frame F;
    F.lds = lds; F.tid = threadIdx.x; F.lane = F.tid & 63; F.wave = __builtin_amdgcn_readfirstlane(F.tid >> 6);
    F.G = gridDim.x; { const int bx = blockIdx.x; F.vcu = (F.G % 8 == 0) ? (bx % 8) * (F.G / 8) + bx / 8 : bx; }
    F.x = args.in[0]; F.c = args.in[1]; F.ctx = args.in[2]; F.c_ctx = args.in[3]; F.w_mod = args.in[4]; F.b_mod = args.in[5]; F.g_pre_mix = args.in[6]; F.g_post_mix = args.in[7];
    F.w_in = args.in[8]; F.b_gate = args.in[9]; F.conv_qk_w = args.in[10]; F.conv_qk_b = args.in[11]; F.g_mlstm = args.in[12]; F.lq1 = args.in[13]; F.lk1 = args.in[14]; F.lq2 = args.in[15];
    F.lk2 = args.in[16]; F.g_diff = args.in[17]; F.w_out = args.in[18]; F.g_pre_ffn = args.in[19]; F.g_post_ffn = args.in[20]; F.w_up = args.in[21]; F.conv_ffn_w = args.in[22];
    F.conv_ffn_b = args.in[23]; F.w_down = args.in[24]; F.out = args.out; F.ws = args.ws;
    constexpr int lo = PH_LO, hi = PH_HI;
    PG8_LAS unsigned char* ring = (PG8_LAS unsigned char*)lds;
#define IN(k) (lo <= (k) && (k) < hi)
    if (IN(0)) p0_prologue(F);
    if (IN(1)) p1_xn(F);
    if (IN(2)) { pg8::Gemm g{(const pg8::bf16_t*)(F.ws + WS_XN), (const pg8::bf16_t*)(F.ws + WS_WIN), UROWS, NPAD, DM}; pg8::StaticOrder S; S.init(UROWS, NPAD, F.G, (int)blockIdx.x);
        pg8::EpiBf16 E{(pg8::bf16_t*)(F.ws + WS_P), LDP, (float*)(F.ws + WS_GATES), LDP / 256};
        pg8::gemm_phase<pg8::EpiBf16, pg8::StaticOrder, true, true>(ring, g, S, E); }
    if (IN(3)) p3_rope(F);
    if (IN(4)) p4_mlstm_simple(F);
    if (IN(5)) p5_attn(F);
    if (IN(6)) { pg8::Gemm g{(const pg8::bf16_t*)(F.ws + WS_MIX), (const pg8::bf16_t*)(F.ws + WS_WOUT), LROWS, DM, DM}; pg8::StaticOrder S; S.init(LROWS, DM, F.G, (int)blockIdx.x);
        pg8::EpiF32 E{(float*)(F.ws + WS_Y), DM};
        pg8::gemm_phase<pg8::EpiF32, pg8::StaticOrder, true, true>(ring, g, S, E); }
    if (IN(7)) p7_x1(F);
#pragma unroll 1
    for (int b = 0; b < 2; ++b) {
        if (IN(8 + 2 * b)) { pg8::Gemm g{(const pg8::bf16_t*)(F.ws + WS_XN) + (size_t)b * SEQ * DM, (const pg8::bf16_t*)(F.ws + WS_WUP), SEQ, NUP, DM}; pg8::StaticOrder S; S.init(SEQ, NUP, F.G, (int)blockIdx.x);
            pg8::EpiBf16 E{(pg8::bf16_t*)(F.ws + WS_U), NUP, nullptr, -1};
            pg8::gemm_phase<pg8::EpiBf16, pg8::StaticOrder, true, true>(ring, g, S, E); }
        if (IN(9 + 2 * b)) p9_convact(F, b);
    }
    if (IN(12)) { pg8::Gemm g{(const pg8::bf16_t*)(F.ws + WS_HMID), (const pg8::bf16_t*)(F.ws + WS_WDN), LROWS, DM, DFF}; pg8::StaticOrder S; S.init(LROWS, DM, F.G, (int)blockIdx.x);
        pg8::EpiF32 E{(float*)(F.ws + WS_Y2), DM};
        pg8::gemm_phase<pg8::EpiF32, pg8::StaticOrder, true, true>(ring, g, S, E); }
    if (IN(13)) p13_final(F);
#undef IN
}

extern "C" void kernel_launch(void* const* d_in, const int* in_sizes, int n_in, void* d_out, int out_size, void* d_ws, size_t ws_size, hipStream_t stream) {
    static int grid = 0;
    if (grid == 0) {
        if (n_in != 25 || in_sizes[0] != LROWS * DM || out_size != LROWS * DM || ws_size < WS_END) { fprintf(stderr, "kernel_launch: unexpected shapes / workspace (n_in %d, ws %zu, need %zu)\n", n_in, ws_size, (size_t)WS_END); grid = -1; return; }
        bool ok = true;
#define SETATTR(p) ok = ok && (hipFuncSetAttribute((const void*)fwd_kernel<p, p + 1>, hipFuncAttributeMaxDynamicSharedMemorySize, LDS_BYTES) == hipSuccess)
        SETATTR(0); SETATTR(1); SETATTR(2); SETATTR(3); SETATTR(4); SETATTR(5); SETATTR(6); SETATTR(7); SETATTR(8); SETATTR(9); SETATTR(10); SETATTR(11); SETATTR(12); SETATTR(13);
#undef SETATTR
        if (!ok) { fprintf(stderr, "kernel_launch: hipFuncSetAttribute failed\n"); grid = -1; return; }
        int dev = 0, cus = 0; (void)hipGetDevice(&dev); (void)hipDeviceGetAttribute(&cus, hipDeviceAttributeMultiprocessorCount, dev);
        grid = cus > 0 ? cus : 256;
    }
    if (grid < 0) return;
    (void)hipMemsetAsync((char*)d_ws + WS_CTL, 0, CTL_ZERO_BYTES, stream);
    Args a{};
    for (int i = 0; i < 25; ++i) a.in[i] = (const float*)d_in[i];
    a.out = (float*)d_out; a.ws = (unsigned char*)d_ws;
#define LAUNCH(p) hipLaunchKernelGGL((fwd_kernel<p, p + 1>), dim3(grid), dim3(NWAVES * 64), LDS_BYTES, stream, a)
    LAUNCH(0); LAUNCH(1); LAUNCH(2); LAUNCH(3); LAUNCH(4); LAUNCH(5); LAUNCH(6); LAUNCH(7); LAUNCH(8); LAUNCH(9); LAUNCH(10); LAUNCH(11); LAUNCH(12); LAUNCH(13);
#undef LAUNCH
}
```

```cpp
#include <hip/hip_runtime.h>
#include <hip/hip_bf16.h>
#include <cstdio>
#include <cstdint>
#include <cmath>

namespace pg8 {
#define PG8_LAS __attribute__((address_space(3)))
typedef unsigned short bf16_t;
typedef short bf16x8 __attribute__((ext_vector_type(8)));
typedef float f32x4 __attribute__((ext_vector_type(4)));
typedef unsigned u32x4 __attribute__((ext_vector_type(4)));
constexpr int BM = 256, BK = 64, HALF = 128, HTB = HALF * BK * 2  , STAGE_BYTES = 8 * HTB, NXCD = 8, WGM = 8;

__host__ __device__ __forceinline__ int lds_byte(int r, int c) { const int st = (r >> 4) * 2 + (c >> 5), rr = r & 15, cc = c & 31, ob = rr * 64 + cc * 2; return st * 1024 + (ob ^ (((ob >> 9) & 1) << 5)); }
__host__ __device__ __forceinline__ void stage_rc(int b, int& R, int& C) { const int st = b / 1024, sb = b % 1024, swz = sb ^ (((sb >> 9) & 1) << 5); R = (st >> 1) * 16 + swz / 64; C = (st & 1) * 32 + (swz % 64) / 2; }
__host__ __device__ __forceinline__ int perm32(int rho) { const int n = rho >> 4, i = rho & 15; return 8 * (i >> 2) + 4 * n + (i & 3); }

struct Unit { int pm, pn; };
struct Gemm { const bf16_t* A; const bf16_t* Bt; int M, N, K; };

struct StaticOrder {
    int nM, nN, nwg, G, c;
    __host__ __device__ void init(int M, int N, int G_, int c_) { nM = M / BM; nN = N / BM; nwg = nM * nN; G = G_; c = c_; }
    __host__ __device__ bool next(int i, Unit& u) const {
        const long L = (long)i * G + c; if (L >= nwg) return false;
        int wgid = (int)L; { const int q = nwg / NXCD, r = nwg % NXCD, xcd = wgid % NXCD, off = wgid / NXCD; wgid = (xcd < r ? xcd * (q + 1) : r * (q + 1) + (xcd - r) * q) + off; }
        const int nig = WGM * nN, gid = wgid / nig, fm = gid * WGM, gsz = (nM - fm) < WGM ? (nM - fm) : WGM;
        u.pm = fm + ((wgid % nig) % gsz); u.pn = (wgid % nig) / gsz; return true;
    }
    __device__ __forceinline__ void a_ready(const Unit&) const {}
    __device__ __forceinline__ void done(const Unit&) const {}
};


__device__ __forceinline__ unsigned cvt_pk_bf16(float lo, float hi) { unsigned r; asm volatile("v_cvt_pk_bf16_f32 %0, %1, %2" : "=v"(r) : "v"(lo), "v"(hi)); return r; }

struct EpiBf16 {
    static constexpr bool PERM = true, AFTER_DRAIN = false;
    bf16_t* O; int ldc; float* gates; int gate_tile;
    __device__ __forceinline__ void operator()(const f32x4 (&acc)[2][2][4][2], const Unit& u, int wr, int wc, int fr, int fq) const {
        const int row0 = u.pm * BM + wr * 64 + fr;
        if (u.pn == gate_tile) {
            if (wc == 0) {
#pragma unroll
                for (int ai = 0; ai < 2; ++ai)
#pragma unroll
                    for (int m = 0; m < 4; ++m) { float* g = gates + (size_t)(row0 + ai * HALF + m * 16) * 32 + 8 * fq;
                        *(f32x4*)(g) = acc[ai][0][m][0]; *(f32x4*)(g + 4) = acc[ai][0][m][1]; }
            }
            return;
        }
        const int col0 = u.pn * BM + wc * 32 + 8 * fq;
#pragma unroll
        for (int ai = 0; ai < 2; ++ai)
#pragma unroll
            for (int m = 0; m < 4; ++m) { bf16_t* rowp = O + (size_t)(row0 + ai * HALF + m * 16) * ldc + col0;
#pragma unroll
                for (int bj = 0; bj < 2; ++bj) { const f32x4 v0 = acc[ai][bj][m][0], v1 = acc[ai][bj][m][1];
                    u32x4 w; w.x = cvt_pk_bf16(v0[0], v0[1]); w.y = cvt_pk_bf16(v0[2], v0[3]); w.z = cvt_pk_bf16(v1[0], v1[1]); w.w = cvt_pk_bf16(v1[2], v1[3]);
                    *(u32x4*)(rowp + bj * HALF) = w; } }
    }
};
struct EpiF32 {
    static constexpr bool PERM = false, AFTER_DRAIN = false;
    float* O; int ldc;
    __device__ __forceinline__ void operator()(const f32x4 (&acc)[2][2][4][2], const Unit& u, int wr, int wc, int fr, int fq) const {
        const int row0 = u.pm * BM + wr * 64 + fr, col0 = u.pn * BM + wc * 32 + 4 * fq;
#pragma unroll
        for (int ai = 0; ai < 2; ++ai)
#pragma unroll
            for (int m = 0; m < 4; ++m) { float* rowp = O + (size_t)(row0 + ai * HALF + m * 16) * ldc + col0;
#pragma unroll
                for (int bj = 0; bj < 2; ++bj)
#pragma unroll
                    for (int n = 0; n < 2; ++n) *(f32x4*)(rowp + bj * HALF + n * 16) = acc[ai][bj][m][n]; }
    }
};

template <class Epi, class Sched, bool ALIGN_EPI = false, bool SP2 = false>
__device__ __forceinline__ void gemm_phase(PG8_LAS unsigned char* lds, const Gemm g, const Sched& S, const Epi& E) {
    int tid_ = threadIdx.x; asm volatile("" : "+v"(tid_));
    const int tid = tid_, wid = __builtin_amdgcn_readfirstlane(tid >> 6), lane = tid & 63, wr = wid >> 2, wc = wid & 3, fr = lane & 15, fq = lane >> 4;
    const int K = g.K, nt = K / BK;
    unsigned voffA[2], voffB[2];
#pragma unroll
    for (int i = 0; i < 2; ++i) { int R, C; stage_rc(tid * 16 + i * 8192, R, C); const int Rb = Epi::PERM ? ((R & ~31) + perm32(R & 31)) : R;
        voffA[i] = (unsigned)(R * K + C) * 2u; voffB[i] = (unsigned)(Rb * K + C) * 2u; }
    const size_t kstep = (size_t)(BK * 2);
    const size_t hstep = (size_t)HALF * K * 2;
    const size_t tstep = 2 * hstep;
    const unsigned ldsw = (unsigned)wid * 1024u;
    const int aoff = lds_byte(wr * 64 + fr, fq * 8), boff = lds_byte(wc * 32 + fr, fq * 8);
#define PG8_SA(b, h) (((b) * 2 + (h)) * HTB)
#define PG8_SB(b, h) ((4 + (b) * 2 + (h)) * HTB)
#define PG8_STAGE(bufoff, gbase, voff) do { _Pragma("unroll") for (int _i = 0; _i < 2; ++_i) \
        __builtin_amdgcn_global_load_lds((const unsigned*)((const char*)(gbase) + (voff)[_i]), (PG8_LAS unsigned*)(lds + (bufoff) + ldsw + _i * 8192), 16, 0, 0); } while (0)
#define PG8_LDA(dst, b, h) do { _Pragma("unroll") for (int m = 0; m < 4; ++m) _Pragma("unroll") for (int k = 0; k < 2; ++k) dst[m][k] = *(const PG8_LAS bf16x8*)(lds + PG8_SA(b, h) + aoff + m * 2048 + k * 1024); } while (0)
#define PG8_LDB(dst, b, h) do { _Pragma("unroll") for (int n = 0; n < 2; ++n) _Pragma("unroll") for (int k = 0; k < 2; ++k) dst[n][k] = *(const PG8_LAS bf16x8*)(lds + PG8_SB(b, h) + boff + n * 2048 + k * 1024); } while (0)
#define PG8_MMA(ai, bj, At, Bt) do { __builtin_amdgcn_s_setprio(1); _Pragma("unroll") for (int m = 0; m < 4; ++m) _Pragma("unroll") for (int n = 0; n < 2; ++n) _Pragma("unroll") for (int k = 0; k < 2; ++k) \
        acc[ai][bj][m][n] = __builtin_amdgcn_mfma_f32_16x16x32_bf16(Bt[n][k], At[m][k], acc[ai][bj][m][n], 0, 0, 0); __builtin_amdgcn_s_setprio(0); } while (0)
#define PG8_WAIT_V(n) asm volatile("s_waitcnt vmcnt(" #n ")" ::: "memory")
#define PG8_WAIT_L(n) asm volatile("s_waitcnt lgkmcnt(" #n ")" ::: "memory")
#define PG8_BAR __builtin_amdgcn_s_barrier()
#define PG8_SCHED __builtin_amdgcn_sched_barrier(0)
    Unit cur, nxt; int ui = 0;
    if (!S.next(0, cur)) return;
    f32x4 acc[2][2][4][2];
#pragma unroll
    for (int a = 0; a < 2; ++a)
#pragma unroll
        for (int b = 0; b < 2; ++b)
#pragma unroll
            for (int m = 0; m < 4; ++m)
#pragma unroll
                for (int n = 0; n < 2; ++n) acc[a][b][m][n] = (f32x4){0.f, 0.f, 0.f, 0.f};
    bf16x8 At[4][2], B0[2][2], B1[2][2];
    const char* cA = (const char*)g.A + (size_t)cur.pm * tstep; const char* cB = (const char*)g.Bt + (size_t)cur.pn * tstep;
    S.a_ready(cur);
    if constexpr (SP2) {
        PG8_STAGE(PG8_SB(0, 0), cB, voffB); PG8_STAGE(PG8_SB(0, 1), cB + hstep, voffB); PG8_STAGE(PG8_SA(0, 0), cA, voffA); PG8_STAGE(PG8_SA(0, 1), cA + hstep, voffA);
        if (wr == 1) PG8_BAR;
        PG8_WAIT_V(2); PG8_BAR;
        PG8_STAGE(PG8_SB(1, 0), cB + kstep, voffB); PG8_STAGE(PG8_SA(1, 0), cA + kstep, voffA); PG8_STAGE(PG8_SB(1, 1), cB + hstep + kstep, voffB);
        PG8_WAIT_V(6); PG8_BAR;
    } else {
        PG8_STAGE(PG8_SB(0, 0), cB, voffB); PG8_STAGE(PG8_SA(0, 0), cA, voffA); PG8_STAGE(PG8_SB(0, 1), cB + hstep, voffB); PG8_STAGE(PG8_SA(0, 1), cA + hstep, voffA);
        if (wr == 1) PG8_BAR;
        PG8_WAIT_V(4); PG8_BAR;
        PG8_STAGE(PG8_SB(1, 0), cB + kstep, voffB); PG8_STAGE(PG8_SA(1, 0), cA + kstep, voffA); PG8_STAGE(PG8_SB(1, 1), cB + hstep + kstep, voffB);
        PG8_WAIT_V(6); PG8_BAR;
    }
    for (;;) {
        const bool has_next = S.next(ui + 1, nxt);
        const char* nA = has_next ? (const char*)g.A + (size_t)nxt.pm * tstep : cA; const char* nB = has_next ? (const char*)g.Bt + (size_t)nxt.pn * tstep : cB;
        for (int t = 0; t < nt; t += 2) {
            const bool last = (t == nt - 2);
            const char* a1 = cA + (size_t)(t + 1) * kstep;
            const char* a2 = last ? nA : cA + (size_t)(t + 2) * kstep; const char* b2 = last ? nB : cB + (size_t)(t + 2) * kstep;
            const char* a3 = a2 + kstep; const char* b3 = b2 + kstep;
            if (last && has_next) S.a_ready(nxt);
            if constexpr (SP2) {
            PG8_LDB(B0, 0, 0); PG8_LDB(B1, 0, 1); PG8_SCHED; PG8_LDA(At, 0, 0); PG8_STAGE(PG8_SA(1, 1), a1 + hstep, voffA);
            PG8_WAIT_V(8); PG8_WAIT_L(0); PG8_BAR; PG8_MMA(0, 0, At, B0); PG8_MMA(0, 1, At, B1); PG8_BAR; PG8_SCHED;
            PG8_LDA(At, 0, 1); PG8_STAGE(PG8_SB(0, 0), b2, voffB); PG8_STAGE(PG8_SB(0, 1), b2 + hstep, voffB); PG8_STAGE(PG8_SA(0, 0), a2, voffA);
            PG8_WAIT_V(8); PG8_WAIT_L(0); PG8_BAR; PG8_MMA(1, 0, At, B0); PG8_MMA(1, 1, At, B1); PG8_BAR; PG8_SCHED;
            PG8_LDB(B0, 1, 0); PG8_LDB(B1, 1, 1); PG8_SCHED; PG8_LDA(At, 1, 0); PG8_STAGE(PG8_SA(0, 1), a2 + hstep, voffA);
            PG8_WAIT_V(8); PG8_WAIT_L(0); PG8_BAR; PG8_MMA(0, 0, At, B0); PG8_MMA(0, 1, At, B1); PG8_BAR; PG8_SCHED;
            PG8_LDA(At, 1, 1); PG8_STAGE(PG8_SB(1, 0), b3, voffB); PG8_STAGE(PG8_SB(1, 1), b3 + hstep, voffB); PG8_STAGE(PG8_SA(1, 0), a3, voffA);
            PG8_WAIT_V(8); PG8_WAIT_L(0); PG8_BAR; PG8_MMA(1, 0, At, B0); PG8_MMA(1, 1, At, B1); PG8_BAR; PG8_SCHED;
            } else {
            PG8_LDB(B0, 0, 0); PG8_SCHED; PG8_LDA(At, 0, 0); PG8_STAGE(PG8_SA(1, 1), a1 + hstep, voffA);
            PG8_WAIT_L(8); PG8_BAR; PG8_WAIT_L(0); PG8_MMA(0, 0, At, B0); PG8_BAR; PG8_SCHED;
            PG8_LDB(B1, 0, 1); PG8_STAGE(PG8_SB(0, 0), b2, voffB);
            PG8_BAR; PG8_WAIT_L(0); PG8_MMA(0, 1, At, B1); PG8_BAR;
            PG8_LDA(At, 0, 1); PG8_STAGE(PG8_SA(0, 0), a2, voffA);
            PG8_BAR; PG8_WAIT_L(0); PG8_MMA(1, 0, At, B0); PG8_BAR; PG8_SCHED;
            PG8_STAGE(PG8_SB(0, 1), b2 + hstep, voffB);
            PG8_WAIT_V(6); PG8_BAR; PG8_MMA(1, 1, At, B1); PG8_BAR;
            PG8_LDB(B0, 1, 0); PG8_SCHED; PG8_LDA(At, 1, 0); PG8_STAGE(PG8_SA(0, 1), a2 + hstep, voffA);
            PG8_WAIT_L(8); PG8_BAR; PG8_WAIT_L(0); PG8_MMA(0, 0, At, B0); PG8_BAR; PG8_SCHED;
            PG8_LDB(B1, 1, 1); PG8_STAGE(PG8_SB(1, 0), b3, voffB);
            PG8_BAR; PG8_WAIT_L(0); PG8_MMA(0, 1, At, B1); PG8_BAR;
            PG8_LDA(At, 1, 1); PG8_STAGE(PG8_SA(1, 0), a3, voffA);
            PG8_BAR; PG8_WAIT_L(0); PG8_MMA(1, 0, At, B0); PG8_BAR; PG8_SCHED;
            PG8_STAGE(PG8_SB(1, 1), b3 + hstep, voffB);
            PG8_WAIT_V(6); PG8_BAR; PG8_MMA(1, 1, At, B1); PG8_BAR;
            }
        }
        if constexpr (ALIGN_EPI) { if (wr == 0) PG8_BAR; }
        if constexpr (!Epi::AFTER_DRAIN) { E(acc, cur, wr, wc, fr, fq); S.done(cur); }
        if (!has_next) break;
#pragma unroll
        for (int a = 0; a < 2; ++a)
#pragma unroll
            for (int b = 0; b < 2; ++b)
#pragma unroll
                for (int m = 0; m < 4; ++m)
#pragma unroll
                    for (int n = 0; n < 2; ++n) acc[a][b][m][n] = (f32x4){0.f, 0.f, 0.f, 0.f};
        cur = nxt; cA = nA; cB = nB; ++ui;
        if constexpr (ALIGN_EPI) { if (wr == 1) PG8_BAR; }
    }
    PG8_WAIT_V(0);
    if constexpr (!ALIGN_EPI) { if (wr == 0) PG8_BAR; }
    PG8_BAR;
    if constexpr (Epi::AFTER_DRAIN) { E.fused(acc, cur, wr, wc, fr, fq, lds, wid, lane); S.done(cur); }
#undef PG8_SA
#undef PG8_SB
#undef PG8_STAGE
#undef PG8_LDA
#undef PG8_LDB
#undef PG8_MMA
#undef PG8_WAIT_V
#undef PG8_WAIT_L
#undef PG8_BAR
#undef PG8_SCHED
}
}


namespace attn {
using bf16x8 = __attribute__((ext_vector_type(8))) short;
using s16x4  = __attribute__((ext_vector_type(4))) short;
using f32x16 = __attribute__((ext_vector_type(16))) float;
using u32x4  = __attribute__((ext_vector_type(4))) unsigned;
typedef unsigned short bf16;
constexpr int NW = 8, QBLK = 32, KVBLK = 64;
constexpr float SCALE = 0.125f;
constexpr float THR = 8.f;
constexpr int SHM_V = KVBLK * 128 * 2, SHM_K = KVBLK * 64 * 2, SHM_ATTN = 2 * SHM_V + 2 * SHM_K + NW * 64 * 4;
#define KSWZ64(row, ch) ((row) * 128 + ((((ch) ^ (((row) >> 1) & 7))) << 4))
#define SBAR() __builtin_amdgcn_sched_barrier(0)
__device__ __forceinline__ int crow(int r, int hi) { return (r & 3) + 8 * (r >> 2) + 4 * hi; }
__device__ __forceinline__ unsigned cvtpk(float lo, float hi) { unsigned r; asm volatile("v_cvt_pk_bf16_f32 %0, %1, %2" : "=v"(r) : "v"(lo), "v"(hi)); return r; }

__device__ __forceinline__ void partialSM(f32x16& p0, f32x16& p1, float& m_reg, float& mn, float& alpha) {
  constexpr float C = SCALE * 1.4426950408889634f;
  float pmax = p0[0];
#pragma unroll
  for (int r = 1; r < 16; ++r) pmax = fmaxf(pmax, p0[r]);
#pragma unroll
  for (int r = 0; r < 16; ++r) pmax = fmaxf(pmax, p1[r]);
  { auto rr = __builtin_amdgcn_permlane32_swap(__float_as_uint(pmax), __float_as_uint(pmax), false, false);
    pmax = fmaxf(__uint_as_float(rr[0]), __uint_as_float(rr[1])); }
  if (__builtin_expect(__all(pmax - m_reg <= THR / SCALE), 1)) { mn = m_reg; alpha = 1.f; }
  else { mn = fmaxf(m_reg, pmax); alpha = __builtin_amdgcn_exp2f((m_reg - mn) * C); m_reg = mn; }
  float mnC = -mn * C;
#pragma unroll
  for (int r = 0; r < 16; ++r) p0[r] = fmaf(p0[r], C, mnC);
#pragma unroll
  for (int r = 0; r < 16; ++r) p1[r] = fmaf(p1[r], C, mnC);
#pragma unroll
  for (int r = 0; r < 16; ++r) p0[r] = __builtin_amdgcn_exp2f(p0[r]);
}
__device__ __forceinline__ void finishSM(f32x16& p0, f32x16& p1, float alpha, float& l_reg, bf16x8& pa0, bf16x8& pa1, bf16x8& pa2, bf16x8& pa3) {
#pragma unroll
  for (int r = 0; r < 16; ++r) p1[r] = __builtin_amdgcn_exp2f(p1[r]);
  float ps = 0;
#pragma unroll
  for (int r = 0; r < 16; ++r) ps += p0[r];
#pragma unroll
  for (int r = 0; r < 16; ++r) ps += p1[r];
  { auto rr = __builtin_amdgcn_permlane32_swap(__float_as_uint(ps), __float_as_uint(ps), false, false);
    ps = __uint_as_float(rr[0]) + __uint_as_float(rr[1]); }
  l_reg = l_reg * alpha + ps;
#define PK4(P, BASE, OUT) do { unsigned a0 = cvtpk(P[BASE + 0], P[BASE + 1]), a1 = cvtpk(P[BASE + 2], P[BASE + 3]);   \
    unsigned b0 = cvtpk(P[BASE + 4], P[BASE + 5]), b1 = cvtpk(P[BASE + 6], P[BASE + 7]);                              \
    auto r0 = __builtin_amdgcn_permlane32_swap(a0, b0, false, false); auto r1 = __builtin_amdgcn_permlane32_swap(a1, b1, false, false); \
    u32x4 w = {r0[0], r1[0], r0[1], r1[1]}; OUT = *reinterpret_cast<bf16x8*>(&w); } while (0)
  PK4(p0, 0, pa0); PK4(p0, 8, pa1); PK4(p1, 0, pa2); PK4(p1, 8, pa3);
#undef PK4
}
__device__ __forceinline__ void qkt(f32x16& p0, f32x16& p1, const char* Ks, const bf16x8* qr, int r32, int hi) {
  p0 = f32x16{}; p1 = f32x16{};
#pragma unroll
  for (int d0 = 0; d0 < 4; ++d0) { const int ch = 2 * d0 + hi;
    bf16x8 b0 = *reinterpret_cast<const bf16x8*>(Ks + KSWZ64(r32, ch));
    bf16x8 b1 = *reinterpret_cast<const bf16x8*>(Ks + KSWZ64(32 + r32, ch));
    p0 = __builtin_amdgcn_mfma_f32_32x32x16_bf16(b0, qr[d0], p0, 0, 0, 0);
    p1 = __builtin_amdgcn_mfma_f32_32x32x16_bf16(b1, qr[d0], p1, 0, 0, 0); }
}
__device__ __forceinline__ int v_st(int k, int c) { const int kk = (k & ~0xC) | ((k & 4) << 1) | ((k & 8) >> 1); return ((kk >> 3) * 4 + (c >> 5)) * 512 + ((kk & 7) * 32 + (c & 31)) * 2; }
__device__ __forceinline__ int v_rd_base(int lane) { return ((lane & 3) << 3) | (((lane >> 2) & 3) << 6) | (((lane >> 4) & 1) << 5) | (((lane >> 5) & 1) << 8); }
constexpr int v_rd_off(int d0, int ks, int half) { return d0 * 512 + ks * 4096 + half * 2048; }
template <int OFF> __device__ __forceinline__ s16x4 tr_read(int vb) {
  s16x4 r; asm volatile("ds_read_b64_tr_b16 %0, %1 offset:%2" : "=&v"(r) : "v"(vb), "i"(OFF) : "memory"); return r;
}
template <int D0> __device__ __forceinline__ void pv_one(f32x16& od, int vb, bf16x8 pa0, bf16x8 pa1, bf16x8 pa2, bf16x8 pa3) {
  const s16x4 l0 = tr_read<v_rd_off(D0, 0, 0)>(vb), h0 = tr_read<v_rd_off(D0, 0, 1)>(vb), l1 = tr_read<v_rd_off(D0, 1, 0)>(vb), h1 = tr_read<v_rd_off(D0, 1, 1)>(vb);
  const s16x4 l2 = tr_read<v_rd_off(D0, 2, 0)>(vb), h2 = tr_read<v_rd_off(D0, 2, 1)>(vb), l3 = tr_read<v_rd_off(D0, 3, 0)>(vb), h3 = tr_read<v_rd_off(D0, 3, 1)>(vb);
  asm volatile("s_waitcnt lgkmcnt(0)" ::: "memory"); SBAR();
#define PK(L, H) (bf16x8){L[0], L[1], L[2], L[3], H[0], H[1], H[2], H[3]}
  od = __builtin_amdgcn_mfma_f32_32x32x16_bf16(pa0, PK(l0, h0), od, 0, 0, 0);
  od = __builtin_amdgcn_mfma_f32_32x32x16_bf16(pa1, PK(l1, h1), od, 0, 0, 0);
  od = __builtin_amdgcn_mfma_f32_32x32x16_bf16(pa2, PK(l2, h2), od, 0, 0, 0);
  od = __builtin_amdgcn_mfma_f32_32x32x16_bf16(pa3, PK(l3, h3), od, 0, 0, 0);
#undef PK
}
__device__ __forceinline__ void pv_d0(f32x16* o, int vb, bf16x8 pa0, bf16x8 pa1, bf16x8 pa2, bf16x8 pa3) {
  pv_one<0>(o[0], vb, pa0, pa1, pa2, pa3); pv_one<1>(o[1], vb, pa0, pa1, pa2, pa3); pv_one<2>(o[2], vb, pa0, pa1, pa2, pa3); pv_one<3>(o[3], vb, pa0, pa1, pa2, pa3);
}

template <int LD>
__device__ __forceinline__ void attn_sub(const bf16* __restrict__ Qb, const bf16* __restrict__ Kh, const bf16* __restrict__ Vh, int NT, char* lds, f32x16 (&o)[4], float (&rli)[16]) {
  int tid_ = threadIdx.x; asm volatile("" : "+v"(tid_));
  const int tid = tid_, wid = tid >> 6, lane = tid & 63, r32 = lane & 31, hi = lane >> 5;
  char* V_lds = lds; char* K_lds = lds + 2 * SHM_V;
  float* ws = (float*)(lds + 2 * SHM_V + 2 * SHM_K) + wid * 64; float* li_l = ws; float* al_l = ws + 32;
  float m_reg = -1e30f, l_reg = 0; bf16x8 qr[4];
#pragma unroll
  for (int d = 0; d < 4; ++d) o[d] = f32x16{};
  const bf16* Qw = Qb + (long)(wid * QBLK + r32) * LD + hi * 8;
#pragma unroll
  for (int d0 = 0; d0 < 4; ++d0) qr[d0] = *reinterpret_cast<const bf16x8*>(Qw + d0 * 16);
  const int sr = tid >> 4, sc = (tid & 15) * 8, vst0 = v_st(sr, sc), vst1 = v_st(32 + sr, sc);
  const int kr = tid >> 3, kc = tid & 7, kst = KSWZ64(kr, kc);
  const int vb0 = (int)(uintptr_t)V_lds + v_rd_base(lane);
  struct { bf16x8 vs0, vs1, ks0; } sr_[2];
#define SLOAD(i, k0) do { sr_[i].vs0 = *reinterpret_cast<const bf16x8*>(&Vh[(long)((k0) + sr) * LD + sc]); sr_[i].vs1 = *reinterpret_cast<const bf16x8*>(&Vh[(long)((k0) + 32 + sr) * LD + sc]); \
    sr_[i].ks0 = *reinterpret_cast<const bf16x8*>(&Kh[(long)((k0) + kr) * LD + kc * 8]); } while (0)
#define SWRITE(b, i) do { *(bf16x8*)(V_lds + (b) * SHM_V + vst0) = sr_[i].vs0; *(bf16x8*)(V_lds + (b) * SHM_V + vst1) = sr_[i].vs1; \
    *(bf16x8*)(K_lds + (b) * SHM_K + kst) = sr_[i].ks0; } while (0)
#define SWAIT() asm volatile("s_waitcnt vmcnt(3)" ::: "memory")
#define RESC(a) do { if (__any((a) < 1.f)) { if (hi == 0) al_l[r32] = (a); asm volatile("s_waitcnt lgkmcnt(0)" ::: "memory"); \
    _Pragma("unroll") for (int d = 0; d < 4; ++d) _Pragma("unroll") for (int r = 0; r < 16; ++r) o[d][r] *= al_l[crow(r, hi)]; } } while (0)
  f32x16 pA0, pA1, pB0, pB1; float mnA, mnB, alA, alB; bf16x8 pa0, pa1, pa2, pa3;
  constexpr int SE = 0, SO = 1;
  SLOAD(SE, 0); asm volatile("s_waitcnt vmcnt(0)" ::: "memory"); SWRITE(0, SE); __syncthreads();
  qkt(pA0, pA1, K_lds, qr, r32, hi); partialSM(pA0, pA1, m_reg, mnA, alA);
  SLOAD(SO, KVBLK); if (2 < NT) SLOAD(SE, 2 * KVBLK);
  SWAIT(); SWRITE(1, SO); __syncthreads();
  for (int j = 1; j + 1 < NT; j += 2) {
    SBAR(); qkt(pB0, pB1, K_lds + SHM_K, qr, r32, hi);
    finishSM(pA0, pA1, alA, l_reg, pa0, pa1, pa2, pa3); SBAR();
    SLOAD(SO, (j + 2) * KVBLK); SBAR();
    pv_d0(o, vb0, pa0, pa1, pa2, pa3); partialSM(pB0, pB1, m_reg, mnB, alB);
    __syncthreads(); SWAIT(); SWRITE(0, SE);
    RESC(alB); __syncthreads();
    SBAR(); qkt(pA0, pA1, K_lds, qr, r32, hi);
    finishSM(pB0, pB1, alB, l_reg, pa0, pa1, pa2, pa3); SBAR();
    if (j + 3 < NT) SLOAD(SE, (j + 3) * KVBLK); SBAR();
    pv_d0(o, vb0 + SHM_V, pa0, pa1, pa2, pa3); partialSM(pA0, pA1, m_reg, mnA, alA);
    __syncthreads(); SWAIT(); SWRITE(1, SO);
    RESC(alA); __syncthreads();
  }
  SBAR(); qkt(pB0, pB1, K_lds + SHM_K, qr, r32, hi);
  finishSM(pA0, pA1, alA, l_reg, pa0, pa1, pa2, pa3); SBAR();
  pv_d0(o, vb0, pa0, pa1, pa2, pa3); partialSM(pB0, pB1, m_reg, mnB, alB);
  __syncthreads(); RESC(alB);
  finishSM(pB0, pB1, alB, l_reg, pa0, pa1, pa2, pa3); SBAR();
  pv_d0(o, vb0 + SHM_V, pa0, pa1, pa2, pa3);
  if (hi == 0) li_l[r32] = l_reg; asm volatile("s_waitcnt lgkmcnt(0)" ::: "memory");
#pragma unroll
  for (int r = 0; r < 16; ++r) rli[r] = __builtin_amdgcn_rcpf(li_l[crow(r, hi)]);
  __syncthreads();
#undef SLOAD
#undef SWRITE
#undef SWAIT
#undef RESC
}
#undef SBAR
}

constexpr int BATCH = 2, SEQ = 8192, DM = 2048, CTX = 256;
constexpr int UROWS_B = CTX + SEQ;
constexpr int UROWS = BATCH * UROWS_B;
constexpr int LROWS = BATCH * SEQ;
constexpr int IN_COLS = 7200, NPAD = 7424, LDP = 7168;
constexpr int DFF = 5632, NUP = 2 * DFF;
constexpr int NMOD = 6 * DM;
constexpr int PC_MQ = 0, PC_MK = 1024, PC_MV = 2048, PC_MO = 3072, PC_DQ = 4096, PC_DK = 5120, PC_DV = 6144;
constexpr float EPS = 1e-6f;
constexpr int KSL = 8;

constexpr size_t MiB = 1u << 20;
constexpr size_t WS_CTL = 0, CTL_ZERO_BYTES = 1 * MiB;
constexpr size_t WS_MODP = 1 * MiB;
constexpr size_t WS_GATES = 3 * MiB;
constexpr size_t WS_WUP = 6 * MiB;
constexpr size_t WS_WDN = 50 * MiB;
constexpr size_t WS_XN = 72 * MiB;
constexpr size_t WS_ARENA = 138 * MiB;
constexpr size_t WS_WIN = WS_ARENA;
constexpr size_t WS_WOUT = WS_ARENA + 29 * MiB;
constexpr size_t WS_P = WS_ARENA + 37 * MiB;
constexpr size_t WS_MIX = WS_ARENA + 268 * MiB;
constexpr size_t WS_ASCR = WS_ARENA + 332 * MiB;
constexpr size_t WS_Y = WS_P;
constexpr size_t WS_U = WS_ARENA;
constexpr size_t WS_HMID = WS_ARENA + 176 * MiB;
constexpr size_t WS_Y2 = WS_ARENA;
constexpr size_t WS_END = WS_ARENA + 364 * MiB;
static_assert(WS_HMID + (size_t)LROWS * DFF * 2 <= WS_END && WS_ASCR + 32 * MiB <= WS_END && WS_MIX >= WS_P + (size_t)UROWS * LDP * 2, "ws map");

constexpr int RING_BYTES = 131072, LDS_BYTES = 147456;
constexpr int LDSCTL_OFF = RING_BYTES, MISC_OFF = LDSCTL_OFF + 320;
constexpr int CW_BAR = 4096;
constexpr int NWAVES = 8;

#define LAS __attribute__((address_space(3)))
typedef unsigned short bf16;
typedef unsigned v4u __attribute__((ext_vector_type(4)));
typedef unsigned v2u __attribute__((ext_vector_type(2)));
typedef float f32x4 __attribute__((ext_vector_type(4)));
typedef short bf16x8 __attribute__((ext_vector_type(8)));

__device__ __forceinline__ unsigned f2bf(float f) { unsigned u = __builtin_bit_cast(unsigned, f); return (u + 0x7fffu + ((u >> 16) & 1u)) >> 16; }
__device__ __forceinline__ unsigned pk2(float lo, float hi) { return f2bf(lo) | (f2bf(hi) << 16); }
__device__ __forceinline__ float bf2f(unsigned short b) { return __builtin_bit_cast(float, (unsigned)b << 16); }
__device__ __forceinline__ float bflo(unsigned w) { return __builtin_bit_cast(float, w << 16); }
__device__ __forceinline__ float bfhi(unsigned w) { return __builtin_bit_cast(float, w & 0xffff0000u); }
__device__ __forceinline__ float wave_sum(float v) {
#pragma unroll
    for (int o = 1; o < 64; o <<= 1) v += __shfl_xor(v, o);
    return v;
}
__device__ __forceinline__ float silu_f(float x) { return x / (1.f + __expf(-x)); }
__device__ __forceinline__ float sigmoid_f(float x) { return 1.f / (1.f + __expf(-x)); }
__device__ __forceinline__ float logsigmoid_f(float x) { return fminf(x, 0.f) - log1pf(__expf(-fabsf(x))); }

struct Frame {
    unsigned char* lds;
    int tid, lane, wave, vcu, G;
    float* out; unsigned char* ws;
};
#define AS4 __attribute__((address_space(4)))
__device__ __forceinline__ const float* inptr(int k) {
    const AS4 char* kp = (const AS4 char*)__builtin_amdgcn_kernarg_segment_ptr();
    asm volatile("" : "+s"(kp));
    return *(const float* const AS4*)(kp + 8 * k);
}
enum { I_X = 0, I_C, I_CTX, I_CCTX, I_WMOD, I_BMOD, I_GPREMIX, I_GPOSTMIX, I_WIN, I_BGATE, I_CONVQKW, I_CONVQKB, I_GMLSTM, I_LQ1, I_LK1, I_LQ2, I_LK2, I_GDIFF, I_WOUT, I_GPREFFN, I_GPOSTFFN, I_WUP, I_CONVFFNW, I_CONVFFNB, I_WDOWN };

__device__ __forceinline__ void transpose_item(const float* W, int K, int N, bf16* WT, int dst_row0, int k0, int n0, float* scr, int lane) {
#pragma unroll 8
    for (int i = 0; i < 32; ++i) { const int kk = 2 * i + (lane >> 5); scr[kk * 33 + (lane & 31)] = W[(size_t)(k0 + kk) * N + n0 + (lane & 31)]; }
    asm volatile("s_waitcnt lgkmcnt(0)" ::: "memory");
    const int c = lane & 7;
#pragma unroll
    for (int j = 0; j < 4; ++j) { const int n = (lane >> 3) + 8 * j; const float* s = scr + (8 * c) * 33 + n;
        v4u o; o.x = pk2(s[0 * 33], s[1 * 33]); o.y = pk2(s[2 * 33], s[3 * 33]); o.z = pk2(s[4 * 33], s[5 * 33]); o.w = pk2(s[6 * 33], s[7 * 33]);
        *(v4u*)(WT + (size_t)(dst_row0 + n) * K + k0 + 8 * c) = o; }
    asm volatile("s_waitcnt lgkmcnt(0)" ::: "memory");
}
__device__ __forceinline__ int win_dst_row(int nb) { return nb < 128 ? 32 * nb : (nb == 128 ? 7168 : 4096 + 32 * (nb - 129)); }

constexpr int MOD_BLOCKS = 48;
__device__ __forceinline__ void p0_prologue(Frame& F) {
    const float* in_w_down = inptr(I_WDOWN); const float* in_c_ctx = inptr(I_CCTX); const float* in_w_mod = inptr(I_WMOD); const float* in_w_out = inptr(I_WOUT); const float* in_w_in = inptr(I_WIN); const float* in_w_up = inptr(I_WUP); const float* in_c = inptr(I_C);
    const int blk = blockIdx.x;
    if (blk < MOD_BLOCKS) {
        const int id = blk * 512 + F.tid;
        const int jq = id % 3072, ks = id / 3072;
        f32x4 a0 = {0, 0, 0, 0}, a1 = a0, a2 = a0;
        const float* wp = in_w_mod + (size_t)(ks * 256) * NMOD + 4 * jq;
#pragma unroll 8
        for (int k = 0; k < 256; ++k) {
            const f32x4 w = *(const f32x4*)(wp + (size_t)k * NMOD);
            const int kk = ks * 256 + k;
            const float s0 = silu_f(in_c[kk]), s1 = silu_f(in_c[DM + kk]), s2 = silu_f(in_c_ctx[kk]);
            a0 += w * s0; a1 += w * s1; a2 += w * s2;
        }
        float* mp = (float*)(F.ws + WS_MODP);
        *(f32x4*)(mp + (size_t)(ks * 3 + 0) * NMOD + 4 * jq) = a0;
        *(f32x4*)(mp + (size_t)(ks * 3 + 1) * NMOD + 4 * jq) = a1;
        *(f32x4*)(mp + (size_t)(ks * 3 + 2) * NMOD + 4 * jq) = a2;
        return;
    }
    float* scr = (float*)(F.lds) + F.wave * 2112;
    const int gw = (blk - MOD_BLOCKS) * NWAVES + F.wave, NGW = (F.G - MOD_BLOCKS) * NWAVES;
    constexpr int I_IN = (DM / 64) * (IN_COLS / 32), I_OUT = (DM / 64) * (DM / 32), I_UP = (DM / 64) * (NUP / 32), I_DN = (DFF / 64) * (DM / 32);
    bf16* win_t = (bf16*)(F.ws + WS_WIN); bf16* wout_t = (bf16*)(F.ws + WS_WOUT); bf16* wup_t = (bf16*)(F.ws + WS_WUP); bf16* wdn_t = (bf16*)(F.ws + WS_WDN);
    for (int it = gw; it < I_IN + I_OUT + I_UP + I_DN; it += NGW) {
        int r = it;
        if (r < I_IN) { const int nblk = IN_COLS / 32, kb = r / nblk, nb = r % nblk; transpose_item(in_w_in, DM, IN_COLS, win_t, win_dst_row(nb), 64 * kb, 32 * nb, scr, F.lane); continue; } r -= I_IN;
        if (r < I_OUT) { const int nblk = DM / 32, kb = r / nblk, nb = r % nblk; transpose_item(in_w_out, DM, DM, wout_t, 32 * nb, 64 * kb, 32 * nb, scr, F.lane); continue; } r -= I_OUT;
        if (r < I_UP) { const int nblk = NUP / 32, kb = r / nblk, nb = r % nblk; transpose_item(in_w_up, DM, NUP, wup_t, 32 * nb, 64 * kb, 32 * nb, scr, F.lane); continue; } r -= I_UP;
        { const int nblk = DM / 32, kb = r / nblk, nb = r % nblk; transpose_item(in_w_down, DFF, DM, wdn_t, 32 * nb, 64 * kb, 32 * nb, scr, F.lane); }
    }
    { v4u* z = (v4u*)(win_t + (size_t)7200 * DM); const int n16 = 224 * DM * 2 / 16; const v4u zero = {0, 0, 0, 0};
      for (int i = (blk - MOD_BLOCKS) * 512 + F.tid; i < n16; i += (F.G - MOD_BLOCKS) * 512) z[i] = zero; }
}

__device__ __forceinline__ void load_mod(Frame& F, float* dst, int v, int col0, int n) {
    const float* in_b_mod = inptr(I_BMOD);
    const float* mp = (const float*)(F.ws + WS_MODP);
    for (int j = F.tid; j < n; j += 512) { float s = in_b_mod[col0 + j];
#pragma unroll
        for (int ks = 0; ks < KSL; ++ks) s += mp[(size_t)(ks * 3 + v) * NMOD + col0 + j];
        dst[j] = s; }
}

__device__ __forceinline__ void p1_xn(Frame& F) {
    const float* in_g_pre_mix = inptr(I_GPREMIX); const float* in_ctx = inptr(I_CTX); const float* in_x = inptr(I_X);
    float* modl = (float*)F.lds;
    for (int v = 0; v < 3; ++v) load_mod(F, modl + v * 4096, v, 0, 4096);
    __syncthreads();
    bf16* XN = (bf16*)(F.ws + WS_XN);
    const int gw = F.vcu * NWAVES + F.wave, NGW = F.G * NWAVES;
    for (int row = gw; row < UROWS; row += NGW) {
        const int b = row / UROWS_B, s = row % UROWS_B;
        const float* src = s < CTX ? in_ctx + ((size_t)b * CTX + s) * DM : in_x + ((size_t)b * SEQ + (s - CTX)) * DM;
        const float* mv = modl + (s < CTX ? 2 : b) * 4096;
        const f32x4* xr = (const f32x4*)src + F.lane;
        f32x4 v[8]; float ss = 0.f;
#pragma unroll
        for (int j = 0; j < 8; ++j) { v[j] = xr[64 * j]; ss += (v[j].x * v[j].x + v[j].y * v[j].y) + (v[j].z * v[j].z + v[j].w * v[j].w); }
        const float rstd = rsqrtf(wave_sum(ss) * (1.f / DM) + EPS);
        v2u* o8 = (v2u*)(XN + (size_t)row * DM) + F.lane;
#pragma unroll
        for (int j = 0; j < 8; ++j) { const int c0 = 4 * (64 * j + F.lane);
            const f32x4 g = *(const f32x4*)(in_g_pre_mix + c0), sh = *(const f32x4*)(mv + c0), sc = *(const f32x4*)(mv + 2048 + c0);
            const f32x4 y = (v[j] * rstd * g) * (sc + 1.f) + sh;
            v2u w; w.x = pk2(y.x, y.y); w.y = pk2(y.z, y.w); o8[64 * j] = w; }
    }
}

__device__ __forceinline__ void p3_rope(Frame& F) {
    float* ct = (float*)F.lds; float* st = ct + 2048;
    for (int i = F.tid; i < 2048; i += 512) { const int pos = i >> 4, f = i & 15; const float inv = powf(10000.f, -(float)f / 16.f); const float ang = (float)pos * inv; ct[i] = cosf(ang); st[i] = sinf(ang); }
    __syncthreads();
    bf16* P = (bf16*)(F.ws + WS_P);
    const int gw = F.vcu * NWAVES + F.wave, NGW = F.G * NWAVES;
    for (int lr = gw; lr < LROWS; lr += NGW) {
        const int b = lr / SEQ, t = lr % SEQ;
        const int pos = (F.lane & 1) ? (t & 63) : (t >> 6);
        bf16* p = P + (size_t)(b * UROWS_B + CTX + t) * LDP + PC_DQ + 32 * F.lane;
        v4u w[4];
#pragma unroll
        for (int i = 0; i < 4; ++i) w[i] = *(const v4u*)(p + 8 * i);
        v4u o[4];
#pragma unroll
        for (int q = 0; q < 2; ++q)
#pragma unroll
            for (int e = 0; e < 4; ++e) { const int f = 8 * q + 2 * e; const unsigned a = w[q][e], bb = w[2 + q][e];
                const float c0 = ct[pos * 16 + f], s0 = st[pos * 16 + f], c1 = ct[pos * 16 + f + 1], s1 = st[pos * 16 + f + 1];
                const float x0l = bflo(a), x0h = bfhi(a), x1l = bflo(bb), x1h = bfhi(bb);
                o[q][e] = pk2(x0l * c0 - x1l * s0, x0h * c1 - x1h * s1);
                o[2 + q][e] = pk2(x1l * c0 + x0l * s0, x1h * c1 + x0h * s1); }
#pragma unroll
        for (int i = 0; i < 4; ++i) *(v4u*)(p + 8 * i) = o[i];
    }
}

__device__ __forceinline__ void p4_mlstm_simple(Frame& F) {
    const float* in_conv_qk_w = inptr(I_CONVQKW); const float* in_conv_qk_b = inptr(I_CONVQKB); const float* in_g_mlstm = inptr(I_GMLSTM); const float* in_b_gate = inptr(I_BGATE);
    if (blockIdx.x >= BATCH * 8) return;
    const int b = blockIdx.x >> 3, h = blockIdx.x & 7, tid = F.tid;
    float* qs = (float*)F.lds; float* ks = qs + 4096; float* vs = ks + 4096; float* tot = vs + 4096;
    float* gi = tot + 4096; float* gf = gi + 32; float* pnum = gf + 32; float* den = pnum + 512;
    const bf16* P = (const bf16*)(F.ws + WS_P); const float* GT = (const float*)(F.ws + WS_GATES);
    float* HF = (float*)(F.ws + WS_XN); bf16* MIX = (bf16*)(F.ws + WS_MIX);
    for (int dir = 0; dir < 2; ++dir) {
        float C[64]; float n0 = 0.f, n1 = 0.f, m = 0.f;
#pragma unroll
        for (int i = 0; i < 64; ++i) C[i] = 0.f;
        for (int seg = 0; seg < 2; ++seg) {
            const int len = seg ? SEQ : CTX, rowbase = b * UROWS_B + (seg ? CTX : 0);
            for (int jb = 0; jb < len / 32; ++jb) {
                __syncthreads();
#pragma unroll 4
                for (int i = 0; i < 16; ++i) { const int idx = tid + 512 * i, tau = idx >> 8, ch = idx & 255, qk = ch >> 7, d = ch & 127;
                    const int pos = dir ? len - 1 - (jb * 32 + tau) : jb * 32 + tau;
                    const int col = (qk ? PC_MK : PC_MQ) + h * 128 + d, cw = qk * 1024 + h * 128 + d;
                    const float rm = pos > 0 ? bf2f(P[(size_t)(rowbase + pos - 1) * LDP + col]) : 0.f, r0 = bf2f(P[(size_t)(rowbase + pos) * LDP + col]),
                                rp = pos < len - 1 ? bf2f(P[(size_t)(rowbase + pos + 1) * LDP + col]) : 0.f;
                    float val = silu_f(in_conv_qk_w[cw] * rm + in_conv_qk_w[2048 + cw] * r0 + in_conv_qk_w[4096 + cw] * rp + in_conv_qk_b[cw]);
                    if (qk) { ks[tau * 128 + d] = val * 0.08838834764831845f; } else { qs[tau * 128 + d] = val; } }
#pragma unroll 4
                for (int i = 0; i < 8; ++i) { const int idx = tid + 512 * i, tau = idx >> 7, e = idx & 127; const int pos = dir ? len - 1 - (jb * 32 + tau) : jb * 32 + tau;
                    vs[tau * 128 + e] = bf2f(P[(size_t)(rowbase + pos) * LDP + PC_MV + h * 128 + e]); }
                if (tid < 32) { const int pos = dir ? len - 1 - (jb * 32 + tid) : jb * 32 + tid; const float* g = GT + (size_t)(rowbase + pos) * 32;
                    gi[tid] = g[(dir * 2) * 8 + h] + in_b_gate[(dir * 2) * 8 + h];
                    gf[tid] = logsigmoid_f(g[(dir * 2 + 1) * 8 + h] + in_b_gate[(dir * 2 + 1) * 8 + h]); }
                __syncthreads();
                for (int tau = 0; tau < 32; ++tau) {
                    const float ig = gi[tau], lf = gf[tau]; const float mn = fmaxf(lf + m, ig); const float fdec = __expf(lf + m - mn), iw = __expf(ig - mn); m = mn;
                    const int par = tau & 1;
                    if (tid < 256) { const int e = tid & 127, dh = tid >> 7; const float ve = vs[tau * 128 + e] * iw; float pn = 0.f;
                        const f32x4* k4 = (const f32x4*)(ks + tau * 128 + dh * 64); const f32x4* q4 = (const f32x4*)(qs + tau * 128 + dh * 64);
#pragma unroll
                        for (int d4 = 0; d4 < 16; ++d4) { const f32x4 kk = k4[d4], qq = q4[d4];
                            C[4 * d4 + 0] = fdec * C[4 * d4 + 0] + ve * kk.x; pn += qq.x * C[4 * d4 + 0];
                            C[4 * d4 + 1] = fdec * C[4 * d4 + 1] + ve * kk.y; pn += qq.y * C[4 * d4 + 1];
                            C[4 * d4 + 2] = fdec * C[4 * d4 + 2] + ve * kk.z; pn += qq.z * C[4 * d4 + 2];
                            C[4 * d4 + 3] = fdec * C[4 * d4 + 3] + ve * kk.w; pn += qq.w * C[4 * d4 + 3]; }
                        pnum[(par * 2 + dh) * 128 + e] = pn;
                    } else if (F.wave == 4) { const int l = F.lane;
                        n0 = fdec * n0 + iw * ks[tau * 128 + 2 * l]; n1 = fdec * n1 + iw * ks[tau * 128 + 2 * l + 1];
                        const float dp = wave_sum(qs[tau * 128 + 2 * l] * n0 + qs[tau * 128 + 2 * l + 1] * n1);
                        if (l == 0) den[par] = dp; }
                    __syncthreads();
                    if (seg == 1 && tid < 128) { const float num = pnum[(par * 2) * 128 + tid] + pnum[(par * 2 + 1) * 128 + tid]; const float dn = den[par];
                        const float hv = num / fmaxf(fabsf(dn), __expf(-m));
                        const int pos = dir ? len - 1 - (jb * 32 + tau) : jb * 32 + tau; float* hp = HF + (size_t)(b * SEQ + pos) * 1024 + h * 128 + tid;
                        if (dir == 0) *hp = hv; else tot[tau * 128 + tid] = *hp + hv; }
                }
                if (seg == 1 && dir == 1) {
                    __syncthreads();
                    for (int q = 0; q < 4; ++q) { const int tau = F.wave * 4 + q, pos = len - 1 - (jb * 32 + tau);
                        const float t0 = tot[tau * 128 + F.lane], t1 = tot[tau * 128 + 64 + F.lane];
                        const float r = rsqrtf(wave_sum(t0 * t0 + t1 * t1) * (1.f / 128.f) + EPS);
                        const bf16* og = P + (size_t)(rowbase + pos) * LDP + PC_MO + h * 128; bf16* mo = MIX + (size_t)(b * SEQ + pos) * DM + h * 128;
                        mo[F.lane] = (bf16)f2bf(t0 * r * in_g_mlstm[h * 128 + F.lane] * sigmoid_f(bf2f(og[F.lane])));
                        mo[64 + F.lane] = (bf16)f2bf(t1 * r * in_g_mlstm[h * 128 + 64 + F.lane] * sigmoid_f(bf2f(og[64 + F.lane]))); }
                }
            }
        }
    }
}

__device__ __forceinline__ void p5_attn(Frame& F) {
    const float* in_g_diff = inptr(I_GDIFF); const float* in_lq1 = inptr(I_LQ1); const float* in_lk1 = inptr(I_LK1); const float* in_lq2 = inptr(I_LQ2); const float* in_lk2 = inptr(I_LK2);
    using namespace attn;
    float lam;
    { float s1 = 0.f, s2 = 0.f; for (int i = 0; i < 64; ++i) { s1 += in_lq1[i] * in_lk1[i]; s2 += in_lq2[i] * in_lk2[i]; } lam = expf(s1) - expf(s2) + 0.2f; }
    const attn::bf16* P = (const attn::bf16*)(F.ws + WS_P); ::bf16* MIX = (::bf16*)(F.ws + WS_MIX);
    float* scr0 = F.out;
    const int tid = F.tid, wid = tid >> 6, lane = tid & 63, r32 = lane & 31, hi = lane >> 5;
#pragma unroll 1
    for (int u = blockIdx.x; u < BATCH * 8 * (SEQ / 256); u += F.G) {
        const int qb = u % (SEQ / 256), bh = u / (SEQ / 256), b = bh >> 3, h = bh & 7;
        const attn::bf16* Pb = P + (size_t)(b * UROWS_B) * LDP;
#pragma unroll 1
        for (int c = 0; c < 2; ++c) {
            f32x16 o[4]; float rli[16];
            attn_sub<LDP>(Pb + (size_t)(CTX + qb * 256) * LDP + PC_DQ + h * 128 + c * 64, Pb + PC_DK + h * 128 + c * 64, Pb + PC_DV + h * 128, UROWS_B / 64, (char*)F.lds, o, rli);
            for (int d0 = 0; d0 < 4; ++d0) for (int r = 0; r < 16; ++r) scr0[(d0 * 16 + r) * 512 + tid + blockIdx.x * 65536 + c * 32768] = o[d0][r] * rli[r];
        }
        const float* s1p = scr0 + (size_t)blockIdx.x * 65536 + tid; const float* s2p = s1p + 32768;
        ::bf16* mo = MIX + (size_t)(b * SEQ + qb * 256 + wid * 32) * DM + 1024 + h * 128 + r32;
        const float g0 = in_g_diff[r32] * 0.8f, g1 = in_g_diff[32 + r32] * 0.8f, g2 = in_g_diff[64 + r32] * 0.8f, g3 = in_g_diff[96 + r32] * 0.8f;
#pragma unroll 2
        for (int r = 0; r < 16; ++r) {
            const float v0 = s1p[(0 * 16 + r) * 512] - lam * s2p[(0 * 16 + r) * 512], v1 = s1p[(1 * 16 + r) * 512] - lam * s2p[(1 * 16 + r) * 512],
                        v2 = s1p[(2 * 16 + r) * 512] - lam * s2p[(2 * 16 + r) * 512], v3 = s1p[(3 * 16 + r) * 512] - lam * s2p[(3 * 16 + r) * 512];
            float ss = (v0 * v0 + v1 * v1) + (v2 * v2 + v3 * v3);
#pragma unroll
            for (int off = 1; off < 32; off <<= 1) ss += __shfl_xor(ss, off);
            const float rs = rsqrtf(ss * (1.f / 128.f) + EPS);
            ::bf16* mr = mo + (size_t)((r & 3) + 8 * (r >> 2) + 4 * hi) * DM;
            mr[0] = (::bf16)f2bf(v0 * rs * g0); mr[32] = (::bf16)f2bf(v1 * rs * g1); mr[64] = (::bf16)f2bf(v2 * rs * g2); mr[96] = (::bf16)f2bf(v3 * rs * g3);
        }
    }
}

__device__ __forceinline__ void p7_x1(Frame& F) {
    const float* in_g_post_mix = inptr(I_GPOSTMIX); const float* in_g_pre_ffn = inptr(I_GPREFFN); const float* in_x = inptr(I_X);
    float* modl = (float*)F.lds;
    for (int b = 0; b < 2; ++b) { load_mod(F, modl + (b * 3 + 0) * 2048, b, 2 * DM, 2048); load_mod(F, modl + (b * 3 + 1) * 2048, b, 3 * DM, 2048); load_mod(F, modl + (b * 3 + 2) * 2048, b, 4 * DM, 2048); }
    __syncthreads();
    const float* Y = (const float*)(F.ws + WS_Y); bf16* XN2 = (bf16*)(F.ws + WS_XN);
    const int gw = F.vcu * NWAVES + F.wave, NGW = F.G * NWAVES;
    for (int row = gw; row < LROWS; row += NGW) {
        const int b = row / SEQ; const float* mv = modl + b * 3 * 2048;
        const f32x4* yr = (const f32x4*)(Y + (size_t)row * DM) + F.lane; const f32x4* xr = (const f32x4*)(in_x + (size_t)row * DM) + F.lane;
        f32x4 v[8]; float ss = 0.f;
#pragma unroll
        for (int j = 0; j < 8; ++j) { v[j] = yr[64 * j]; ss += (v[j].x * v[j].x + v[j].y * v[j].y) + (v[j].z * v[j].z + v[j].w * v[j].w); }
        const float rstd = rsqrtf(wave_sum(ss) * (1.f / DM) + EPS);
        float s2 = 0.f; f32x4* orow = (f32x4*)(F.out + (size_t)row * DM) + F.lane;
#pragma unroll
        for (int j = 0; j < 8; ++j) { const int c0 = 4 * (64 * j + F.lane);
            const f32x4 g = *(const f32x4*)(in_g_post_mix + c0), ga = *(const f32x4*)(mv + c0);
            v[j] = xr[64 * j] + ga * (v[j] * rstd * g); orow[64 * j] = v[j];
            s2 += (v[j].x * v[j].x + v[j].y * v[j].y) + (v[j].z * v[j].z + v[j].w * v[j].w); }
        const float rstd2 = rsqrtf(wave_sum(s2) * (1.f / DM) + EPS);
        v2u* o8 = (v2u*)(XN2 + (size_t)row * DM) + F.lane;
#pragma unroll
        for (int j = 0; j < 8; ++j) { const int c0 = 4 * (64 * j + F.lane);
            const f32x4 g = *(const f32x4*)(in_g_pre_ffn + c0), sh = *(const f32x4*)(mv + 2048 + c0), sc = *(const f32x4*)(mv + 4096 + c0);
            const f32x4 y = (v[j] * rstd2 * g) * (sc + 1.f) + sh;
            v2u w; w.x = pk2(y.x, y.y); w.y = pk2(y.z, y.w); o8[64 * j] = w; }
    }
}

__device__ __forceinline__ void p9_convact(Frame& F, int b) {
    const float* in_conv_ffn_w = inptr(I_CONVFFNW); const float* in_conv_ffn_b = inptr(I_CONVFFNB);
    const bf16* U = (const bf16*)(F.ws + WS_U); bf16* HM = (bf16*)(F.ws + WS_HMID) + (size_t)b * SEQ * DFF;
    const int nj = DFF / 8;
    for (long it = (long)blockIdx.x * 512 + F.tid; it < (long)SEQ * nj; it += (long)F.G * 512) {
        const int t = (int)(it / nj), j0 = (int)(it % nj) * 8;
        float accg[8], accv[8];
#pragma unroll
        for (int e = 0; e < 8; ++e) { accg[e] = in_conv_ffn_b[j0 + e]; accv[e] = in_conv_ffn_b[DFF + j0 + e]; }
#pragma unroll
        for (int dt = 0; dt < 3; ++dt) { const int tt = t + dt - 1; if (tt < 0 || tt >= SEQ) continue;
            const v4u g = *(const v4u*)(U + (size_t)tt * NUP + j0), v = *(const v4u*)(U + (size_t)tt * NUP + DFF + j0);
            const float* wg = in_conv_ffn_w + (size_t)dt * NUP + j0; const float* wv = wg + DFF;
#pragma unroll
            for (int e = 0; e < 4; ++e) { accg[2 * e] += wg[2 * e] * bflo(g[e]); accg[2 * e + 1] += wg[2 * e + 1] * bfhi(g[e]); accv[2 * e] += wv[2 * e] * bflo(v[e]); accv[2 * e + 1] += wv[2 * e + 1] * bfhi(v[e]); } }
        v4u o;
#pragma unroll
        for (int e = 0; e < 4; ++e) o[e] = pk2(silu_f(accg[2 * e]) * accv[2 * e], silu_f(accg[2 * e + 1]) * accv[2 * e + 1]);
        *(v4u*)(HM + (size_t)t * DFF + j0) = o;
    }
}

__device__ __forceinline__ void p13_final(Frame& F) {
    const float* in_g_post_ffn = inptr(I_GPOSTFFN);
    float* modl = (float*)F.lds;
    for (int b = 0; b < 2; ++b) load_mod(F, modl + b * 2048, b, 5 * DM, 2048);
    __syncthreads();
    const float* Y2 = (const float*)(F.ws + WS_Y2);
    const int gw = F.vcu * NWAVES + F.wave, NGW = F.G * NWAVES;
    for (int row = gw; row < LROWS; row += NGW) {
        const int b = row / SEQ; const float* mv = modl + b * 2048;
        const f32x4* yr = (const f32x4*)(Y2 + (size_t)row * DM) + F.lane; f32x4* orow = (f32x4*)(F.out + (size_t)row * DM) + F.lane;
        f32x4 v[8]; float ss = 0.f;
#pragma unroll
        for (int j = 0; j < 8; ++j) { v[j] = yr[64 * j]; ss += (v[j].x * v[j].x + v[j].y * v[j].y) + (v[j].z * v[j].z + v[j].w * v[j].w); }
        const float rstd = rsqrtf(wave_sum(ss) * (1.f / DM) + EPS);
#pragma unroll
        for (int j = 0; j < 8; ++j) { const int c0 = 4 * (64 * j + F.lane);
            const f32x4 g = *(const f32x4*)(in_g_post_ffn + c0), ga = *(const f32x4*)(mv + c0);
            orow[64 * j] = orow[64 * j] + ga * (v[j] * rstd * g); }
    }
}


#define GAS __attribute__((address_space(1)))
typedef GAS unsigned gu32;
#define RLX_AGENT __ATOMIC_RELAXED, __HIP_MEMORY_SCOPE_AGENT
#define XB_TMO      128
#define XB_XCNT(j)  (256  + 64 * (j))
#define XB_XSUB(j)  (1280 + 64 * (j))
#define XB_XGEN(j)  (2304 + 64 * (j))
#define XB_TOP      3328
#define XB_TOPGEN   3392
#define XCD_BAR_WORDS 3456
#define XB_SPIN_CAP (1u << 25)

__device__ __forceinline__ unsigned xb_ld(unsigned* p)              { return __hip_atomic_load(p, __ATOMIC_RELAXED, __HIP_MEMORY_SCOPE_AGENT); }
__device__ __forceinline__ unsigned xb_add(unsigned* p, unsigned v) { return __hip_atomic_fetch_add(p, v, __ATOMIC_RELAXED, __HIP_MEMORY_SCOPE_AGENT); }
__device__ __forceinline__ unsigned xb_xcc_id() { return (unsigned)__builtin_amdgcn_s_getreg((3 << 11) | 20) & 0xFu; }
#define XB_SPIN(cond, bar) do { unsigned _sp = 0; while (cond) { __builtin_amdgcn_s_sleep(1); \
    if ((++_sp & 255u) == 0u) { if (xb_ld(&(bar)[XB_TMO])) break; if (_sp > XB_SPIN_CAP) { atomicAdd(&(bar)[XB_TMO], 1u); break; } } } } while (0)

struct XcdBarrier {
    unsigned* bar; unsigned x;
    volatile LAS unsigned* st;
};

__device__ __forceinline__ XcdBarrier xcd_barrier_post(unsigned* bar, volatile LAS unsigned* st) {
    XcdBarrier b; b.bar = bar; b.x = xb_xcc_id(); b.st = st;
    if (threadIdx.x == 0) (void)xb_add(&bar[XB_XCNT(b.x)], 1u);
    return b;
}
__device__ __forceinline__ void xcd_barrier_complete(unsigned* bar, unsigned x, unsigned& nloc, unsigned& nx) {
    const unsigned G = gridDim.x * gridDim.y * gridDim.z;
    unsigned sum, cnt, mine, sp = 0u;
    for (;;) {
        sum = 0u; cnt = 0u; mine = 0u;
#pragma unroll
        for (unsigned j = 0; j < 16; ++j) { const unsigned c = xb_ld(&bar[XB_XCNT(j)]); sum += c; cnt += (c > 0u) ? 1u : 0u; mine = (j == x) ? c : mine; }
        if (sum == G) break;
        __builtin_amdgcn_s_sleep(1);
        if ((++sp & 255u) == 0u) { if (xb_ld(&bar[XB_TMO])) break; if (sp > XB_SPIN_CAP) { atomicAdd(&bar[XB_TMO], 1u); break; } }
    }
    nloc = mine > 0u ? mine : 1u; nx = cnt > 0u ? cnt : 1u;
}

__device__ __forceinline__ void xcd_barrier(const XcdBarrier& b) {
    asm volatile("s_waitcnt vmcnt(0)" ::: "memory");
    __syncthreads();
    if (threadIdx.x == 0) {
        unsigned* bar = b.bar;
        __builtin_amdgcn_s_waitcnt(0);
        unsigned nloc = b.st[0], nx = b.st[1];
        if (nloc == 0u) { xcd_barrier_complete(bar, b.x, nloc, nx); b.st[0] = nloc; b.st[1] = nx; }
        const unsigned old = xb_add(&bar[XB_XSUB(b.x)], 1u);
        const unsigned gen = old / nloc;
        if (old + 1u == (gen + 1u) * nloc) {
            __builtin_amdgcn_fence(__ATOMIC_RELEASE, "agent");
            asm volatile("s_waitcnt vmcnt(0)" ::: "memory");
            const unsigned og = xb_add(&bar[XB_TOP], 1u);
            const unsigned tg = og / nx;
            if (og + 1u == (tg + 1u) * nx) xb_add(&bar[XB_TOPGEN], 1u);
            else XB_SPIN(xb_ld(&bar[XB_TOPGEN]) == tg, bar);
            __builtin_amdgcn_fence(__ATOMIC_ACQUIRE, "agent");
            xb_add(&bar[XB_XGEN(b.x)], 1u);
            asm volatile("s_waitcnt vmcnt(0)" ::: "memory");
        } else {
            XB_SPIN(xb_ld(&bar[XB_XGEN(b.x)]) == gen, bar);
            __builtin_amdgcn_fence(__ATOMIC_ACQUIRE, "agent");
            asm volatile("s_waitcnt vmcnt(0)" ::: "memory");
        }
    }
    __syncthreads();
}


#ifndef MK_N_LAUNCHES
#define MK_N_LAUNCHES 1
#endif
constexpr int N_PHASES = 14;
struct Args { const float* in[25]; float* out; unsigned char* ws; int ph_lo, ph_hi; };
template <int PH_LO, int PH_HI>
__global__ void __launch_bounds__(NWAVES * 64, 2) fwd_kernel(Args args) {
    extern __shared__ __attribute__((aligned(16))) unsigned char lds[];
    Frame F;
    F.lds = lds; F.tid = threadIdx.x; F.lane = F.tid & 63; F.wave = __builtin_amdgcn_readfirstlane(F.tid >> 6);
    F.G = gridDim.x; { const int bx = blockIdx.x; F.vcu = (F.G % 8 == 0) ? (bx % 8) * (F.G / 8) + bx / 8 : bx; }
    F.out = args.out; F.ws = args.ws;
    constexpr int lo = PH_LO, hi = PH_HI;
    PG8_LAS unsigned char* ring = (PG8_LAS unsigned char*)lds;
    XcdBarrier bar; bar.bar = nullptr; bar.x = 0; bar.st = nullptr;
    if constexpr (hi - lo > 1) {
        for (int u = F.tid; u < (LDS_BYTES - LDSCTL_OFF) / 4; u += NWAVES * 64) ((LAS unsigned*)((LAS unsigned char*)lds + LDSCTL_OFF))[u] = 0u;
        __syncthreads();
        bar = xcd_barrier_post((unsigned*)(F.ws + WS_CTL) + CW_BAR, (volatile LAS unsigned*)((LAS unsigned char*)lds + MISC_OFF) + 8);
    }
#define IN(k) (lo <= (k) && (k) < hi)
#define SEAM(k) do { if constexpr (IN(k) && IN((k) + 1)) xcd_barrier(bar); } while (0)
    if constexpr (IN(0)) p0_prologue(F);
    SEAM(0);
    if constexpr (IN(1)) p1_xn(F);
    SEAM(1);
    if constexpr (IN(2)) { pg8::Gemm g{(const pg8::bf16_t*)(F.ws + WS_XN), (const pg8::bf16_t*)(F.ws + WS_WIN), UROWS, NPAD, DM}; pg8::StaticOrder S; S.init(UROWS, NPAD, F.G, (int)blockIdx.x);
        pg8::EpiBf16 E{(pg8::bf16_t*)(F.ws + WS_P), LDP, (float*)(F.ws + WS_GATES), LDP / 256};
        pg8::gemm_phase<pg8::EpiBf16, pg8::StaticOrder, true, true>(ring, g, S, E); }
    SEAM(2);
    if constexpr (IN(3)) p3_rope(F);
    SEAM(3);
    if constexpr (IN(4)) p4_mlstm_simple(F);
    SEAM(4);
    if constexpr (IN(5)) p5_attn(F);
    SEAM(5);
    if constexpr (IN(6)) { pg8::Gemm g{(const pg8::bf16_t*)(F.ws + WS_MIX), (const pg8::bf16_t*)(F.ws + WS_WOUT), LROWS, DM, DM}; pg8::StaticOrder S; S.init(LROWS, DM, F.G, (int)blockIdx.x);
        pg8::EpiF32 E{(float*)(F.ws + WS_Y), DM};
        pg8::gemm_phase<pg8::EpiF32, pg8::StaticOrder, true, true>(ring, g, S, E); }
    SEAM(6);
    if constexpr (IN(7)) p7_x1(F);
    SEAM(7);
    if constexpr (IN(8)) { pg8::Gemm g{(const pg8::bf16_t*)(F.ws + WS_XN), (const pg8::bf16_t*)(F.ws + WS_WUP), SEQ, NUP, DM}; pg8::StaticOrder S; S.init(SEQ, NUP, F.G, (int)blockIdx.x);
        pg8::EpiBf16 E{(pg8::bf16_t*)(F.ws + WS_U), NUP, nullptr, -1};
        pg8::gemm_phase<pg8::EpiBf16, pg8::StaticOrder, true, true>(ring, g, S, E); }
    SEAM(8);
    if constexpr (IN(9)) p9_convact(F, 0);
    SEAM(9);
    if constexpr (IN(10)) { pg8::Gemm g{(const pg8::bf16_t*)(F.ws + WS_XN) + (size_t)SEQ * DM, (const pg8::bf16_t*)(F.ws + WS_WUP), SEQ, NUP, DM}; pg8::StaticOrder S; S.init(SEQ, NUP, F.G, (int)blockIdx.x);
        pg8::EpiBf16 E{(pg8::bf16_t*)(F.ws + WS_U), NUP, nullptr, -1};
        pg8::gemm_phase<pg8::EpiBf16, pg8::StaticOrder, true, true>(ring, g, S, E); }
    SEAM(10);
    if constexpr (IN(11)) p9_convact(F, 1);
    SEAM(11);
    if constexpr (IN(12)) { pg8::Gemm g{(const pg8::bf16_t*)(F.ws + WS_HMID), (const pg8::bf16_t*)(F.ws + WS_WDN), LROWS, DM, DFF}; pg8::StaticOrder S; S.init(LROWS, DM, F.G, (int)blockIdx.x);
        pg8::EpiF32 E{(float*)(F.ws + WS_Y2), DM};
        pg8::gemm_phase<pg8::EpiF32, pg8::StaticOrder, true, true>(ring, g, S, E); }
    SEAM(12);
    if constexpr (IN(13)) p13_final(F);
#undef IN
#undef SEAM
}

extern "C" void kernel_launch(void* const* d_in, const int* in_sizes, int n_in, void* d_out, int out_size, void* d_ws, size_t ws_size, hipStream_t stream) {
    static int grid = 0;
    if (grid == 0) {
        if (n_in != 25 || in_sizes[0] != LROWS * DM || out_size != LROWS * DM || ws_size < WS_END) { fprintf(stderr, "kernel_launch: unexpected shapes / workspace (n_in %d, ws %zu, need %zu)\n", n_in, ws_size, (size_t)WS_END); grid = -1; return; }
        bool ok = true;
#define SETATTR(a, b) ok = ok && (hipFuncSetAttribute((const void*)fwd_kernel<a, b>, hipFuncAttributeMaxDynamicSharedMemorySize, LDS_BYTES) == hipSuccess)
#if MK_N_LAUNCHES == 1
        SETATTR(0, N_PHASES);
#else
        SETATTR(0, 1); SETATTR(1, 2); SETATTR(2, 3); SETATTR(3, 4); SETATTR(4, 5); SETATTR(5, 6); SETATTR(6, 7); SETATTR(7, 8); SETATTR(8, 9); SETATTR(9, 10); SETATTR(10, 11); SETATTR(11, 12); SETATTR(12, 13); SETATTR(13, 14);
#endif
#undef SETATTR
        if (!ok) { fprintf(stderr, "kernel_launch: hipFuncSetAttribute failed\n"); grid = -1; return; }
        int dev = 0, cus = 0, per_cu = 0; (void)hipGetDevice(&dev); (void)hipDeviceGetAttribute(&cus, hipDeviceAttributeMultiprocessorCount, dev);
#if MK_N_LAUNCHES == 1
        if (hipOccupancyMaxActiveBlocksPerMultiprocessor(&per_cu, (const void*)fwd_kernel<0, N_PHASES>, NWAVES * 64, LDS_BYTES) != hipSuccess || per_cu < 1) { fprintf(stderr, "kernel_launch: occupancy query says %d blocks per CU\n", per_cu); (void)hipGetLastError(); }
#endif
        grid = cus > 0 ? cus : 256;
    }
    if (grid < 0) return;
    (void)hipMemsetAsync((char*)d_ws + WS_CTL, 0, CTL_ZERO_BYTES, stream);
    Args a{};
    for (int i = 0; i < 25; ++i) a.in[i] = (const float*)d_in[i];
    a.out = (float*)d_out; a.ws = (unsigned char*)d_ws;
#if MK_N_LAUNCHES == 1
    hipLaunchKernelGGL((fwd_kernel<0, N_PHASES>), dim3(grid), dim3(NWAVES * 64), LDS_BYTES, stream, a);
#else
#define LAUNCH(p) hipLaunchKernelGGL((fwd_kernel<p, p + 1>), dim3(grid), dim3(NWAVES * 64), LDS_BYTES, stream, a)
    LAUNCH(0); LAUNCH(1); LAUNCH(2); LAUNCH(3); LAUNCH(4); LAUNCH(5); LAUNCH(6); LAUNCH(7); LAUNCH(8); LAUNCH(9); LAUNCH(10); LAUNCH(11); LAUNCH(12); LAUNCH(13);
#undef LAUNCH
#endif
}
```

```cpp
#include <hip/hip_runtime.h>
#include <hip/hip_bf16.h>
#include <cstdio>
#include <cstdint>
#include <cmath>

namespace pg8 {
#define PG8_LAS __attribute__((address_space(3)))
typedef unsigned short bf16_t;
typedef short bf16x8 __attribute__((ext_vector_type(8)));
typedef float f32x4 __attribute__((ext_vector_type(4)));
typedef unsigned u32x4 __attribute__((ext_vector_type(4)));
constexpr int BM = 256, BK = 64, HALF = 128, HTB = HALF * BK * 2  , STAGE_BYTES = 8 * HTB, NXCD = 8, WGM = 8;

__host__ __device__ __forceinline__ int lds_byte(int r, int c) { const int st = (r >> 4) * 2 + (c >> 5), rr = r & 15, cc = c & 31, ob = rr * 64 + cc * 2; return st * 1024 + (ob ^ (((ob >> 9) & 1) << 5)); }
__host__ __device__ __forceinline__ void stage_rc(int b, int& R, int& C) { const int st = b / 1024, sb = b % 1024, swz = sb ^ (((sb >> 9) & 1) << 5); R = (st >> 1) * 16 + swz / 64; C = (st & 1) * 32 + (swz % 64) / 2; }
__host__ __device__ __forceinline__ int perm32(int rho) { const int n = rho >> 4, i = rho & 15; return 8 * (i >> 2) + 4 * n + (i & 3); }

struct Unit { int pm, pn; };
struct Gemm { const bf16_t* A; const bf16_t* Bt; int M, N, K; };

struct StaticOrder {
    int nM, nN, nwg, G, c;
    __host__ __device__ void init(int M, int N, int G_, int c_) { nM = M / BM; nN = N / BM; nwg = nM * nN; G = G_; c = c_; }
    __host__ __device__ bool next(int i, Unit& u) const {
        const long L = (long)i * G + c; if (L >= nwg) return false;
        int wgid = (int)L; { const int q = nwg / NXCD, r = nwg % NXCD, xcd = wgid % NXCD, off = wgid / NXCD; wgid = (xcd < r ? xcd * (q + 1) : r * (q + 1) + (xcd - r) * q) + off; }
        const int nig = WGM * nN, gid = wgid / nig, fm = gid * WGM, gsz = (nM - fm) < WGM ? (nM - fm) : WGM;
        u.pm = fm + ((wgid % nig) % gsz); u.pn = (wgid % nig) / gsz; return true;
    }
    __device__ __forceinline__ void a_ready(const Unit&) const {}
    __device__ __forceinline__ void done(const Unit&) const {}
};


__device__ __forceinline__ unsigned cvt_pk_bf16(float lo, float hi) { unsigned r; asm volatile("v_cvt_pk_bf16_f32 %0, %1, %2" : "=v"(r) : "v"(lo), "v"(hi)); return r; }

struct EpiBf16 {
    static constexpr bool PERM = true, AFTER_DRAIN = false;
    bf16_t* O; int ldc; float* gates; int gate_tile;
    __device__ __forceinline__ void operator()(const f32x4 (&acc)[2][2][4][2], const Unit& u, int wr, int wc, int fr, int fq) const {
        const int row0 = u.pm * BM + wr * 64 + fr;
        if (u.pn == gate_tile) {
            if (wc == 0) {
#pragma unroll
                for (int ai = 0; ai < 2; ++ai)
#pragma unroll
                    for (int m = 0; m < 4; ++m) { float* g = gates + (size_t)(row0 + ai * HALF + m * 16) * 32 + 8 * fq;
                        *(f32x4*)(g) = acc[ai][0][m][0]; *(f32x4*)(g + 4) = acc[ai][0][m][1]; }
            }
            return;
        }
        const int col0 = u.pn * BM + wc * 32 + 8 * fq;
#pragma unroll
        for (int ai = 0; ai < 2; ++ai)
#pragma unroll
            for (int m = 0; m < 4; ++m) { bf16_t* rowp = O + (size_t)(row0 + ai * HALF + m * 16) * ldc + col0;
#pragma unroll
                for (int bj = 0; bj < 2; ++bj) { const f32x4 v0 = acc[ai][bj][m][0], v1 = acc[ai][bj][m][1];
                    u32x4 w; w.x = cvt_pk_bf16(v0[0], v0[1]); w.y = cvt_pk_bf16(v0[2], v0[3]); w.z = cvt_pk_bf16(v1[0], v1[1]); w.w = cvt_pk_bf16(v1[2], v1[3]);
                    *(u32x4*)(rowp + bj * HALF) = w; } }
    }
};
struct EpiF32 {
    static constexpr bool PERM = false, AFTER_DRAIN = false;
    float* O; int ldc;
    __device__ __forceinline__ void operator()(const f32x4 (&acc)[2][2][4][2], const Unit& u, int wr, int wc, int fr, int fq) const {
        const int row0 = u.pm * BM + wr * 64 + fr, col0 = u.pn * BM + wc * 32 + 4 * fq;
#pragma unroll
        for (int ai = 0; ai < 2; ++ai)
#pragma unroll
            for (int m = 0; m < 4; ++m) { float* rowp = O + (size_t)(row0 + ai * HALF + m * 16) * ldc + col0;
#pragma unroll
                for (int bj = 0; bj < 2; ++bj)
#pragma unroll
                    for (int n = 0; n < 2; ++n) *(f32x4*)(rowp + bj * HALF + n * 16) = acc[ai][bj][m][n]; }
    }
};

template <class Epi, class Sched, bool ALIGN_EPI = false, bool SP2 = false>
__device__ __forceinline__ void gemm_phase(PG8_LAS unsigned char* lds, const Gemm g, const Sched& S, const Epi& E) {
    int tid_ = threadIdx.x; asm volatile("" : "+v"(tid_));
    const int tid = tid_, wid = __builtin_amdgcn_readfirstlane(tid >> 6), lane = tid & 63, wr = wid >> 2, wc = wid & 3, fr = lane & 15, fq = lane >> 4;
    const int K = g.K, nt = K / BK;
    unsigned voffA[2], voffB[2];
#pragma unroll
    for (int i = 0; i < 2; ++i) { int R, C; stage_rc(tid * 16 + i * 8192, R, C); const int Rb = Epi::PERM ? ((R & ~31) + perm32(R & 31)) : R;
        voffA[i] = (unsigned)(R * K + C) * 2u; voffB[i] = (unsigned)(Rb * K + C) * 2u; }
    const size_t kstep = (size_t)(BK * 2);
    const size_t hstep = (size_t)HALF * K * 2;
    const size_t tstep = 2 * hstep;
    const unsigned ldsw = (unsigned)wid * 1024u;
    const int aoff = lds_byte(wr * 64 + fr, fq * 8), boff = lds_byte(wc * 32 + fr, fq * 8);
#define PG8_SA(b, h) (((b) * 2 + (h)) * HTB)
#define PG8_SB(b, h) ((4 + (b) * 2 + (h)) * HTB)
#define PG8_STAGE(bufoff, gbase, voff) do { _Pragma("unroll") for (int _i = 0; _i < 2; ++_i) \
        __builtin_amdgcn_global_load_lds((const unsigned*)((const char*)(gbase) + (voff)[_i]), (PG8_LAS unsigned*)(lds + (bufoff) + ldsw + _i * 8192), 16, 0, 0); } while (0)
#define PG8_LDA(dst, b, h) do { _Pragma("unroll") for (int m = 0; m < 4; ++m) _Pragma("unroll") for (int k = 0; k < 2; ++k) dst[m][k] = *(const PG8_LAS bf16x8*)(lds + PG8_SA(b, h) + aoff + m * 2048 + k * 1024); } while (0)
#define PG8_LDB(dst, b, h) do { _Pragma("unroll") for (int n = 0; n < 2; ++n) _Pragma("unroll") for (int k = 0; k < 2; ++k) dst[n][k] = *(const PG8_LAS bf16x8*)(lds + PG8_SB(b, h) + boff + n * 2048 + k * 1024); } while (0)
#define PG8_MMA(ai, bj, At, Bt) do { __builtin_amdgcn_s_setprio(1); _Pragma("unroll") for (int m = 0; m < 4; ++m) _Pragma("unroll") for (int n = 0; n < 2; ++n) _Pragma("unroll") for (int k = 0; k < 2; ++k) \
        acc[ai][bj][m][n] = __builtin_amdgcn_mfma_f32_16x16x32_bf16(Bt[n][k], At[m][k], acc[ai][bj][m][n], 0, 0, 0); __builtin_amdgcn_s_setprio(0); } while (0)
#define PG8_WAIT_V(n) asm volatile("s_waitcnt vmcnt(" #n ")" ::: "memory")
#define PG8_WAIT_L(n) asm volatile("s_waitcnt lgkmcnt(" #n ")" ::: "memory")
#define PG8_BAR __builtin_amdgcn_s_barrier()
#define PG8_SCHED __builtin_amdgcn_sched_barrier(0)
    Unit cur, nxt; int ui = 0;
    if (!S.next(0, cur)) return;
    f32x4 acc[2][2][4][2];
#pragma unroll
    for (int a = 0; a < 2; ++a)
#pragma unroll
        for (int b = 0; b < 2; ++b)
#pragma unroll
            for (int m = 0; m < 4; ++m)
#pragma unroll
                for (int n = 0; n < 2; ++n) acc[a][b][m][n] = (f32x4){0.f, 0.f, 0.f, 0.f};
    bf16x8 At[4][2], B0[2][2], B1[2][2];
    const char* cA = (const char*)g.A + (size_t)cur.pm * tstep; const char* cB = (const char*)g.Bt + (size_t)cur.pn * tstep;
    S.a_ready(cur);
    if constexpr (SP2) {
        PG8_STAGE(PG8_SB(0, 0), cB, voffB); PG8_STAGE(PG8_SB(0, 1), cB + hstep, voffB); PG8_STAGE(PG8_SA(0, 0), cA, voffA); PG8_STAGE(PG8_SA(0, 1), cA + hstep, voffA);
        if (wr == 1) PG8_BAR;
        PG8_WAIT_V(2); PG8_BAR;
        PG8_STAGE(PG8_SB(1, 0), cB + kstep, voffB); PG8_STAGE(PG8_SA(1, 0), cA + kstep, voffA); PG8_STAGE(PG8_SB(1, 1), cB + hstep + kstep, voffB);
        PG8_WAIT_V(6); PG8_BAR;
    } else {
        PG8_STAGE(PG8_SB(0, 0), cB, voffB); PG8_STAGE(PG8_SA(0, 0), cA, voffA); PG8_STAGE(PG8_SB(0, 1), cB + hstep, voffB); PG8_STAGE(PG8_SA(0, 1), cA + hstep, voffA);
        if (wr == 1) PG8_BAR;
        PG8_WAIT_V(4); PG8_BAR;
        PG8_STAGE(PG8_SB(1, 0), cB + kstep, voffB); PG8_STAGE(PG8_SA(1, 0), cA + kstep, voffA); PG8_STAGE(PG8_SB(1, 1), cB + hstep + kstep, voffB);
        PG8_WAIT_V(6); PG8_BAR;
    }
    for (;;) {
        const bool has_next = S.next(ui + 1, nxt);
        const char* nA = has_next ? (const char*)g.A + (size_t)nxt.pm * tstep : cA; const char* nB = has_next ? (const char*)g.Bt + (size_t)nxt.pn * tstep : cB;
        for (int t = 0; t < nt; t += 2) {
            const bool last = (t == nt - 2);
            const char* a1 = cA + (size_t)(t + 1) * kstep;
            const char* a2 = last ? nA : cA + (size_t)(t + 2) * kstep; const char* b2 = last ? nB : cB + (size_t)(t + 2) * kstep;
            const char* a3 = a2 + kstep; const char* b3 = b2 + kstep;
            if (last && has_next) S.a_ready(nxt);
            if constexpr (SP2) {
            PG8_LDB(B0, 0, 0); PG8_LDB(B1, 0, 1); PG8_SCHED; PG8_LDA(At, 0, 0); PG8_STAGE(PG8_SA(1, 1), a1 + hstep, voffA);
            PG8_WAIT_V(8); PG8_WAIT_L(0); PG8_BAR; PG8_MMA(0, 0, At, B0); PG8_MMA(0, 1, At, B1); PG8_BAR; PG8_SCHED;
            PG8_LDA(At, 0, 1); PG8_STAGE(PG8_SB(0, 0), b2, voffB); PG8_STAGE(PG8_SB(0, 1), b2 + hstep, voffB); PG8_STAGE(PG8_SA(0, 0), a2, voffA);
            PG8_WAIT_V(8); PG8_WAIT_L(0); PG8_BAR; PG8_MMA(1, 0, At, B0); PG8_MMA(1, 1, At, B1); PG8_BAR; PG8_SCHED;
            PG8_LDB(B0, 1, 0); PG8_LDB(B1, 1, 1); PG8_SCHED; PG8_LDA(At, 1, 0); PG8_STAGE(PG8_SA(0, 1), a2 + hstep, voffA);
            PG8_WAIT_V(8); PG8_WAIT_L(0); PG8_BAR; PG8_MMA(0, 0, At, B0); PG8_MMA(0, 1, At, B1); PG8_BAR; PG8_SCHED;
            PG8_LDA(At, 1, 1); PG8_STAGE(PG8_SB(1, 0), b3, voffB); PG8_STAGE(PG8_SB(1, 1), b3 + hstep, voffB); PG8_STAGE(PG8_SA(1, 0), a3, voffA);
            PG8_WAIT_V(8); PG8_WAIT_L(0); PG8_BAR; PG8_MMA(1, 0, At, B0); PG8_MMA(1, 1, At, B1); PG8_BAR; PG8_SCHED;
            } else {
            PG8_LDB(B0, 0, 0); PG8_SCHED; PG8_LDA(At, 0, 0); PG8_STAGE(PG8_SA(1, 1), a1 + hstep, voffA);
            PG8_WAIT_L(8); PG8_BAR; PG8_WAIT_L(0); PG8_MMA(0, 0, At, B0); PG8_BAR; PG8_SCHED;
            PG8_LDB(B1, 0, 1); PG8_STAGE(PG8_SB(0, 0), b2, voffB);
            PG8_BAR; PG8_WAIT_L(0); PG8_MMA(0, 1, At, B1); PG8_BAR;
            PG8_LDA(At, 0, 1); PG8_STAGE(PG8_SA(0, 0), a2, voffA);
            PG8_BAR; PG8_WAIT_L(0); PG8_MMA(1, 0, At, B0); PG8_BAR; PG8_SCHED;
            PG8_STAGE(PG8_SB(0, 1), b2 + hstep, voffB);
            PG8_WAIT_V(6); PG8_BAR; PG8_MMA(1, 1, At, B1); PG8_BAR;
            PG8_LDB(B0, 1, 0); PG8_SCHED; PG8_LDA(At, 1, 0); PG8_STAGE(PG8_SA(0, 1), a2 + hstep, voffA);
            PG8_WAIT_L(8); PG8_BAR; PG8_WAIT_L(0); PG8_MMA(0, 0, At, B0); PG8_BAR; PG8_SCHED;
            PG8_LDB(B1, 1, 1); PG8_STAGE(PG8_SB(1, 0), b3, voffB);
            PG8_BAR; PG8_WAIT_L(0); PG8_MMA(0, 1, At, B1); PG8_BAR;
            PG8_LDA(At, 1, 1); PG8_STAGE(PG8_SA(1, 0), a3, voffA);
            PG8_BAR; PG8_WAIT_L(0); PG8_MMA(1, 0, At, B0); PG8_BAR; PG8_SCHED;
            PG8_STAGE(PG8_SB(1, 1), b3 + hstep, voffB);
            PG8_WAIT_V(6); PG8_BAR; PG8_MMA(1, 1, At, B1); PG8_BAR;
            }
        }
        if constexpr (ALIGN_EPI) { if (wr == 0) PG8_BAR; }
        if constexpr (!Epi::AFTER_DRAIN) { E(acc, cur, wr, wc, fr, fq); S.done(cur); }
        if (!has_next) break;
#pragma unroll
        for (int a = 0; a < 2; ++a)
#pragma unroll
            for (int b = 0; b < 2; ++b)
#pragma unroll
                for (int m = 0; m < 4; ++m)
#pragma unroll
                    for (int n = 0; n < 2; ++n) acc[a][b][m][n] = (f32x4){0.f, 0.f, 0.f, 0.f};
        cur = nxt; cA = nA; cB = nB; ++ui;
        if constexpr (ALIGN_EPI) { if (wr == 1) PG8_BAR; }
    }
    PG8_WAIT_V(0);
    if constexpr (!ALIGN_EPI) { if (wr == 0) PG8_BAR; }
    PG8_BAR;
    if constexpr (Epi::AFTER_DRAIN) { E.fused(acc, cur, wr, wc, fr, fq, lds, wid, lane); S.done(cur); }
#undef PG8_SA
#undef PG8_SB
#undef PG8_STAGE
#undef PG8_LDA
#undef PG8_LDB
#undef PG8_MMA
#undef PG8_WAIT_V
#undef PG8_WAIT_L
#undef PG8_BAR
#undef PG8_SCHED
}
}


namespace attn {
using bf16x8 = __attribute__((ext_vector_type(8))) short;
using s16x4  = __attribute__((ext_vector_type(4))) short;
using f32x16 = __attribute__((ext_vector_type(16))) float;
using u32x4  = __attribute__((ext_vector_type(4))) unsigned;
typedef unsigned short bf16;
constexpr int NW = 8, QBLK = 32, KVBLK = 64;
constexpr float SCALE = 0.125f;
constexpr float THR = 8.f;
constexpr int SHM_V = KVBLK * 128 * 2, SHM_K = KVBLK * 64 * 2, SHM_ATTN = 2 * SHM_V + 2 * SHM_K + NW * 64 * 4;
#define KSWZ64(row, ch) ((row) * 128 + ((((ch) ^ (((row) >> 1) & 7))) << 4))
#define SBAR() __builtin_amdgcn_sched_barrier(0)
__device__ __forceinline__ int crow(int r, int hi) { return (r & 3) + 8 * (r >> 2) + 4 * hi; }
__device__ __forceinline__ unsigned cvtpk(float lo, float hi) { unsigned r; asm volatile("v_cvt_pk_bf16_f32 %0, %1, %2" : "=v"(r) : "v"(lo), "v"(hi)); return r; }

__device__ __forceinline__ void partialSM(f32x16& p0, f32x16& p1, float& m_reg, float& mn, float& alpha) {
  constexpr float C = SCALE * 1.4426950408889634f;
  float pmax = p0[0];
#pragma unroll
  for (int r = 1; r < 16; ++r) pmax = fmaxf(pmax, p0[r]);
#pragma unroll
  for (int r = 0; r < 16; ++r) pmax = fmaxf(pmax, p1[r]);
  { auto rr = __builtin_amdgcn_permlane32_swap(__float_as_uint(pmax), __float_as_uint(pmax), false, false);
    pmax = fmaxf(__uint_as_float(rr[0]), __uint_as_float(rr[1])); }
  if (__builtin_expect(__all(pmax - m_reg <= THR / SCALE), 1)) { mn = m_reg; alpha = 1.f; }
  else { mn = fmaxf(m_reg, pmax); alpha = __builtin_amdgcn_exp2f((m_reg - mn) * C); m_reg = mn; }
  float mnC = -mn * C;
#pragma unroll
  for (int r = 0; r < 16; ++r) p0[r] = fmaf(p0[r], C, mnC);
#pragma unroll
  for (int r = 0; r < 16; ++r) p1[r] = fmaf(p1[r], C, mnC);
#pragma unroll
  for (int r = 0; r < 16; ++r) p0[r] = __builtin_amdgcn_exp2f(p0[r]);
}
__device__ __forceinline__ void finishSM(f32x16& p0, f32x16& p1, float alpha, float& l_reg, bf16x8& pa0, bf16x8& pa1, bf16x8& pa2, bf16x8& pa3) {
#pragma unroll
  for (int r = 0; r < 16; ++r) p1[r] = __builtin_amdgcn_exp2f(p1[r]);
  float ps = 0;
#pragma unroll
  for (int r = 0; r < 16; ++r) ps += p0[r];
#pragma unroll
  for (int r = 0; r < 16; ++r) ps += p1[r];
  { auto rr = __builtin_amdgcn_permlane32_swap(__float_as_uint(ps), __float_as_uint(ps), false, false);
    ps = __uint_as_float(rr[0]) + __uint_as_float(rr[1]); }
  l_reg = l_reg * alpha + ps;
#define PK4(P, BASE, OUT) do { unsigned a0 = cvtpk(P[BASE + 0], P[BASE + 1]), a1 = cvtpk(P[BASE + 2], P[BASE + 3]);   \
    unsigned b0 = cvtpk(P[BASE + 4], P[BASE + 5]), b1 = cvtpk(P[BASE + 6], P[BASE + 7]);                              \
    auto r0 = __builtin_amdgcn_permlane32_swap(a0, b0, false, false); auto r1 = __builtin_amdgcn_permlane32_swap(a1, b1, false, false); \
    u32x4 w = {r0[0], r1[0], r0[1], r1[1]}; OUT = *reinterpret_cast<bf16x8*>(&w); } while (0)
  PK4(p0, 0, pa0); PK4(p0, 8, pa1); PK4(p1, 0, pa2); PK4(p1, 8, pa3);
#undef PK4
}
__device__ __forceinline__ void qkt(f32x16& p0, f32x16& p1, const char* Ks, const bf16x8* qr, int r32, int hi) {
  p0 = f32x16{}; p1 = f32x16{};
#pragma unroll
  for (int d0 = 0; d0 < 4; ++d0) { const int ch = 2 * d0 + hi;
    bf16x8 b0 = *reinterpret_cast<const bf16x8*>(Ks + KSWZ64(r32, ch));
    bf16x8 b1 = *reinterpret_cast<const bf16x8*>(Ks + KSWZ64(32 + r32, ch));
    p0 = __builtin_amdgcn_mfma_f32_32x32x16_bf16(b0, qr[d0], p0, 0, 0, 0);
    p1 = __builtin_amdgcn_mfma_f32_32x32x16_bf16(b1, qr[d0], p1, 0, 0, 0); }
}
__device__ __forceinline__ int v_st(int k, int c) { const int kk = (k & ~0xC) | ((k & 4) << 1) | ((k & 8) >> 1); return ((kk >> 3) * 4 + (c >> 5)) * 512 + ((kk & 7) * 32 + (c & 31)) * 2; }
__device__ __forceinline__ int v_rd_base(int lane) { return ((lane & 3) << 3) | (((lane >> 2) & 3) << 6) | (((lane >> 4) & 1) << 5) | (((lane >> 5) & 1) << 8); }
constexpr int v_rd_off(int d0, int ks, int half) { return d0 * 512 + ks * 4096 + half * 2048; }
template <int OFF> __device__ __forceinline__ s16x4 tr_read(int vb) {
  s16x4 r; asm volatile("ds_read_b64_tr_b16 %0, %1 offset:%2" : "=&v"(r) : "v"(vb), "i"(OFF) : "memory"); return r;
}
template <int D0> __device__ __forceinline__ void pv_one(f32x16& od, int vb, bf16x8 pa0, bf16x8 pa1, bf16x8 pa2, bf16x8 pa3) {
  const s16x4 l0 = tr_read<v_rd_off(D0, 0, 0)>(vb), h0 = tr_read<v_rd_off(D0, 0, 1)>(vb), l1 = tr_read<v_rd_off(D0, 1, 0)>(vb), h1 = tr_read<v_rd_off(D0, 1, 1)>(vb);
  const s16x4 l2 = tr_read<v_rd_off(D0, 2, 0)>(vb), h2 = tr_read<v_rd_off(D0, 2, 1)>(vb), l3 = tr_read<v_rd_off(D0, 3, 0)>(vb), h3 = tr_read<v_rd_off(D0, 3, 1)>(vb);
  asm volatile("s_waitcnt lgkmcnt(0)" ::: "memory"); SBAR();
#define PK(L, H) (bf16x8){L[0], L[1], L[2], L[3], H[0], H[1], H[2], H[3]}
  od = __builtin_amdgcn_mfma_f32_32x32x16_bf16(pa0, PK(l0, h0), od, 0, 0, 0);
  od = __builtin_amdgcn_mfma_f32_32x32x16_bf16(pa1, PK(l1, h1), od, 0, 0, 0);
  od = __builtin_amdgcn_mfma_f32_32x32x16_bf16(pa2, PK(l2, h2), od, 0, 0, 0);
  od = __builtin_amdgcn_mfma_f32_32x32x16_bf16(pa3, PK(l3, h3), od, 0, 0, 0);
#undef PK
}
__device__ __forceinline__ void pv_d0(f32x16* o, int vb, bf16x8 pa0, bf16x8 pa1, bf16x8 pa2, bf16x8 pa3) {
  pv_one<0>(o[0], vb, pa0, pa1, pa2, pa3); pv_one<1>(o[1], vb, pa0, pa1, pa2, pa3); pv_one<2>(o[2], vb, pa0, pa1, pa2, pa3); pv_one<3>(o[3], vb, pa0, pa1, pa2, pa3);
}

template <int LD>
__device__ __forceinline__ void attn_sub(const bf16* __restrict__ Qb, const bf16* __restrict__ Kh, const bf16* __restrict__ Vh, int NT, char* lds, f32x16 (&o)[4], float (&rli)[16]) {
  int tid_ = threadIdx.x; asm volatile("" : "+v"(tid_));
  const int tid = tid_, wid = tid >> 6, lane = tid & 63, r32 = lane & 31, hi = lane >> 5;
  char* V_lds = lds; char* K_lds = lds + 2 * SHM_V;
  float* ws = (float*)(lds + 2 * SHM_V + 2 * SHM_K) + wid * 64; float* li_l = ws; float* al_l = ws + 32;
  float m_reg = -1e30f, l_reg = 0; bf16x8 qr[4];
#pragma unroll
  for (int d = 0; d < 4; ++d) o[d] = f32x16{};
  const bf16* Qw = Qb + (long)(wid * QBLK + r32) * LD + hi * 8;
#pragma unroll
  for (int d0 = 0; d0 < 4; ++d0) qr[d0] = *reinterpret_cast<const bf16x8*>(Qw + d0 * 16);
  const int sr = tid >> 4, sc = (tid & 15) * 8, vst0 = v_st(sr, sc), vst1 = v_st(32 + sr, sc);
  const int kr = tid >> 3, kc = tid & 7, kst = KSWZ64(kr, kc);
  const int vb0 = (int)(uintptr_t)V_lds + v_rd_base(lane);
  struct { bf16x8 vs0, vs1, ks0; } sr_[2];
#define SLOAD(i, k0) do { sr_[i].vs0 = *reinterpret_cast<const bf16x8*>(&Vh[(long)((k0) + sr) * LD + sc]); sr_[i].vs1 = *reinterpret_cast<const bf16x8*>(&Vh[(long)((k0) + 32 + sr) * LD + sc]); \
    sr_[i].ks0 = *reinterpret_cast<const bf16x8*>(&Kh[(long)((k0) + kr) * LD + kc * 8]); } while (0)
#define SWRITE(b, i) do { *(bf16x8*)(V_lds + (b) * SHM_V + vst0) = sr_[i].vs0; *(bf16x8*)(V_lds + (b) * SHM_V + vst1) = sr_[i].vs1; \
    *(bf16x8*)(K_lds + (b) * SHM_K + kst) = sr_[i].ks0; } while (0)
#define SWAIT() asm volatile("s_waitcnt vmcnt(3)" ::: "memory")
#define RESC(a) do { if (__any((a) < 1.f)) { if (hi == 0) al_l[r32] = (a); asm volatile("s_waitcnt lgkmcnt(0)" ::: "memory"); \
    _Pragma("unroll") for (int d = 0; d < 4; ++d) _Pragma("unroll") for (int r = 0; r < 16; ++r) o[d][r] *= al_l[crow(r, hi)]; } } while (0)
  f32x16 pA0, pA1, pB0, pB1; float mnA, mnB, alA, alB; bf16x8 pa0, pa1, pa2, pa3;
  constexpr int SE = 0, SO = 1;
  SLOAD(SE, 0); asm volatile("s_waitcnt vmcnt(0)" ::: "memory"); SWRITE(0, SE); __syncthreads();
  qkt(pA0, pA1, K_lds, qr, r32, hi); partialSM(pA0, pA1, m_reg, mnA, alA);
  SLOAD(SO, KVBLK); if (2 < NT) SLOAD(SE, 2 * KVBLK);
  SWAIT(); SWRITE(1, SO); __syncthreads();
  for (int j = 1; j + 1 < NT; j += 2) {
    SBAR(); qkt(pB0, pB1, K_lds + SHM_K, qr, r32, hi);
    finishSM(pA0, pA1, alA, l_reg, pa0, pa1, pa2, pa3); SBAR();
    SLOAD(SO, (j + 2) * KVBLK); SBAR();
    pv_d0(o, vb0, pa0, pa1, pa2, pa3); partialSM(pB0, pB1, m_reg, mnB, alB);
    __syncthreads(); SWAIT(); SWRITE(0, SE);
    RESC(alB); __syncthreads();
    SBAR(); qkt(pA0, pA1, K_lds, qr, r32, hi);
    finishSM(pB0, pB1, alB, l_reg, pa0, pa1, pa2, pa3); SBAR();
    if (j + 3 < NT) SLOAD(SE, (j + 3) * KVBLK); SBAR();
    pv_d0(o, vb0 + SHM_V, pa0, pa1, pa2, pa3); partialSM(pA0, pA1, m_reg, mnA, alA);
    __syncthreads(); SWAIT(); SWRITE(1, SO);
    RESC(alA); __syncthreads();
  }
  SBAR(); qkt(pB0, pB1, K_lds + SHM_K, qr, r32, hi);
  finishSM(pA0, pA1, alA, l_reg, pa0, pa1, pa2, pa3); SBAR();
  pv_d0(o, vb0, pa0, pa1, pa2, pa3); partialSM(pB0, pB1, m_reg, mnB, alB);
  __syncthreads(); RESC(alB);
  finishSM(pB0, pB1, alB, l_reg, pa0, pa1, pa2, pa3); SBAR();
  pv_d0(o, vb0 + SHM_V, pa0, pa1, pa2, pa3);
  if (hi == 0) li_l[r32] = l_reg; asm volatile("s_waitcnt lgkmcnt(0)" ::: "memory");
#pragma unroll
  for (int r = 0; r < 16; ++r) rli[r] = __builtin_amdgcn_rcpf(li_l[crow(r, hi)]);
  __syncthreads();
#undef SLOAD
#undef SWRITE
#undef SWAIT
#undef RESC
}
#undef SBAR
}

constexpr int BATCH = 2, SEQ = 8192, DM = 2048, CTX = 256;
constexpr int UROWS_B = CTX + SEQ;
constexpr int UROWS = BATCH * UROWS_B;
constexpr int LROWS = BATCH * SEQ;
constexpr int IN_COLS = 7200, NPAD = 7424, LDP = 7168;
constexpr int DFF = 5632, NUP = 2 * DFF;
constexpr int NMOD = 6 * DM;
constexpr int PC_MQ = 0, PC_MK = 1024, PC_MV = 2048, PC_MO = 3072, PC_DQ = 4096, PC_DK = 5120, PC_DV = 6144;
constexpr float EPS = 1e-6f;
constexpr int KSL = 8;

constexpr size_t MiB = 1u << 20;
constexpr size_t WS_CTL = 0, CTL_ZERO_BYTES = 1 * MiB;
constexpr size_t WS_MODP = 1 * MiB;
constexpr size_t WS_GATES = 3 * MiB;
constexpr size_t WS_WUP = 6 * MiB;
constexpr size_t WS_WDN = 50 * MiB;
constexpr size_t WS_XN = 72 * MiB;
constexpr size_t WS_ARENA = 138 * MiB;
constexpr size_t WS_WIN = WS_ARENA;
constexpr size_t WS_WOUT = WS_ARENA + 29 * MiB;
constexpr size_t WS_P = WS_ARENA + 37 * MiB;
constexpr size_t WS_MIX = WS_ARENA + 268 * MiB;
constexpr size_t WS_ASCR = WS_ARENA + 332 * MiB;
constexpr size_t WS_Y = WS_P;
constexpr size_t WS_U = WS_ARENA;
constexpr size_t WS_HMID = WS_ARENA + 176 * MiB;
constexpr size_t WS_Y2 = WS_ARENA;
constexpr size_t WS_END = WS_ARENA + 364 * MiB;
static_assert(WS_HMID + (size_t)LROWS * DFF * 2 <= WS_END && WS_ASCR + 32 * MiB <= WS_END && WS_MIX >= WS_P + (size_t)UROWS * LDP * 2, "ws map");

constexpr int RING_BYTES = 131072, LDS_BYTES = 147456;
constexpr int LDSCTL_OFF = RING_BYTES, MISC_OFF = LDSCTL_OFF + 320;
constexpr int CW_BAR = 4096;
constexpr int NWAVES = 8;

#define LAS __attribute__((address_space(3)))
typedef unsigned short bf16;
typedef unsigned v4u __attribute__((ext_vector_type(4)));
typedef unsigned v2u __attribute__((ext_vector_type(2)));
typedef float f32x4 __attribute__((ext_vector_type(4)));
typedef short bf16x8 __attribute__((ext_vector_type(8)));

__device__ __forceinline__ unsigned f2bf(float f) { unsigned u = __builtin_bit_cast(unsigned, f); return (u + 0x7fffu + ((u >> 16) & 1u)) >> 16; }
__device__ __forceinline__ unsigned pk2(float lo, float hi) { return f2bf(lo) | (f2bf(hi) << 16); }
__device__ __forceinline__ float bf2f(unsigned short b) { return __builtin_bit_cast(float, (unsigned)b << 16); }
__device__ __forceinline__ float bflo(unsigned w) { return __builtin_bit_cast(float, w << 16); }
__device__ __forceinline__ float bfhi(unsigned w) { return __builtin_bit_cast(float, w & 0xffff0000u); }
__device__ __forceinline__ float wave_sum(float v) {
#pragma unroll
    for (int o = 1; o < 64; o <<= 1) v += __shfl_xor(v, o);
    return v;
}
__device__ __forceinline__ float silu_f(float x) { return x / (1.f + __expf(-x)); }
__device__ __forceinline__ float sigmoid_f(float x) { return 1.f / (1.f + __expf(-x)); }
__device__ __forceinline__ float logsigmoid_f(float x) { return fminf(x, 0.f) - log1pf(__expf(-fabsf(x))); }

struct Frame {
    unsigned char* lds;
    int tid, lane, wave, vcu, G;
    float* out; unsigned char* ws;
};
#define AS4 __attribute__((address_space(4)))
__device__ __forceinline__ const float* inptr(int k) {
    const AS4 char* kp = (const AS4 char*)__builtin_amdgcn_kernarg_segment_ptr();
    asm volatile("" : "+s"(kp));
    return *(const float* const AS4*)(kp + 8 * k);
}
enum { I_X = 0, I_C, I_CTX, I_CCTX, I_WMOD, I_BMOD, I_GPREMIX, I_GPOSTMIX, I_WIN, I_BGATE, I_CONVQKW, I_CONVQKB, I_GMLSTM, I_LQ1, I_LK1, I_LQ2, I_LK2, I_GDIFF, I_WOUT, I_GPREFFN, I_GPOSTFFN, I_WUP, I_CONVFFNW, I_CONVFFNB, I_WDOWN };

__device__ __forceinline__ void transpose_item(const float* W, int K, int N, bf16* WT, int dst_row0, int k0, int n0, float* scr, int lane) {
#pragma unroll 8
    for (int i = 0; i < 32; ++i) { const int kk = 2 * i + (lane >> 5); scr[kk * 33 + (lane & 31)] = W[(size_t)(k0 + kk) * N + n0 + (lane & 31)]; }
    asm volatile("s_waitcnt lgkmcnt(0)" ::: "memory");
    const int c = lane & 7;
#pragma unroll
    for (int j = 0; j < 4; ++j) { const int n = (lane >> 3) + 8 * j; const float* s = scr + (8 * c) * 33 + n;
        v4u o; o.x = pk2(s[0 * 33], s[1 * 33]); o.y = pk2(s[2 * 33], s[3 * 33]); o.z = pk2(s[4 * 33], s[5 * 33]); o.w = pk2(s[6 * 33], s[7 * 33]);
        *(v4u*)(WT + (size_t)(dst_row0 + n) * K + k0 + 8 * c) = o; }
    asm volatile("s_waitcnt lgkmcnt(0)" ::: "memory");
}
__device__ __forceinline__ int win_dst_row(int nb) { return nb < 128 ? 32 * nb : (nb == 128 ? 7168 : 4096 + 32 * (nb - 129)); }

constexpr int MOD_BLOCKS = 48;
__device__ __forceinline__ void p0_prologue(Frame& F) {
    const float* in_w_down = inptr(I_WDOWN); const float* in_c_ctx = inptr(I_CCTX); const float* in_w_mod = inptr(I_WMOD); const float* in_w_out = inptr(I_WOUT); const float* in_w_in = inptr(I_WIN); const float* in_w_up = inptr(I_WUP); const float* in_c = inptr(I_C);
    const int blk = blockIdx.x;
    if (blk < MOD_BLOCKS) {
        const int id = blk * 512 + F.tid;
        const int jq = id % 3072, ks = id / 3072;
        f32x4 a0 = {0, 0, 0, 0}, a1 = a0, a2 = a0;
        const float* wp = in_w_mod + (size_t)(ks * 256) * NMOD + 4 * jq;
#pragma unroll 8
        for (int k = 0; k < 256; ++k) {
            const f32x4 w = *(const f32x4*)(wp + (size_t)k * NMOD);
            const int kk = ks * 256 + k;
            const float s0 = silu_f(in_c[kk]), s1 = silu_f(in_c[DM + kk]), s2 = silu_f(in_c_ctx[kk]);
            a0 += w * s0; a1 += w * s1; a2 += w * s2;
        }
        float* mp = (float*)(F.ws + WS_MODP);
        *(f32x4*)(mp + (size_t)(ks * 3 + 0) * NMOD + 4 * jq) = a0;
        *(f32x4*)(mp + (size_t)(ks * 3 + 1) * NMOD + 4 * jq) = a1;
        *(f32x4*)(mp + (size_t)(ks * 3 + 2) * NMOD + 4 * jq) = a2;
        return;
    }
    float* scr = (float*)(F.lds) + F.wave * 2112;
    const int gw = (blk - MOD_BLOCKS) * NWAVES + F.wave, NGW = (F.G - MOD_BLOCKS) * NWAVES;
    constexpr int I_IN = (DM / 64) * (IN_COLS / 32), I_OUT = (DM / 64) * (DM / 32), I_UP = (DM / 64) * (NUP / 32), I_DN = (DFF / 64) * (DM / 32);
    bf16* win_t = (bf16*)(F.ws + WS_WIN); bf16* wout_t = (bf16*)(F.ws + WS_WOUT); bf16* wup_t = (bf16*)(F.ws + WS_WUP); bf16* wdn_t = (bf16*)(F.ws + WS_WDN);
    for (int it = gw; it < I_IN + I_OUT + I_UP + I_DN; it += NGW) {
        int r = it;
        if (r < I_IN) { const int nblk = IN_COLS / 32, kb = r / nblk, nb = r % nblk; transpose_item(in_w_in, DM, IN_COLS, win_t, win_dst_row(nb), 64 * kb, 32 * nb, scr, F.lane); continue; } r -= I_IN;
        if (r < I_OUT) { const int nblk = DM / 32, kb = r / nblk, nb = r % nblk; transpose_item(in_w_out, DM, DM, wout_t, 32 * nb, 64 * kb, 32 * nb, scr, F.lane); continue; } r -= I_OUT;
        if (r < I_UP) { const int nblk = NUP / 32, kb = r / nblk, nb = r % nblk; transpose_item(in_w_up, DM, NUP, wup_t, 32 * nb, 64 * kb, 32 * nb, scr, F.lane); continue; } r -= I_UP;
        { const int nblk = DM / 32, kb = r / nblk, nb = r % nblk; transpose_item(in_w_down, DFF, DM, wdn_t, 32 * nb, 64 * kb, 32 * nb, scr, F.lane); }
    }
    { v4u* z = (v4u*)(win_t + (size_t)7200 * DM); const int n16 = 224 * DM * 2 / 16; const v4u zero = {0, 0, 0, 0};
      for (int i = (blk - MOD_BLOCKS) * 512 + F.tid; i < n16; i += (F.G - MOD_BLOCKS) * 512) z[i] = zero; }
}

__device__ __forceinline__ void load_mod(Frame& F, float* dst, int v, int col0, int n) {
    const float* in_b_mod = inptr(I_BMOD);
    const float* mp = (const float*)(F.ws + WS_MODP);
    for (int j = F.tid; j < n; j += 512) { float s = in_b_mod[col0 + j];
#pragma unroll
        for (int ks = 0; ks < KSL; ++ks) s += mp[(size_t)(ks * 3 + v) * NMOD + col0 + j];
        dst[j] = s; }
}

__device__ __forceinline__ void p1_xn(Frame& F) {
    const float* in_g_pre_mix = inptr(I_GPREMIX); const float* in_ctx = inptr(I_CTX); const float* in_x = inptr(I_X);
    float* modl = (float*)F.lds;
    for (int v = 0; v < 3; ++v) load_mod(F, modl + v * 4096, v, 0, 4096);
    __syncthreads();
    bf16* XN = (bf16*)(F.ws + WS_XN);
    const int gw = F.vcu * NWAVES + F.wave, NGW = F.G * NWAVES;
    for (int row = gw; row < UROWS; row += NGW) {
        const int b = row / UROWS_B, s = row % UROWS_B;
        const float* src = s < CTX ? in_ctx + ((size_t)b * CTX + s) * DM : in_x + ((size_t)b * SEQ + (s - CTX)) * DM;
        const float* mv = modl + (s < CTX ? 2 : b) * 4096;
        const f32x4* xr = (const f32x4*)src + F.lane;
        f32x4 v[8]; float ss = 0.f;
#pragma unroll
        for (int j = 0; j < 8; ++j) { v[j] = xr[64 * j]; ss += (v[j].x * v[j].x + v[j].y * v[j].y) + (v[j].z * v[j].z + v[j].w * v[j].w); }
        const float rstd = rsqrtf(wave_sum(ss) * (1.f / DM) + EPS);
        v2u* o8 = (v2u*)(XN + (size_t)row * DM) + F.lane;
#pragma unroll
        for (int j = 0; j < 8; ++j) { const int c0 = 4 * (64 * j + F.lane);
            const f32x4 g = *(const f32x4*)(in_g_pre_mix + c0), sh = *(const f32x4*)(mv + c0), sc = *(const f32x4*)(mv + 2048 + c0);
            const f32x4 y = (v[j] * rstd * g) * (sc + 1.f) + sh;
            v2u w; w.x = pk2(y.x, y.y); w.y = pk2(y.z, y.w); o8[64 * j] = w; }
    }
}

__device__ __forceinline__ void p3_rope(Frame& F) {
    float* ct = (float*)F.lds; float* st = ct + 2048;
    for (int i = F.tid; i < 2048; i += 512) { const int pos = i >> 4, f = i & 15; const float inv = powf(10000.f, -(float)f / 16.f); const float ang = (float)pos * inv; ct[i] = cosf(ang); st[i] = sinf(ang); }
    __syncthreads();
    bf16* P = (bf16*)(F.ws + WS_P);
    const int gw = F.vcu * NWAVES + F.wave, NGW = F.G * NWAVES;
    for (int lr = gw; lr < LROWS; lr += NGW) {
        const int b = lr / SEQ, t = lr % SEQ;
        const int pos = (F.lane & 1) ? (t & 63) : (t >> 6);
        bf16* p = P + (size_t)(b * UROWS_B + CTX + t) * LDP + PC_DQ + 32 * F.lane;
        v4u w[4];
#pragma unroll
        for (int i = 0; i < 4; ++i) w[i] = *(const v4u*)(p + 8 * i);
        v4u o[4];
#pragma unroll
        for (int q = 0; q < 2; ++q)
#pragma unroll
            for (int e = 0; e < 4; ++e) { const int f = 8 * q + 2 * e; const unsigned a = w[q][e], bb = w[2 + q][e];
                const float c0 = ct[pos * 16 + f], s0 = st[pos * 16 + f], c1 = ct[pos * 16 + f + 1], s1 = st[pos * 16 + f + 1];
                const float x0l = bflo(a), x0h = bfhi(a), x1l = bflo(bb), x1h = bfhi(bb);
                o[q][e] = pk2(x0l * c0 - x1l * s0, x0h * c1 - x1h * s1);
                o[2 + q][e] = pk2(x1l * c0 + x0l * s0, x1h * c1 + x0h * s1); }
#pragma unroll
        for (int i = 0; i < 4; ++i) *(v4u*)(p + 8 * i) = o[i];
    }
}

__device__ __forceinline__ void p5_attn(Frame& F) {
    const float* in_g_diff = inptr(I_GDIFF); const float* in_lq1 = inptr(I_LQ1); const float* in_lk1 = inptr(I_LK1); const float* in_lq2 = inptr(I_LQ2); const float* in_lk2 = inptr(I_LK2);
    using namespace attn;
    float lam;
    { float s1 = 0.f, s2 = 0.f; for (int i = 0; i < 64; ++i) { s1 += in_lq1[i] * in_lk1[i]; s2 += in_lq2[i] * in_lk2[i]; } lam = expf(s1) - expf(s2) + 0.2f; }
    const attn::bf16* P = (const attn::bf16*)(F.ws + WS_P); ::bf16* MIX = (::bf16*)(F.ws + WS_MIX);
    float* scr0 = (float*)(F.ws + WS_XN);
    const int tid = F.tid, wid = tid >> 6, lane = tid & 63, r32 = lane & 31, hi = lane >> 5;
#pragma unroll 1
    for (int u = blockIdx.x; u < BATCH * 8 * (SEQ / 256); u += F.G) {
        const int qb = u % (SEQ / 256), bh = u / (SEQ / 256), b = bh >> 3, h = bh & 7;
        const attn::bf16* Pb = P + (size_t)(b * UROWS_B) * LDP;
#pragma unroll 1
        for (int c = 0; c < 2; ++c) {
            f32x16 o[4]; float rli[16];
            attn_sub<LDP>(Pb + (size_t)(CTX + qb * 256) * LDP + PC_DQ + h * 128 + c * 64, Pb + PC_DK + h * 128 + c * 64, Pb + PC_DV + h * 128, UROWS_B / 64, (char*)F.lds, o, rli);
            for (int d0 = 0; d0 < 4; ++d0) for (int r = 0; r < 16; ++r) scr0[(d0 * 16 + r) * 512 + tid + blockIdx.x * 65536 + c * 32768] = o[d0][r] * rli[r];
        }
        const float* s1p = scr0 + (size_t)blockIdx.x * 65536 + tid; const float* s2p = s1p + 32768;
        ::bf16* mo = MIX + (size_t)(b * SEQ + qb * 256 + wid * 32) * DM + 1024 + h * 128 + r32;
        const float g0 = in_g_diff[r32] * 0.8f, g1 = in_g_diff[32 + r32] * 0.8f, g2 = in_g_diff[64 + r32] * 0.8f, g3 = in_g_diff[96 + r32] * 0.8f;
#pragma unroll 2
        for (int r = 0; r < 16; ++r) {
            const float v0 = s1p[(0 * 16 + r) * 512] - lam * s2p[(0 * 16 + r) * 512], v1 = s1p[(1 * 16 + r) * 512] - lam * s2p[(1 * 16 + r) * 512],
                        v2 = s1p[(2 * 16 + r) * 512] - lam * s2p[(2 * 16 + r) * 512], v3 = s1p[(3 * 16 + r) * 512] - lam * s2p[(3 * 16 + r) * 512];
            float ss = (v0 * v0 + v1 * v1) + (v2 * v2 + v3 * v3);
#pragma unroll
            for (int off = 1; off < 32; off <<= 1) ss += __shfl_xor(ss, off);
            const float rs = rsqrtf(ss * (1.f / 128.f) + EPS);
            ::bf16* mr = mo + (size_t)((r & 3) + 8 * (r >> 2) + 4 * hi) * DM;
            mr[0] = (::bf16)f2bf(v0 * rs * g0); mr[32] = (::bf16)f2bf(v1 * rs * g1); mr[64] = (::bf16)f2bf(v2 * rs * g2); mr[96] = (::bf16)f2bf(v3 * rs * g3);
        }
    }
}

__device__ __forceinline__ void p7_x1(Frame& F) {
    const float* in_g_post_mix = inptr(I_GPOSTMIX); const float* in_g_pre_ffn = inptr(I_GPREFFN); const float* in_x = inptr(I_X);
    float* modl = (float*)F.lds;
    for (int b = 0; b < 2; ++b) { load_mod(F, modl + (b * 3 + 0) * 2048, b, 2 * DM, 2048); load_mod(F, modl + (b * 3 + 1) * 2048, b, 3 * DM, 2048); load_mod(F, modl + (b * 3 + 2) * 2048, b, 4 * DM, 2048); }
    __syncthreads();
    const float* Y = (const float*)(F.ws + WS_Y); bf16* XN2 = (bf16*)(F.ws + WS_XN);
    const int gw = F.vcu * NWAVES + F.wave, NGW = F.G * NWAVES;
    for (int row = gw; row < LROWS; row += NGW) {
        const int b = row / SEQ; const float* mv = modl + b * 3 * 2048;
        const f32x4* yr = (const f32x4*)(Y + (size_t)row * DM) + F.lane; const f32x4* xr = (const f32x4*)(in_x + (size_t)row * DM) + F.lane;
        f32x4 v[8]; float ss = 0.f;
#pragma unroll
        for (int j = 0; j < 8; ++j) { v[j] = yr[64 * j]; ss += (v[j].x * v[j].x + v[j].y * v[j].y) + (v[j].z * v[j].z + v[j].w * v[j].w); }
        const float rstd = rsqrtf(wave_sum(ss) * (1.f / DM) + EPS);
        float s2 = 0.f; f32x4* orow = (f32x4*)(F.out + (size_t)row * DM) + F.lane;
#pragma unroll
        for (int j = 0; j < 8; ++j) { const int c0 = 4 * (64 * j + F.lane);
            const f32x4 g = *(const f32x4*)(in_g_post_mix + c0), ga = *(const f32x4*)(mv + c0);
            v[j] = xr[64 * j] + ga * (v[j] * rstd * g); orow[64 * j] = v[j];
            s2 += (v[j].x * v[j].x + v[j].y * v[j].y) + (v[j].z * v[j].z + v[j].w * v[j].w); }
        const float rstd2 = rsqrtf(wave_sum(s2) * (1.f / DM) + EPS);
        v2u* o8 = (v2u*)(XN2 + (size_t)row * DM) + F.lane;
#pragma unroll
        for (int j = 0; j < 8; ++j) { const int c0 = 4 * (64 * j + F.lane);
            const f32x4 g = *(const f32x4*)(in_g_pre_ffn + c0), sh = *(const f32x4*)(mv + 2048 + c0), sc = *(const f32x4*)(mv + 4096 + c0);
            const f32x4 y = (v[j] * rstd2 * g) * (sc + 1.f) + sh;
            v2u w; w.x = pk2(y.x, y.y); w.y = pk2(y.z, y.w); o8[64 * j] = w; }
    }
}

__device__ __forceinline__ void p9_convact(Frame& F, int b) {
    const float* in_conv_ffn_w = inptr(I_CONVFFNW); const float* in_conv_ffn_b = inptr(I_CONVFFNB);
    const bf16* U = (const bf16*)(F.ws + WS_U); bf16* HM = (bf16*)(F.ws + WS_HMID) + (size_t)b * SEQ * DFF;
    const int nj = DFF / 8;
    for (long it = (long)blockIdx.x * 512 + F.tid; it < (long)SEQ * nj; it += (long)F.G * 512) {
        const int t = (int)(it / nj), j0 = (int)(it % nj) * 8;
        float accg[8], accv[8];
#pragma unroll
        for (int e = 0; e < 8; ++e) { accg[e] = in_conv_ffn_b[j0 + e]; accv[e] = in_conv_ffn_b[DFF + j0 + e]; }
#pragma unroll
        for (int dt = 0; dt < 3; ++dt) { const int tt = t + dt - 1; if (tt < 0 || tt >= SEQ) continue;
            const v4u g = *(const v4u*)(U + (size_t)tt * NUP + j0), v = *(const v4u*)(U + (size_t)tt * NUP + DFF + j0);
            const float* wg = in_conv_ffn_w + (size_t)dt * NUP + j0; const float* wv = wg + DFF;
#pragma unroll
            for (int e = 0; e < 4; ++e) { accg[2 * e] += wg[2 * e] * bflo(g[e]); accg[2 * e + 1] += wg[2 * e + 1] * bfhi(g[e]); accv[2 * e] += wv[2 * e] * bflo(v[e]); accv[2 * e + 1] += wv[2 * e + 1] * bfhi(v[e]); } }
        v4u o;
#pragma unroll
        for (int e = 0; e < 4; ++e) o[e] = pk2(silu_f(accg[2 * e]) * accv[2 * e], silu_f(accg[2 * e + 1]) * accv[2 * e + 1]);
        *(v4u*)(HM + (size_t)t * DFF + j0) = o;
    }
}

__device__ __forceinline__ void p13_final(Frame& F) {
    const float* in_g_post_ffn = inptr(I_GPOSTFFN);
    float* modl = (float*)F.lds;
    for (int b = 0; b < 2; ++b) load_mod(F, modl + b * 2048, b, 5 * DM, 2048);
    __syncthreads();
    const float* Y2 = (const float*)(F.ws + WS_Y2);
    const int gw = F.vcu * NWAVES + F.wave, NGW = F.G * NWAVES;
    for (int row = gw; row < LROWS; row += NGW) {
        const int b = row / SEQ; const float* mv = modl + b * 2048;
        const f32x4* yr = (const f32x4*)(Y2 + (size_t)row * DM) + F.lane; f32x4* orow = (f32x4*)(F.out + (size_t)row * DM) + F.lane;
        f32x4 v[8]; float ss = 0.f;
#pragma unroll
        for (int j = 0; j < 8; ++j) { v[j] = yr[64 * j]; ss += (v[j].x * v[j].x + v[j].y * v[j].y) + (v[j].z * v[j].z + v[j].w * v[j].w); }
        const float rstd = rsqrtf(wave_sum(ss) * (1.f / DM) + EPS);
#pragma unroll
        for (int j = 0; j < 8; ++j) { const int c0 = 4 * (64 * j + F.lane);
            const f32x4 g = *(const f32x4*)(in_g_post_ffn + c0), ga = *(const f32x4*)(mv + c0);
            orow[64 * j] = orow[64 * j] + ga * (v[j] * rstd * g); }
    }
}


namespace ml {
using bf16x8 = __attribute__((ext_vector_type(8))) short;
using s16x4  = __attribute__((ext_vector_type(4))) short;
using f32x16 = __attribute__((ext_vector_type(16))) float;
using u32x4  = __attribute__((ext_vector_type(4))) unsigned;
typedef short v4i16_t __attribute__((ext_vector_type(4)));
#define MFMA32(a, b, c) __builtin_amdgcn_mfma_f32_32x32x16_bf16((a), (b), (c), 0, 0, 0)
__device__ __forceinline__ int crow(int r, int hi) { return (r & 3) + 8 * (r >> 2) + 4 * hi; }
__device__ __forceinline__ unsigned off_a(unsigned row, unsigned ch) { return 2048u * (row >> 3) + 512u * (ch >> 2) + 64u * (row & 7) + 16u * ((ch & 3) ^ ((row >> 2) & 3)); }
struct RdBase { unsigned r[2], t[2], p[2]; };
__device__ __forceinline__ RdBase rd_bases(unsigned lane) {
    const unsigned l31 = lane & 31, h = lane >> 5, y = (l31 >> 2) & 3, blk = (lane >> 4) & 1, q = (lane & 15) >> 2, p = lane & 3, cz = 2 * blk + (p >> 1);
    RdBase B;
    B.r[0] = 2048u * (l31 >> 3) + 64u * (l31 & 7) + 16u * ((0u | h) ^ y);
    B.r[1] = 2048u * (l31 >> 3) + 64u * (l31 & 7) + 16u * ((2u | h) ^ y);
    B.t[0] = 2048u * h + 64u * q + 8u * (p & 1) + 16u * (cz ^ (2 * h + 0));
    B.t[1] = 2048u * h + 64u * q + 8u * (p & 1) + 16u * (cz ^ (2 * h + 1));
    B.p[0] = 64u * (4 * h + q) + 8u * (p & 1) + 16u * (cz ^ (0 + h));
    B.p[1] = 64u * (4 * h + q) + 8u * (p & 1) + 16u * (cz ^ (2 + h));
    return B; }
#define ROW_OFF(rb, s) (8192u * (rb) + 512u * ((s) >> 1))
#define TR_OFF(c, ks, t) (4096u * (ks) + 512u * (c) + 256u * (t))
#define TRP_OFF(c, ks, t) (4096u * (ks) + 2048u * (t) + 512u * (c))
__device__ __forceinline__ bf16x8 ld_row(const LAS unsigned char* tile, unsigned a) { return *(const LAS bf16x8*)(tile + a); }
__device__ __forceinline__ bf16x8 ld_tr2(const LAS unsigned char* tile, unsigned a0, unsigned a1) {
    const s16x4 lo = __builtin_bit_cast(s16x4, __builtin_amdgcn_ds_read_tr16_b64_v4i16((LAS v4i16_t*)(tile + a0)));
    const s16x4 hi = __builtin_bit_cast(s16x4, __builtin_amdgcn_ds_read_tr16_b64_v4i16((LAS v4i16_t*)(tile + a1)));
    return (bf16x8){lo[0], lo[1], lo[2], lo[3], hi[0], hi[1], hi[2], hi[3]}; }
__device__ __forceinline__ unsigned cvtpk(float lo, float hi) { typedef float f2 __attribute__((ext_vector_type(2))); typedef __bf16 b2 __attribute__((ext_vector_type(2)));
    f2 v = {lo, hi}; b2 b = __builtin_convertvector(v, b2); return __builtin_bit_cast(unsigned, b); }

constexpr int SC_OFF = 132096;
constexpr int NCH = 66;
__device__ __forceinline__ int chunk_row0(int b, int jj) { return b * UROWS_B + (jj < 2 ? 128 * jj : CTX + 128 * (jj - 2)); }
constexpr size_t WS_CDC = WS_ASCR;
constexpr size_t WS_SCAL = WS_ASCR + 4 * MiB;
constexpr size_t WS_MST = WS_SCAL + 32 * 1024;
constexpr size_t WS_DN = WS_MST + 16 * 1024;

__device__ __forceinline__ void gate_scalars(const float* GT, const float* bgate, int b, int h, int dir, int jj, int lane, LAS float* gs, LAS float* bs, float& G, float& bL) {
    const int r0 = chunk_row0(b, jj);
    const float bi = bgate[(dir * 2) * 8 + h], bf = bgate[(dir * 2 + 1) * 8 + h];
    const float* g0 = GT + (size_t)(r0 + 2 * lane) * 32; const float* g1 = g0 + 32;
    const float i0 = g0[(dir * 2) * 8 + h] + bi, i1 = g1[(dir * 2) * 8 + h] + bi;
    const float f0 = logsigmoid_f(g0[(dir * 2 + 1) * 8 + h] + bf), f1 = logsigmoid_f(g1[(dir * 2 + 1) * 8 + h] + bf);
    float ps = f0 + f1;
#pragma unroll
    for (int o = 1; o < 64; o <<= 1) { const float y = __shfl_up(ps, o); if (lane >= o) ps += y; }
    const float tot = __shfl(ps, 63);
    float b0, b1;
    if (dir == 0) { b1 = ps; b0 = ps - f1; }
    else { const float excl = ps - (f0 + f1); b0 = tot - excl; b1 = b0 - f0; }
    const float ga = i0 - b0, gb = i1 - b1;
    float mx = fmaxf(ga, gb);
#pragma unroll
    for (int o = 1; o < 64; o <<= 1) mx = fmaxf(mx, __shfl_xor(mx, o));
    gs[2 * lane] = ga; gs[2 * lane + 1] = gb; bs[2 * lane] = b0; bs[2 * lane + 1] = b1;
    G = mx; bL = tot;
}

template <int MODE>
__device__ __forceinline__ void stage_tile(const bf16* P, int r0, int col0, LAS unsigned char* tile, int tid, const LAS float* rw, const float* cw, const float* cb, int cwoff, float scale, int seg0, int seg1) {
#pragma unroll 2
    for (int i = 0; i < 4; ++i) {
        const int id = tid + 512 * i, row = id >> 4, ch = id & 15; const int r = r0 + row;
        const bf16* p = P + (size_t)r * LDP + col0 + 8 * ch;
        const v4u x0 = *(const v4u*)p;
        float y[8];
        if (MODE == 0) { const float w = rw ? rw[row] : 1.f;
#pragma unroll
            for (int e = 0; e < 4; ++e) { y[2 * e] = bflo(x0[e]) * w; y[2 * e + 1] = bfhi(x0[e]) * w; }
        } else {
            v4u xm = {0, 0, 0, 0}, xp = {0, 0, 0, 0};
            if (r - 1 >= seg0) xm = *(const v4u*)(p - LDP);
            if (r + 1 < seg1) xp = *(const v4u*)(p + LDP);
            const float* w0 = cw + cwoff + 8 * ch; const float* bb = cb + cwoff + 8 * ch;
#pragma unroll
            for (int e = 0; e < 4; ++e) {
                const float a0 = w0[2 * e] * bflo(xm[e]) + w0[2048 + 2 * e] * bflo(x0[e]) + w0[4096 + 2 * e] * bflo(xp[e]) + bb[2 * e];
                const float a1 = w0[2 * e + 1] * bfhi(xm[e]) + w0[2048 + 2 * e + 1] * bfhi(x0[e]) + w0[4096 + 2 * e + 1] * bfhi(xp[e]) + bb[2 * e + 1];
                y[2 * e] = silu_f(a0) * scale; y[2 * e + 1] = silu_f(a1) * scale; }
        }
        v4u o; o.x = cvtpk(y[0], y[1]); o.y = cvtpk(y[2], y[3]); o.z = cvtpk(y[4], y[5]); o.w = cvtpk(y[6], y[7]);
        *(LAS v4u*)(tile + off_a(row, ch)) = o;
    }
}

__device__ __forceinline__ void stage1(Frame& F) {
    const float* in_b_gate = inptr(I_BGATE); const float* in_cw = inptr(I_CONVQKW); const float* in_cb = inptr(I_CONVQKB);
    const bf16* P = (const bf16*)(F.ws + WS_P); const float* GT = (const float*)(F.ws + WS_GATES);
    LAS unsigned char* L = (LAS unsigned char*)F.lds;
    LAS unsigned char* Kt = L; LAS unsigned char* Vf = L + 32768; LAS unsigned char* Vb = L + 65536;
    LAS float* sc = (LAS float*)(L + 98304);
    int tid_ = threadIdx.x; asm volatile("" : "+v"(tid_)); const int tid = tid_, lane = tid & 63, wid = __builtin_amdgcn_readfirstlane(tid >> 6);
    const RdBase RB = rd_bases(lane);
#pragma unroll 1
    for (int u = blockIdx.x; u < 16 * NCH; u += F.G) {
        const int bh = u / NCH, jj = u % NCH, b = bh >> 3, h = bh & 7, r0 = chunk_row0(b, jj);
        const int seg0 = b * UROWS_B + (jj < 2 ? 0 : CTX), seg1 = b * UROWS_B + (jj < 2 ? CTX : UROWS_B);
        __syncthreads();
        if (wid < 2) { float G, bL; gate_scalars(GT, in_b_gate, b, h, wid, jj, lane, sc + wid * 256, sc + wid * 256 + 128, G, bL);
            sc[512 + wid * 128 + 2 * lane] = __expf(sc[wid * 256 + 2 * lane] - G); sc[512 + wid * 128 + 2 * lane + 1] = __expf(sc[wid * 256 + 2 * lane + 1] - G);
            if (lane == 0) { float* s = (float*)(F.ws + WS_SCAL) + ((size_t)(bh * 2 + wid) * NCH + jj) * 2; s[0] = G; s[1] = bL; } }
        stage_tile<1>(P, r0, PC_MK + h * 128, Kt, tid, nullptr, in_cw, in_cb, 1024 + h * 128, 0.08838834764831845f, seg0, seg1);
        __syncthreads();
        stage_tile<0>(P, r0, PC_MV + h * 128, Vf, tid, sc + 512, nullptr, nullptr, 0, 1.f, 0, 0);
        stage_tile<0>(P, r0, PC_MV + h * 128, Vb, tid, sc + 640, nullptr, nullptr, 0, 1.f, 0, 0);
        __syncthreads();
        const int dir = wid >> 2, db = wid & 3; const LAS unsigned char* Vw = dir ? Vb : Vf;
        f32x16 acc[4];
#pragma unroll
        for (int c = 0; c < 4; ++c) acc[c] = f32x16{};
        const LAS unsigned char* Kd = Kt + 512 * db;
#pragma unroll
        for (int ks = 0; ks < 8; ++ks) {
            const bf16x8 a = ld_tr2(Kd, RB.t[0] + TR_OFF(0, ks, 0), RB.t[1] + TR_OFF(0, ks, 1));
#pragma unroll
            for (int c = 0; c < 4; ++c) { const bf16x8 bv = ld_tr2(Vw, RB.t[0] + TR_OFF(c, ks, 0), RB.t[1] + TR_OFF(c, ks, 1)); acc[c] = MFMA32(a, bv, acc[c]); }
        }
        if ((tid & 255) < 128) { const int d = tid & 127, dr = tid >> 8; const LAS float* w = sc + 512 + dr * 128; float s = 0.f;
#pragma unroll 8
            for (int r = 0; r < 128; ++r) s += w[r] * bf2f(*(const LAS unsigned short*)(Kt + off_a(r, d >> 3) + (d & 7) * 2));
            ((float*)(F.ws + WS_DN))[((size_t)(bh * 2 + dr) * NCH + jj) * 128 + d] = s; }
        float* dst = (jj < 2 ? (float*)(F.ws + WS_CDC) + ((size_t)(bh * 2 + dir) * 2 + jj) * 16384 : F.out + ((size_t)(bh * 2 + dir) * 64 + (jj - 2)) * 16384) + (32 * db) * 128 + (lane & 31);
        const int hi = lane >> 5;
#pragma unroll
        for (int c = 0; c < 4; ++c)
#pragma unroll
            for (int r = 0; r < 16; ++r) dst[crow(r, hi) * 128 + 32 * c] = acc[c][r];
    }
}

__device__ __forceinline__ void stage2(Frame& F) {
    const int g = blockIdx.x * 512 + F.tid;
    if (g >= 32 * 4096) return;
    const int chain = g >> 12, e4 = g & 4095, dir = chain & 1;
    const float* scal = (const float*)(F.ws + WS_SCAL) + (size_t)chain * NCH * 2;
    f32x4* lat = (f32x4*)(F.out + (size_t)chain * 64 * 16384) + e4; const f32x4* cdc = (const f32x4*)((const float*)(F.ws + WS_CDC) + (size_t)chain * 2 * 16384) + e4;
    f32x4* dn = (f32x4*)((float*)(F.ws + WS_DN) + (size_t)chain * NCH * 128) + e4;
    float* mst = (float*)(F.ws + WS_MST) + (size_t)chain * NCH;
    f32x4 C = {0.f, 0.f, 0.f, 0.f}, n = {0.f, 0.f, 0.f, 0.f}; float m = 0.f;
#pragma unroll
    for (int c = 0; c < 2; ++c) { const int jj = dir ? 1 - c : c; const float G = scal[2 * jj], bL = scal[2 * jj + 1];
        const float M = fmaxf(m, G), dec = __expf(m - M), sca = __expf(G - M);
        if (e4 == 0) mst[jj] = m;
        C = C * dec + cdc[(size_t)jj * 4096] * sca;
        if (e4 < 32) { const f32x4 d = dn[jj * 32]; dn[jj * 32] = n; n = n * dec + d * sca; }
        m = bL + M; }
#pragma unroll 1
    for (int c0 = 0; c0 < 64; c0 += 8) {
        f32x4 d[8];
#pragma unroll
        for (int i = 0; i < 8; ++i) { const int j = dir ? 63 - (c0 + i) : c0 + i; d[i] = lat[(size_t)j * 4096]; }
#pragma unroll
        for (int i = 0; i < 8; ++i) { const int j = dir ? 63 - (c0 + i) : c0 + i, jj = j + 2; const float G = scal[2 * jj], bL = scal[2 * jj + 1];
            const float M = fmaxf(m, G), dec = __expf(m - M), sca = __expf(G - M);
            if (e4 == 0) mst[jj] = m;
            lat[(size_t)j * 4096] = C; C = C * dec + d[i] * sca;
            if (e4 < 32) { const f32x4 dd = dn[jj * 32]; dn[jj * 32] = n; n = n * dec + dd * sca; }
            m = bL + M; }
    }
}

__device__ __forceinline__ void stage3(Frame& F) {
    const float* in_b_gate = inptr(I_BGATE); const float* in_cw = inptr(I_CONVQKW); const float* in_cb = inptr(I_CONVQKB); const float* in_gm = inptr(I_GMLSTM);
    const bf16* P = (const bf16*)(F.ws + WS_P); const float* GT = (const float*)(F.ws + WS_GATES); bf16* MIX = (bf16*)(F.ws + WS_MIX);
    LAS unsigned char* L = (LAS unsigned char*)F.lds;
    LAS unsigned char* Qt = L; LAS unsigned char* Kt = L + 32768; LAS unsigned char* Vt = L + 65536; LAS unsigned char* Ct = L + 98304;
    LAS float* sc = (LAS float*)(L + SC_OFF);
    int tid_ = threadIdx.x; asm volatile("" : "+v"(tid_)); const int tid = tid_, lane = tid & 63, wid = __builtin_amdgcn_readfirstlane(tid >> 6);
    const int tb = wid >> 1, eh = wid & 1, hi = lane >> 5, tl = lane & 31;
    const RdBase RB = rd_bases(lane);
#pragma unroll 1
    for (int u = blockIdx.x; u < 16 * 64; u += F.G) {
        const int bh = u >> 6, j = u & 63, jj = j + 2, b = bh >> 3, h = bh & 7, r0 = chunk_row0(b, jj);
        const int seg0 = b * UROWS_B + CTX, seg1 = (b + 1) * UROWS_B;
        __syncthreads();
        if (wid < 2) { float G, bL; gate_scalars(GT, in_b_gate, b, h, wid, jj, lane, sc + wid * 256, sc + wid * 256 + 128, G, bL);
            const float m0 = ((const float*)(F.ws + WS_MST))[(size_t)(bh * 2 + wid) * NCH + jj]; const float ML = fmaxf(m0, G);
#pragma unroll
            for (int q = 0; q < 2; ++q) { const int t = 2 * lane + q; sc[512 + wid * 128 + t] = __expf(sc[wid * 256 + t] - ML); sc[768 + wid * 128 + t] = __expf(-sc[wid * 256 + 128 + t] - ML); }
            if (lane == 0) sc[1920 + wid] = __expf(m0 - ML);
        } else if (wid < 4) { const int dr = wid - 2; const float* nv = (const float*)(F.ws + WS_DN) + ((size_t)(bh * 2 + dr) * NCH + jj) * 128; sc[1024 + dr * 128 + lane] = nv[lane]; sc[1024 + dr * 128 + 64 + lane] = nv[64 + lane]; }
        stage_tile<1>(P, r0, PC_MQ + h * 128, Qt, tid, nullptr, in_cw, in_cb, h * 128, 1.f, seg0, seg1);
        stage_tile<1>(P, r0, PC_MK + h * 128, Kt, tid, nullptr, in_cw, in_cb, 1024 + h * 128, 0.08838834764831845f, seg0, seg1);
        stage_tile<0>(P, r0, PC_MV + h * 128, Vt, tid, nullptr, nullptr, nullptr, 0, 1.f, 0, 0);
        __syncthreads();
        { const int t = tid & 127, part = tid >> 7; float s0 = 0.f, s1 = 0.f;
#pragma unroll
            for (int c4 = 0; c4 < 4; ++c4) { const v4u qv = *(const LAS v4u*)(Qt + off_a(t, 4 * part + c4)); const LAS float* n0 = sc + 1024 + 32 * part + 8 * c4; const LAS float* n1 = n0 + 128;
#pragma unroll
                for (int e = 0; e < 4; ++e) { const float ql = bflo(qv[e]), qh = bfhi(qv[e]); s0 += ql * n0[2 * e] + qh * n0[2 * e + 1]; s1 += ql * n1[2 * e] + qh * n1[2 * e + 1]; } }
            LAS float* qp = (LAS float*)(L + SC_OFF + 8192);
            qp[(0 * 4 + part) * 128 + t] = s0; qp[(1 * 4 + part) * 128 + t] = s1; }
        f32x16 hsum[2];
#pragma unroll
        for (int c = 0; c < 2; ++c) hsum[c] = f32x16{};
        bf16x8 qf[8];
        { const LAS unsigned char* Qw = Qt + 8192 * tb;
#pragma unroll
          for (int kd = 0; kd < 8; ++kd) qf[kd] = ld_row(Qw, RB.r[kd & 1] + ROW_OFF(0, kd)); }
#pragma unroll 1
        for (int dir = 0; dir < 2; ++dir) {
            __syncthreads();
            { const float* Cg = F.out + ((size_t)(bh * 2 + dir) * 64 + j) * 16384;
#pragma unroll 2
              for (int i = 0; i < 4; ++i) { const int id = tid + 512 * i, e = id & 127, dc = id >> 7;
                float y[8];
#pragma unroll
                for (int q = 0; q < 8; ++q) y[q] = Cg[(size_t)(8 * dc + q) * 128 + e];
                v4u o; o.x = cvtpk(y[0], y[1]); o.y = cvtpk(y[2], y[3]); o.z = cvtpk(y[4], y[5]); o.w = cvtpk(y[6], y[7]);
                *(LAS v4u*)(Ct + off_a(e, dc)) = o; } }
            __syncthreads();
            const LAS float* w = sc + 512 + dir * 128; const LAS float* fl = sc + 768 + dir * 128; const float dec = sc[1920 + dir];
            int tlm = tl; asm volatile("" : "+v"(tlm));
            const int t = 32 * tb + tl;
            bf16x8 pf[8]; float dsum = 0.f;
#pragma unroll
            for (int sb = 0; sb < 4; ++sb) {
                const bool live = dir ? (sb >= tb) : (sb <= tb);
                f32x16 s = f32x16{};
                if (live) {
#pragma unroll
                    for (int kd = 0; kd < 8; ++kd) s = MFMA32(ld_row(Kt, RB.r[kd & 1] + ROW_OFF(sb, kd)), qf[kd], s);
#pragma unroll
                    for (int g4 = 0; g4 < 4; ++g4) { const f32x4 wv = *(const LAS f32x4*)(w + 32 * sb + 8 * g4 + 4 * hi);
#pragma unroll
                        for (int q = 0; q < 4; ++q) s[4 * g4 + q] *= wv[q]; }
                    if (sb == tb) {
#pragma unroll
                        for (int g4 = 0; g4 < 4; ++g4)
#pragma unroll
                            for (int q = 0; q < 4; ++q) { const int sl = 8 * g4 + 4 * hi + q; const bool ok = dir ? (sl >= tlm) : (sl <= tlm); s[4 * g4 + q] = ok ? s[4 * g4 + q] : 0.f; } }
#pragma unroll
                    for (int r = 0; r < 16; ++r) dsum += s[r];
                }
#pragma unroll
                for (int sp = 0; sp < 2; ++sp) { u32x4 pw; pw.x = cvtpk(s[8 * sp + 0], s[8 * sp + 1]); pw.y = cvtpk(s[8 * sp + 2], s[8 * sp + 3]); pw.z = cvtpk(s[8 * sp + 4], s[8 * sp + 5]); pw.w = cvtpk(s[8 * sp + 6], s[8 * sp + 7]);
                    pf[2 * sb + sp] = __builtin_bit_cast(bf16x8, pw); }
            }
            { auto rr = __builtin_amdgcn_permlane32_swap(__float_as_uint(dsum), __float_as_uint(dsum), false, false); dsum = __uint_as_float(rr[0]) + __uint_as_float(rr[1]); }
            if (eh == 0 && hi == 0) { const LAS float* qp = (const LAS float*)(L + SC_OFF + 8192) + dir * 512 + t;
                sc[1536 + t] = dsum + dec * ((qp[0] + qp[128]) + (qp[256] + qp[384])); }
            f32x16 acc[2];
            const LAS unsigned char* Cw = Ct + 8192 * (2 * eh); const LAS unsigned char* Vw = Vt + 512 * (2 * eh);
#pragma unroll
            for (int c = 0; c < 2; ++c) { acc[c] = f32x16{};
#pragma unroll
                for (int kd = 0; kd < 8; ++kd) acc[c] = MFMA32(qf[kd], ld_row(Cw, RB.r[kd & 1] + ROW_OFF(c, kd)), acc[c]);
#pragma unroll
                for (int r = 0; r < 16; ++r) acc[c][r] *= dec; }
#pragma unroll
            for (int sb = 0; sb < 4; ++sb) {
                const bool live = dir ? (sb >= tb) : (sb <= tb);
                if (live) {
#pragma unroll
                    for (int sp = 0; sp < 2; ++sp)
#pragma unroll
                        for (int c = 0; c < 2; ++c) acc[c] = MFMA32(pf[2 * sb + sp], ld_tr2(Vw, RB.p[0] + TRP_OFF(c, 2 * sb + sp, 0), RB.p[1] + TRP_OFF(c, 2 * sb + sp, 1)), acc[c]);
                }
            }
            __syncthreads();
#pragma unroll
            for (int g4 = 0; g4 < 4; ++g4) { const f32x4 dv = *(const LAS f32x4*)(sc + 1536 + 32 * tb + 8 * g4 + 4 * hi), fv = *(const LAS f32x4*)(fl + 32 * tb + 8 * g4 + 4 * hi);
#pragma unroll
                for (int q = 0; q < 4; ++q) { const float inv = 1.f / fmaxf(fabsf(dv[q]), fv[q]);
                    hsum[0][4 * g4 + q] += acc[0][4 * g4 + q] * inv; hsum[1][4 * g4 + q] += acc[1][4 * g4 + q] * inv; } }
        }
        int lq = lane; asm volatile("" : "+v"(lq));
        const int hi2 = lq >> 5, tl2 = lq & 31;
        float ss[16];
#pragma unroll
        for (int r = 0; r < 16; ++r) { float v = hsum[0][r] * hsum[0][r] + hsum[1][r] * hsum[1][r];
#pragma unroll
            for (int o = 1; o < 32; o <<= 1) v += __shfl_xor(v, o);
            ss[r] = v; }
        if (tl2 == 0) {
#pragma unroll
            for (int r = 0; r < 16; ++r) sc[1664 + eh * 128 + 32 * tb + crow(r, hi2)] = ss[r]; }
        __syncthreads();
        bf16* mo = MIX + (size_t)(b * SEQ + 128 * j + 32 * tb + 4 * hi2) * DM + h * 128 + 64 * eh + tl2;
        const bf16* og = P + (size_t)(r0 + 32 * tb + 4 * hi2) * LDP + PC_MO + h * 128 + 64 * eh + tl2;
        const LAS float* sq = sc + 1664 + 32 * tb + 4 * hi2;
        const float g0 = in_gm[h * 128 + 64 * eh + tl2], g1 = in_gm[h * 128 + 64 * eh + 32 + tl2];
#pragma unroll
        for (int r = 0; r < 16; ++r) { const int row = (r & 3) + 8 * (r >> 2); const float rs = rsqrtf((sq[row] + sq[128 + row]) * (1.f / 128.f) + EPS);
            mo[(size_t)row * DM] = (bf16)f2bf(hsum[0][r] * rs * g0 * sigmoid_f(bf2f(og[(size_t)row * LDP])));
            mo[(size_t)row * DM + 32] = (bf16)f2bf(hsum[1][r] * rs * g1 * sigmoid_f(bf2f(og[(size_t)row * LDP + 32]))); }
    }
}
#undef MFMA32
}

#define GAS __attribute__((address_space(1)))
typedef GAS unsigned gu32;
#define RLX_AGENT __ATOMIC_RELAXED, __HIP_MEMORY_SCOPE_AGENT
#define XB_TMO      128
#define XB_XCNT(j)  (256  + 64 * (j))
#define XB_XSUB(j)  (1280 + 64 * (j))
#define XB_XGEN(j)  (2304 + 64 * (j))
#define XB_TOP      3328
#define XB_TOPGEN   3392
#define XCD_BAR_WORDS 3456
#define XB_SPIN_CAP (1u << 25)

__device__ __forceinline__ unsigned xb_ld(unsigned* p)              { return __hip_atomic_load(p, __ATOMIC_RELAXED, __HIP_MEMORY_SCOPE_AGENT); }
__device__ __forceinline__ unsigned xb_add(unsigned* p, unsigned v) { return __hip_atomic_fetch_add(p, v, __ATOMIC_RELAXED, __HIP_MEMORY_SCOPE_AGENT); }
__device__ __forceinline__ unsigned xb_xcc_id() { return (unsigned)__builtin_amdgcn_s_getreg((3 << 11) | 20) & 0xFu; }
#define XB_SPIN(cond, bar) do { unsigned _sp = 0; while (cond) { __builtin_amdgcn_s_sleep(1); \
    if ((++_sp & 255u) == 0u) { if (xb_ld(&(bar)[XB_TMO])) break; if (_sp > XB_SPIN_CAP) { atomicAdd(&(bar)[XB_TMO], 1u); break; } } } } while (0)

struct XcdBarrier {
    unsigned* bar; unsigned x;
    volatile LAS unsigned* st;
};

__device__ __forceinline__ XcdBarrier xcd_barrier_post(unsigned* bar, volatile LAS unsigned* st) {
    XcdBarrier b; b.bar = bar; b.x = xb_xcc_id(); b.st = st;
    if (threadIdx.x == 0) (void)xb_add(&bar[XB_XCNT(b.x)], 1u);
    return b;
}
__device__ __forceinline__ void xcd_barrier_complete(unsigned* bar, unsigned x, unsigned& nloc, unsigned& nx) {
    const unsigned G = gridDim.x * gridDim.y * gridDim.z;
    unsigned sum, cnt, mine, sp = 0u;
    for (;;) {
        sum = 0u; cnt = 0u; mine = 0u;
#pragma unroll
        for (unsigned j = 0; j < 16; ++j) { const unsigned c = xb_ld(&bar[XB_XCNT(j)]); sum += c; cnt += (c > 0u) ? 1u : 0u; mine = (j == x) ? c : mine; }
        if (sum == G) break;
        __builtin_amdgcn_s_sleep(1);
        if ((++sp & 255u) == 0u) { if (xb_ld(&bar[XB_TMO])) break; if (sp > XB_SPIN_CAP) { atomicAdd(&bar[XB_TMO], 1u); break; } }
    }
    nloc = mine > 0u ? mine : 1u; nx = cnt > 0u ? cnt : 1u;
}

__device__ __forceinline__ void xcd_barrier(const XcdBarrier& b) {
    asm volatile("s_waitcnt vmcnt(0)" ::: "memory");
    __syncthreads();
    if (threadIdx.x == 0) {
        unsigned* bar = b.bar;
        __builtin_amdgcn_s_waitcnt(0);
        unsigned nloc = b.st[0], nx = b.st[1];
        if (nloc == 0u) { xcd_barrier_complete(bar, b.x, nloc, nx); b.st[0] = nloc; b.st[1] = nx; }
        const unsigned old = xb_add(&bar[XB_XSUB(b.x)], 1u);
        const unsigned gen = old / nloc;
        if (old + 1u == (gen + 1u) * nloc) {
            __builtin_amdgcn_fence(__ATOMIC_RELEASE, "agent");
            asm volatile("s_waitcnt vmcnt(0)" ::: "memory");
            const unsigned og = xb_add(&bar[XB_TOP], 1u);
            const unsigned tg = og / nx;
            if (og + 1u == (tg + 1u) * nx) xb_add(&bar[XB_TOPGEN], 1u);
            else XB_SPIN(xb_ld(&bar[XB_TOPGEN]) == tg, bar);
            __builtin_amdgcn_fence(__ATOMIC_ACQUIRE, "agent");
            xb_add(&bar[XB_XGEN(b.x)], 1u);
            asm volatile("s_waitcnt vmcnt(0)" ::: "memory");
        } else {
            XB_SPIN(xb_ld(&bar[XB_XGEN(b.x)]) == gen, bar);
            __builtin_amdgcn_fence(__ATOMIC_ACQUIRE, "agent");
            asm volatile("s_waitcnt vmcnt(0)" ::: "memory");
        }
    }
    __syncthreads();
}


#ifndef MK_N_LAUNCHES
#define MK_N_LAUNCHES 1
#endif
constexpr int N_PHASES = 14;
struct Args { const float* in[25]; float* out; unsigned char* ws; int ph_lo, ph_hi; };
template <int PH_LO, int PH_HI>
__global__ void __launch_bounds__(NWAVES * 64, 2) fwd_kernel(Args args) {
    extern __shared__ __attribute__((aligned(16))) unsigned char lds[];
    Frame F;
    F.lds = lds; F.tid = threadIdx.x; F.lane = F.tid & 63; F.wave = __builtin_amdgcn_readfirstlane(F.tid >> 6);
    F.G = gridDim.x; { const int bx = blockIdx.x; F.vcu = (F.G % 8 == 0) ? (bx % 8) * (F.G / 8) + bx / 8 : bx; }
    F.out = args.out; F.ws = args.ws;
    constexpr int lo = PH_LO, hi = PH_HI;
    PG8_LAS unsigned char* ring = (PG8_LAS unsigned char*)lds;
    XcdBarrier bar; bar.bar = nullptr; bar.x = 0; bar.st = nullptr;
    if constexpr (hi - lo > 1) {
        for (int u = F.tid; u < (LDS_BYTES - LDSCTL_OFF) / 4; u += NWAVES * 64) ((LAS unsigned*)((LAS unsigned char*)lds + LDSCTL_OFF))[u] = 0u;
        __syncthreads();
        bar = xcd_barrier_post((unsigned*)(F.ws + WS_CTL) + CW_BAR, (volatile LAS unsigned*)((LAS unsigned char*)lds + MISC_OFF) + 8);
    }
#define IN(k) (lo <= (k) && (k) < hi)
#define SEAM(k) do { if constexpr (IN(k) && IN((k) + 1)) xcd_barrier(bar); } while (0)
    if constexpr (IN(0)) p0_prologue(F);
    SEAM(0);
    if constexpr (IN(1)) p1_xn(F);
    SEAM(1);
    if constexpr (IN(2)) { pg8::Gemm g{(const pg8::bf16_t*)(F.ws + WS_XN), (const pg8::bf16_t*)(F.ws + WS_WIN), UROWS, NPAD, DM}; pg8::StaticOrder S; S.init(UROWS, NPAD, F.G, (int)blockIdx.x);
        pg8::EpiBf16 E{(pg8::bf16_t*)(F.ws + WS_P), LDP, (float*)(F.ws + WS_GATES), LDP / 256};
        pg8::gemm_phase<pg8::EpiBf16, pg8::StaticOrder, true, true>(ring, g, S, E); }
    SEAM(2);
    if constexpr (IN(3)) { p3_rope(F); ml::stage1(F); }
    SEAM(3);
    if constexpr (IN(4)) ml::stage2(F);
    SEAM(4);
    if constexpr (IN(5)) { ml::stage3(F); p5_attn(F); }
    SEAM(5);
    if constexpr (IN(6)) { pg8::Gemm g{(const pg8::bf16_t*)(F.ws + WS_MIX), (const pg8::bf16_t*)(F.ws + WS_WOUT), LROWS, DM, DM}; pg8::StaticOrder S; S.init(LROWS, DM, F.G, (int)blockIdx.x);
        pg8::EpiF32 E{(float*)(F.ws + WS_Y), DM};
        pg8::gemm_phase<pg8::EpiF32, pg8::StaticOrder, true, true>(ring, g, S, E); }
    SEAM(6);
    if constexpr (IN(7)) p7_x1(F);
    SEAM(7);
    if constexpr (IN(8)) { pg8::Gemm g{(const pg8::bf16_t*)(F.ws + WS_XN), (const pg8::bf16_t*)(F.ws + WS_WUP), SEQ, NUP, DM}; pg8::StaticOrder S; S.init(SEQ, NUP, F.G, (int)blockIdx.x);
        pg8::EpiBf16 E{(pg8::bf16_t*)(F.ws + WS_U), NUP, nullptr, -1};
        pg8::gemm_phase<pg8::EpiBf16, pg8::StaticOrder, true, true>(ring, g, S, E); }
    SEAM(8);
    if constexpr (IN(9)) p9_convact(F, 0);
    SEAM(9);
    if constexpr (IN(10)) { pg8::Gemm g{(const pg8::bf16_t*)(F.ws + WS_XN) + (size_t)SEQ * DM, (const pg8::bf16_t*)(F.ws + WS_WUP), SEQ, NUP, DM}; pg8::StaticOrder S; S.init(SEQ, NUP, F.G, (int)blockIdx.x);
        pg8::EpiBf16 E{(pg8::bf16_t*)(F.ws + WS_U), NUP, nullptr, -1};
        pg8::gemm_phase<pg8::EpiBf16, pg8::StaticOrder, true, true>(ring, g, S, E); }
    SEAM(10);
    if constexpr (IN(11)) p9_convact(F, 1);
    SEAM(11);
    if constexpr (IN(12)) { pg8::Gemm g{(const pg8::bf16_t*)(F.ws + WS_HMID), (const pg8::bf16_t*)(F.ws + WS_WDN), LROWS, DM, DFF}; pg8::StaticOrder S; S.init(LROWS, DM, F.G, (int)blockIdx.x);
        pg8::EpiF32 E{(float*)(F.ws + WS_Y2), DM};
        pg8::gemm_phase<pg8::EpiF32, pg8::StaticOrder, true, true>(ring, g, S, E); }
    SEAM(12);
    if constexpr (IN(13)) p13_final(F);
#undef IN
#undef SEAM
}

extern "C" void kernel_launch(void* const* d_in, const int* in_sizes, int n_in, void* d_out, int out_size, void* d_ws, size_t ws_size, hipStream_t stream) {
    static int grid = 0;
    if (grid == 0) {
        if (n_in != 25 || in_sizes[0] != LROWS * DM || out_size != LROWS * DM || ws_size < WS_END) { fprintf(stderr, "kernel_launch: unexpected shapes / workspace (n_in %d, ws %zu, need %zu)\n", n_in, ws_size, (size_t)WS_END); grid = -1; return; }
        bool ok = true;
#define SETATTR(a, b) ok = ok && (hipFuncSetAttribute((const void*)fwd_kernel<a, b>, hipFuncAttributeMaxDynamicSharedMemorySize, LDS_BYTES) == hipSuccess)
#if MK_N_LAUNCHES == 1
        SETATTR(0, N_PHASES);
#else
        SETATTR(0, 1); SETATTR(1, 2); SETATTR(2, 3); SETATTR(3, 4); SETATTR(4, 5); SETATTR(5, 6); SETATTR(6, 7); SETATTR(7, 8); SETATTR(8, 9); SETATTR(9, 10); SETATTR(10, 11); SETATTR(11, 12); SETATTR(12, 13); SETATTR(13, 14);
#endif
#undef SETATTR
        if (!ok) { fprintf(stderr, "kernel_launch: hipFuncSetAttribute failed\n"); grid = -1; return; }
        int dev = 0, cus = 0, per_cu = 0; (void)hipGetDevice(&dev); (void)hipDeviceGetAttribute(&cus, hipDeviceAttributeMultiprocessorCount, dev);
#if MK_N_LAUNCHES == 1
        if (hipOccupancyMaxActiveBlocksPerMultiprocessor(&per_cu, (const void*)fwd_kernel<0, N_PHASES>, NWAVES * 64, LDS_BYTES) != hipSuccess || per_cu < 1) { fprintf(stderr, "kernel_launch: occupancy query says %d blocks per CU\n", per_cu); (void)hipGetLastError(); }
#endif
        grid = cus > 0 ? cus : 256;
    }
    if (grid < 0) return;
    (void)hipMemsetAsync((char*)d_ws + WS_CTL, 0, CTL_ZERO_BYTES, stream);
    Args a{};
    for (int i = 0; i < 25; ++i) a.in[i] = (const float*)d_in[i];
    a.out = (float*)d_out; a.ws = (unsigned char*)d_ws;
#if MK_N_LAUNCHES == 1
    hipLaunchKernelGGL((fwd_kernel<0, N_PHASES>), dim3(grid), dim3(NWAVES * 64), LDS_BYTES, stream, a);
#else
#define LAUNCH(p) hipLaunchKernelGGL((fwd_kernel<p, p + 1>), dim3(grid), dim3(NWAVES * 64), LDS_BYTES, stream, a)
    LAUNCH(0); LAUNCH(1); LAUNCH(2); LAUNCH(3); LAUNCH(4); LAUNCH(5); LAUNCH(6); LAUNCH(7); LAUNCH(8); LAUNCH(9); LAUNCH(10); LAUNCH(11); LAUNCH(12); LAUNCH(13);
#undef LAUNCH
#endif
}
```

```cpp
#include <hip/hip_runtime.h>
#include <hip/hip_bf16.h>
#include <cstdio>
#include <cstdint>
#include <cmath>

namespace pg8 {
#define PG8_LAS __attribute__((address_space(3)))
typedef unsigned short bf16_t;
typedef short bf16x8 __attribute__((ext_vector_type(8)));
typedef float f32x4 __attribute__((ext_vector_type(4)));
typedef unsigned u32x4 __attribute__((ext_vector_type(4)));
typedef unsigned u32x2 __attribute__((ext_vector_type(2)));
typedef float f32x2 __attribute__((ext_vector_type(2)));
constexpr int BM = 256, BK = 64, HALF = 128, HTB = HALF * BK * 2  , STAGE_BYTES = 8 * HTB, NXCD = 8, WGM = 8;

__host__ __device__ __forceinline__ int lds_byte(int r, int c) { const int st = (r >> 4) * 2 + (c >> 5), rr = r & 15, cc = c & 31, ob = rr * 64 + cc * 2; return st * 1024 + (ob ^ (((ob >> 9) & 1) << 5)); }
__host__ __device__ __forceinline__ void stage_rc(int b, int& R, int& C) { const int st = b / 1024, sb = b % 1024, swz = sb ^ (((sb >> 9) & 1) << 5); R = (st >> 1) * 16 + swz / 64; C = (st & 1) * 32 + (swz % 64) / 2; }
__host__ __device__ __forceinline__ int perm32(int rho) { const int n = rho >> 4, i = rho & 15; return 8 * (i >> 2) + 4 * n + (i & 3); }

struct Unit { int pm, pn; };
struct Gemm { const bf16_t* A; const bf16_t* Bt; int M, N, K; };

struct StaticOrder {
    int nM, nN, nwg, G, c;
    __host__ __device__ void init(int M, int N, int G_, int c_) { nM = M / BM; nN = N / BM; nwg = nM * nN; G = G_; c = c_; }
    __host__ __device__ bool next(int i, Unit& u) const {
        const long L = (long)i * G + c; if (L >= nwg) return false;
        int wgid = (int)L; { const int q = nwg / NXCD, r = nwg % NXCD, xcd = wgid % NXCD, off = wgid / NXCD; wgid = (xcd < r ? xcd * (q + 1) : r * (q + 1) + (xcd - r) * q) + off; }
        const int nig = WGM * nN, gid = wgid / nig, fm = gid * WGM, gsz = (nM - fm) < WGM ? (nM - fm) : WGM;
        u.pm = fm + ((wgid % nig) % gsz); u.pn = (wgid % nig) / gsz; return true;
    }
    __device__ __forceinline__ void a_ready(const Unit&) const {}
    __device__ __forceinline__ void done(const Unit&) const {}
};


__device__ __forceinline__ unsigned cvt_pk_bf16(float lo, float hi) { unsigned r; asm volatile("v_cvt_pk_bf16_f32 %0, %1, %2" : "=v"(r) : "v"(lo), "v"(hi)); return r; }

struct EpiBf16 {
    static constexpr bool PERM = true, AFTER_DRAIN = false;
    bf16_t* O; int ldc; float* gates; int gate_tile;
    __device__ __forceinline__ void operator()(const f32x4 (&acc)[2][2][4][2], const Unit& u, int wr, int wc, int fr, int fq) const {
        const int row0 = u.pm * BM + wr * 64 + fr;
        if (u.pn == gate_tile) {
            if (wc == 0) {
#pragma unroll
                for (int ai = 0; ai < 2; ++ai)
#pragma unroll
                    for (int m = 0; m < 4; ++m) { float* g = gates + (size_t)(row0 + ai * HALF + m * 16) * 32 + 8 * fq;
                        *(f32x4*)(g) = acc[ai][0][m][0]; *(f32x4*)(g + 4) = acc[ai][0][m][1]; }
            }
            return;
        }
        const int col0 = u.pn * BM + wc * 32 + 8 * fq;
#pragma unroll
        for (int ai = 0; ai < 2; ++ai)
#pragma unroll
            for (int m = 0; m < 4; ++m) { bf16_t* rowp = O + (size_t)(row0 + ai * HALF + m * 16) * ldc + col0;
#pragma unroll
                for (int bj = 0; bj < 2; ++bj) { const f32x4 v0 = acc[ai][bj][m][0], v1 = acc[ai][bj][m][1];
                    u32x4 w; w.x = cvt_pk_bf16(v0[0], v0[1]); w.y = cvt_pk_bf16(v0[2], v0[3]); w.z = cvt_pk_bf16(v1[0], v1[1]); w.w = cvt_pk_bf16(v1[2], v1[3]);
                    *(u32x4*)(rowp + bj * HALF) = w; } }
    }
};
__device__ __forceinline__ float dpp_ror1(float v) { return __builtin_bit_cast(float, __builtin_amdgcn_update_dpp(0, __builtin_bit_cast(int, v), 0x121, 0xf, 0xf, false)); }
__device__ __forceinline__ float dpp_rol1(float v) { return __builtin_bit_cast(float, __builtin_amdgcn_update_dpp(0, __builtin_bit_cast(int, v), 0x12f, 0xf, 0xf, false)); }
__device__ __forceinline__ float silu_e(float x) { return x * __builtin_amdgcn_rcpf(1.f + __expf(-x)); }
struct EpiFfn {
    static constexpr bool PERM = true, AFTER_DRAIN = false;
    bf16_t* H; int ldh; const float* cw; const float* cb; int nup, dff; float* edge; PG8_LAS float* xl;
    __device__ __forceinline__ void operator()(const f32x4 (&acc)[2][2][4][2], const Unit& u, int wr, int wc, int fr, int fq) const {
#pragma unroll
        for (int ai = 0; ai < 2; ++ai) { const int sg = 2 * ai + wr;
#pragma unroll
            for (int bj = 0; bj < 2; ++bj)
#pragma unroll
                for (int n = 0; n < 2; ++n) { PG8_LAS f32x4* p = (PG8_LAS f32x4*)xl + ((((sg * 2) * 4 + wc) * 2 + bj) * 2 + n) * 4 + fq;
                    if (fr == 0) p[0] = acc[ai][bj][0][n];
                    if (fr == 15) p[64] = acc[ai][bj][3][n]; } }
        asm volatile("s_waitcnt lgkmcnt(0)" ::: "memory"); __builtin_amdgcn_s_barrier(); asm volatile("" ::: "memory");
        const int npn = nup / BM; const int colh = u.pn * HALF + wc * 32 + 8 * fq;
        float* eb = edge + (size_t)(u.pm * npn + u.pn) * 1024;
#pragma unroll
        for (int ai = 0; ai < 2; ++ai) { const int sg = 2 * ai + wr;
#pragma unroll
            for (int n = 0; n < 2; ++n) {
                unsigned hpk[4][2];
#pragma unroll
                for (int hf = 0; hf < 2; ++hf) {
                    f32x2 sgv[4];
#pragma unroll
                    for (int bj = 0; bj < 2; ++bj) {
                        const int wcol = bj * dff + colh + 4 * n + 2 * hf;
                        const f32x2 w0 = *(const f32x2*)(cw + wcol), w1 = *(const f32x2*)(cw + nup + wcol), w2 = *(const f32x2*)(cw + 2 * nup + wcol), bb = *(const f32x2*)(cb + wcol);
                        const PG8_LAS f32x2* xp = (const PG8_LAS f32x2*)xl + (((wc * 2 + bj) * 2 + n) * 4 + fq) * 2 + hf;
                        f32x2 rprev = {0.f, 0.f};
                        if (sg > 0) rprev = xp[((sg - 1) * 128 + 64) * 2];
#pragma unroll
                        for (int m = 0; m < 4; ++m) {
                            const f32x2 cur = {acc[ai][bj][m][n][2 * hf], acc[ai][bj][m][n][2 * hf + 1]}; f32x2 rr, rl, rn;
#pragma unroll
                            for (int i = 0; i < 2; ++i) { rr[i] = dpp_ror1(cur[i]); rl[i] = dpp_rol1(cur[i]); }
                            if (m < 3) {
#pragma unroll
                                for (int i = 0; i < 2; ++i) rn[i] = dpp_rol1(acc[ai][bj][m < 3 ? m + 1 : 3][n][2 * hf + i]);
                            } else { rn = (f32x2){0.f, 0.f}; if (sg < 3) rn = xp[((sg + 1) * 128) * 2]; }
                            const f32x2 pv = fr > 0 ? rr : rprev, nx = fr < 15 ? rl : rn;
                            const f32x2 c = w0 * pv + w1 * cur + w2 * nx + bb;
                            rprev = rr;
                            if (m == 0) { if (sg == 0 && fr == 0) { float* e = eb + bj * HALF + wc * 32 + 8 * fq + 4 * n + 2 * hf; *(f32x2*)e = c; *(f32x2*)(e + 256) = cur; } }
                            if (m == 3) { if (sg == 3 && fr == 15) { float* e = eb + 512 + bj * HALF + wc * 32 + 8 * fq + 4 * n + 2 * hf; *(f32x2*)e = c; *(f32x2*)(e + 256) = cur; } }
                            if (bj == 0) { sgv[m][0] = silu_e(c[0]); sgv[m][1] = silu_e(c[1]); } else sgv[m] = sgv[m] * c;
                        }
                    }
#pragma unroll
                    for (int m = 0; m < 4; ++m) hpk[m][hf] = cvt_pk_bf16(sgv[m][0], sgv[m][1]);
                }
#pragma unroll
                for (int m = 0; m < 4; ++m) { u32x2 w; w.x = hpk[m][0]; w.y = hpk[m][1];
                    *(u32x2*)(H + (size_t)(u.pm * BM + ai * HALF + wr * 64 + m * 16 + fr) * ldh + colh + 4 * n) = w; }
                asm volatile("" ::: "memory");
            }
        }
    }
};
struct EpiF32 {
    static constexpr bool PERM = false, AFTER_DRAIN = false;
    float* O; int ldc;
    __device__ __forceinline__ void operator()(const f32x4 (&acc)[2][2][4][2], const Unit& u, int wr, int wc, int fr, int fq) const {
        const int row0 = u.pm * BM + wr * 64 + fr, col0 = u.pn * BM + wc * 32 + 4 * fq;
#pragma unroll
        for (int ai = 0; ai < 2; ++ai)
#pragma unroll
            for (int m = 0; m < 4; ++m) { float* rowp = O + (size_t)(row0 + ai * HALF + m * 16) * ldc + col0;
#pragma unroll
                for (int bj = 0; bj < 2; ++bj)
#pragma unroll
                    for (int n = 0; n < 2; ++n) *(f32x4*)(rowp + bj * HALF + n * 16) = acc[ai][bj][m][n]; }
    }
};

template <class Epi, class Sched, bool ALIGN_EPI = false, bool SP2 = false>
__device__ __forceinline__ void gemm_phase(PG8_LAS unsigned char* lds, const Gemm g, const Sched& S, const Epi& E) {
    int tid_ = threadIdx.x; asm volatile("" : "+v"(tid_));
    const int tid = tid_, wid = __builtin_amdgcn_readfirstlane(tid >> 6), lane = tid & 63, wr = wid >> 2, wc = wid & 3, fr = lane & 15, fq = lane >> 4;
    const int K = g.K, nt = K / BK;
    unsigned voffA[2], voffB[2];
#pragma unroll
    for (int i = 0; i < 2; ++i) { int R, C; stage_rc(tid * 16 + i * 8192, R, C); const int Rb = Epi::PERM ? ((R & ~31) + perm32(R & 31)) : R;
        voffA[i] = (unsigned)(R * K + C) * 2u; voffB[i] = (unsigned)(Rb * K + C) * 2u; }
    const size_t kstep = (size_t)(BK * 2);
    const size_t hstep = (size_t)HALF * K * 2;
    const size_t tstep = 2 * hstep;
    const unsigned ldsw = (unsigned)wid * 1024u;
    const int aoff = lds_byte(wr * 64 + fr, fq * 8), boff = lds_byte(wc * 32 + fr, fq * 8);
#define PG8_SA(b, h) (((b) * 2 + (h)) * HTB)
#define PG8_SB(b, h) ((4 + (b) * 2 + (h)) * HTB)
#define PG8_STAGE(bufoff, gbase, voff) do { _Pragma("unroll") for (int _i = 0; _i < 2; ++_i) \
        __builtin_amdgcn_global_load_lds((const unsigned*)((const char*)(gbase) + (voff)[_i]), (PG8_LAS unsigned*)(lds + (bufoff) + ldsw + _i * 8192), 16, 0, 0); } while (0)
#define PG8_LDA(dst, b, h) do { _Pragma("unroll") for (int m = 0; m < 4; ++m) _Pragma("unroll") for (int k = 0; k < 2; ++k) dst[m][k] = *(const PG8_LAS bf16x8*)(lds + PG8_SA(b, h) + aoff + m * 2048 + k * 1024); } while (0)
#define PG8_LDB(dst, b, h) do { _Pragma("unroll") for (int n = 0; n < 2; ++n) _Pragma("unroll") for (int k = 0; k < 2; ++k) dst[n][k] = *(const PG8_LAS bf16x8*)(lds + PG8_SB(b, h) + boff + n * 2048 + k * 1024); } while (0)
#define PG8_MMA(ai, bj, At, Bt) do { __builtin_amdgcn_s_setprio(1); _Pragma("unroll") for (int m = 0; m < 4; ++m) _Pragma("unroll") for (int n = 0; n < 2; ++n) _Pragma("unroll") for (int k = 0; k < 2; ++k) \
        acc[ai][bj][m][n] = __builtin_amdgcn_mfma_f32_16x16x32_bf16(Bt[n][k], At[m][k], acc[ai][bj][m][n], 0, 0, 0); __builtin_amdgcn_s_setprio(0); } while (0)
#define PG8_WAIT_V(n) asm volatile("s_waitcnt vmcnt(" #n ")" ::: "memory")
#define PG8_WAIT_L(n) asm volatile("s_waitcnt lgkmcnt(" #n ")" ::: "memory")
#define PG8_BAR __builtin_amdgcn_s_barrier()
#define PG8_SCHED __builtin_amdgcn_sched_barrier(0)
    Unit cur, nxt; int ui = 0;
    if (!S.next(0, cur)) return;
    f32x4 acc[2][2][4][2];
#pragma unroll
    for (int a = 0; a < 2; ++a)
#pragma unroll
        for (int b = 0; b < 2; ++b)
#pragma unroll
            for (int m = 0; m < 4; ++m)
#pragma unroll
                for (int n = 0; n < 2; ++n) acc[a][b][m][n] = (f32x4){0.f, 0.f, 0.f, 0.f};
    bf16x8 At[4][2], B0[2][2], B1[2][2];
    const char* cA = (const char*)g.A + (size_t)cur.pm * tstep; const char* cB = (const char*)g.Bt + (size_t)cur.pn * tstep;
    S.a_ready(cur);
    if constexpr (SP2) {
        PG8_STAGE(PG8_SB(0, 0), cB, voffB); PG8_STAGE(PG8_SB(0, 1), cB + hstep, voffB); PG8_STAGE(PG8_SA(0, 0), cA, voffA); PG8_STAGE(PG8_SA(0, 1), cA + hstep, voffA);
        if (wr == 1) PG8_BAR;
        PG8_WAIT_V(2); PG8_BAR;
        PG8_STAGE(PG8_SB(1, 0), cB + kstep, voffB); PG8_STAGE(PG8_SA(1, 0), cA + kstep, voffA); PG8_STAGE(PG8_SB(1, 1), cB + hstep + kstep, voffB);
        PG8_WAIT_V(6); PG8_BAR;
    } else {
        PG8_STAGE(PG8_SB(0, 0), cB, voffB); PG8_STAGE(PG8_SA(0, 0), cA, voffA); PG8_STAGE(PG8_SB(0, 1), cB + hstep, voffB); PG8_STAGE(PG8_SA(0, 1), cA + hstep, voffA);
        if (wr == 1) PG8_BAR;
        PG8_WAIT_V(4); PG8_BAR;
        PG8_STAGE(PG8_SB(1, 0), cB + kstep, voffB); PG8_STAGE(PG8_SA(1, 0), cA + kstep, voffA); PG8_STAGE(PG8_SB(1, 1), cB + hstep + kstep, voffB);
        PG8_WAIT_V(6); PG8_BAR;
    }
    for (;;) {
        const bool has_next = S.next(ui + 1, nxt);
        const char* nA = has_next ? (const char*)g.A + (size_t)nxt.pm * tstep : cA; const char* nB = has_next ? (const char*)g.Bt + (size_t)nxt.pn * tstep : cB;
        for (int t = 0; t < nt; t += 2) {
            const bool last = (t == nt - 2);
            const char* a1 = cA + (size_t)(t + 1) * kstep;
            const char* a2 = last ? nA : cA + (size_t)(t + 2) * kstep; const char* b2 = last ? nB : cB + (size_t)(t + 2) * kstep;
            const char* a3 = a2 + kstep; const char* b3 = b2 + kstep;
            if (last && has_next) S.a_ready(nxt);
            if constexpr (SP2) {
            PG8_LDB(B0, 0, 0); PG8_LDB(B1, 0, 1); PG8_SCHED; PG8_LDA(At, 0, 0); PG8_STAGE(PG8_SA(1, 1), a1 + hstep, voffA);
            PG8_WAIT_V(8); PG8_WAIT_L(0); PG8_BAR; PG8_MMA(0, 0, At, B0); PG8_MMA(0, 1, At, B1); PG8_BAR; PG8_SCHED;
            PG8_LDA(At, 0, 1); PG8_STAGE(PG8_SB(0, 0), b2, voffB); PG8_STAGE(PG8_SB(0, 1), b2 + hstep, voffB); PG8_STAGE(PG8_SA(0, 0), a2, voffA);
            PG8_WAIT_V(8); PG8_WAIT_L(0); PG8_BAR; PG8_MMA(1, 0, At, B0); PG8_MMA(1, 1, At, B1); PG8_BAR; PG8_SCHED;
            PG8_LDB(B0, 1, 0); PG8_LDB(B1, 1, 1); PG8_SCHED; PG8_LDA(At, 1, 0); PG8_STAGE(PG8_SA(0, 1), a2 + hstep, voffA);
            PG8_WAIT_V(8); PG8_WAIT_L(0); PG8_BAR; PG8_MMA(0, 0, At, B0); PG8_MMA(0, 1, At, B1); PG8_BAR; PG8_SCHED;
            PG8_LDA(At, 1, 1); PG8_STAGE(PG8_SB(1, 0), b3, voffB); PG8_STAGE(PG8_SB(1, 1), b3 + hstep, voffB); PG8_STAGE(PG8_SA(1, 0), a3, voffA);
            PG8_WAIT_V(8); PG8_WAIT_L(0); PG8_BAR; PG8_MMA(1, 0, At, B0); PG8_MMA(1, 1, At, B1); PG8_BAR; PG8_SCHED;
            } else {
            PG8_LDB(B0, 0, 0); PG8_SCHED; PG8_LDA(At, 0, 0); PG8_STAGE(PG8_SA(1, 1), a1 + hstep, voffA);
            PG8_WAIT_L(8); PG8_BAR; PG8_WAIT_L(0); PG8_MMA(0, 0, At, B0); PG8_BAR; PG8_SCHED;
            PG8_LDB(B1, 0, 1); PG8_STAGE(PG8_SB(0, 0), b2, voffB);
            PG8_BAR; PG8_WAIT_L(0); PG8_MMA(0, 1, At, B1); PG8_BAR;
            PG8_LDA(At, 0, 1); PG8_STAGE(PG8_SA(0, 0), a2, voffA);
            PG8_BAR; PG8_WAIT_L(0); PG8_MMA(1, 0, At, B0); PG8_BAR; PG8_SCHED;
            PG8_STAGE(PG8_SB(0, 1), b2 + hstep, voffB);
            PG8_WAIT_V(6); PG8_BAR; PG8_MMA(1, 1, At, B1); PG8_BAR;
            PG8_LDB(B0, 1, 0); PG8_SCHED; PG8_LDA(At, 1, 0); PG8_STAGE(PG8_SA(0, 1), a2 + hstep, voffA);
            PG8_WAIT_L(8); PG8_BAR; PG8_WAIT_L(0); PG8_MMA(0, 0, At, B0); PG8_BAR; PG8_SCHED;
            PG8_LDB(B1, 1, 1); PG8_STAGE(PG8_SB(1, 0), b3, voffB);
            PG8_BAR; PG8_WAIT_L(0); PG8_MMA(0, 1, At, B1); PG8_BAR;
            PG8_LDA(At, 1, 1); PG8_STAGE(PG8_SA(1, 0), a3, voffA);
            PG8_BAR; PG8_WAIT_L(0); PG8_MMA(1, 0, At, B0); PG8_BAR; PG8_SCHED;
            PG8_STAGE(PG8_SB(1, 1), b3 + hstep, voffB);
            PG8_WAIT_V(6); PG8_BAR; PG8_MMA(1, 1, At, B1); PG8_BAR;
            }
        }
        if constexpr (ALIGN_EPI) { if (wr == 0) PG8_BAR; }
        if constexpr (!Epi::AFTER_DRAIN) { E(acc, cur, wr, wc, fr, fq); S.done(cur); }
        if (!has_next) break;
#pragma unroll
        for (int a = 0; a < 2; ++a)
#pragma unroll
            for (int b = 0; b < 2; ++b)
#pragma unroll
                for (int m = 0; m < 4; ++m)
#pragma unroll
                    for (int n = 0; n < 2; ++n) acc[a][b][m][n] = (f32x4){0.f, 0.f, 0.f, 0.f};
        cur = nxt; cA = nA; cB = nB; ++ui;
        if constexpr (ALIGN_EPI) { if (wr == 1) PG8_BAR; }
    }
    PG8_WAIT_V(0);
    if constexpr (!ALIGN_EPI) { if (wr == 0) PG8_BAR; }
    PG8_BAR;
    if constexpr (Epi::AFTER_DRAIN) { E.fused(acc, cur, wr, wc, fr, fq, lds, wid, lane); S.done(cur); }
#undef PG8_SA
#undef PG8_SB
#undef PG8_STAGE
#undef PG8_LDA
#undef PG8_LDB
#undef PG8_MMA
#undef PG8_WAIT_V
#undef PG8_WAIT_L
#undef PG8_BAR
#undef PG8_SCHED
}
}


namespace attn {
using bf16x8 = __attribute__((ext_vector_type(8))) short;
using s16x4  = __attribute__((ext_vector_type(4))) short;
using f32x16 = __attribute__((ext_vector_type(16))) float;
using u32x4  = __attribute__((ext_vector_type(4))) unsigned;
typedef unsigned short bf16;
constexpr int NW = 8, QBLK = 32, KVBLK = 64;
constexpr float SCALE = 0.125f;
constexpr float THR = 8.f;
constexpr int SHM_V = KVBLK * 128 * 2, SHM_K = KVBLK * 64 * 2, SHM_ATTN = 2 * SHM_V + 2 * SHM_K + NW * 64 * 4;
#define KSWZ64(row, ch) ((row) * 128 + ((((ch) ^ (((row) >> 1) & 7))) << 4))
#define SBAR() __builtin_amdgcn_sched_barrier(0)
__device__ __forceinline__ int crow(int r, int hi) { return (r & 3) + 8 * (r >> 2) + 4 * hi; }
__device__ __forceinline__ unsigned cvtpk(float lo, float hi) { unsigned r; asm volatile("v_cvt_pk_bf16_f32 %0, %1, %2" : "=v"(r) : "v"(lo), "v"(hi)); return r; }

__device__ __forceinline__ void partialSM(f32x16& p0, f32x16& p1, float& m_reg, float& mn, float& alpha) {
  constexpr float C = SCALE * 1.4426950408889634f;
  float pmax = p0[0];
#pragma unroll
  for (int r = 1; r < 16; ++r) pmax = fmaxf(pmax, p0[r]);
#pragma unroll
  for (int r = 0; r < 16; ++r) pmax = fmaxf(pmax, p1[r]);
  { auto rr = __builtin_amdgcn_permlane32_swap(__float_as_uint(pmax), __float_as_uint(pmax), false, false);
    pmax = fmaxf(__uint_as_float(rr[0]), __uint_as_float(rr[1])); }
  if (__builtin_expect(__all(pmax - m_reg <= THR / SCALE), 1)) { mn = m_reg; alpha = 1.f; }
  else { mn = fmaxf(m_reg, pmax); alpha = __builtin_amdgcn_exp2f((m_reg - mn) * C); m_reg = mn; }
  float mnC = -mn * C;
#pragma unroll
  for (int r = 0; r < 16; ++r) p0[r] = fmaf(p0[r], C, mnC);
#pragma unroll
  for (int r = 0; r < 16; ++r) p1[r] = fmaf(p1[r], C, mnC);
#pragma unroll
  for (int r = 0; r < 16; ++r) p0[r] = __builtin_amdgcn_exp2f(p0[r]);
}
__device__ __forceinline__ void finishSM(f32x16& p0, f32x16& p1, float alpha, float& l_reg, bf16x8& pa0, bf16x8& pa1, bf16x8& pa2, bf16x8& pa3) {
#pragma unroll
  for (int r = 0; r < 16; ++r) p1[r] = __builtin_amdgcn_exp2f(p1[r]);
  float ps = 0;
#pragma unroll
  for (int r = 0; r < 16; ++r) ps += p0[r];
#pragma unroll
  for (int r = 0; r < 16; ++r) ps += p1[r];
  { auto rr = __builtin_amdgcn_permlane32_swap(__float_as_uint(ps), __float_as_uint(ps), false, false);
    ps = __uint_as_float(rr[0]) + __uint_as_float(rr[1]); }
  l_reg = l_reg * alpha + ps;
#define PK4(P, BASE, OUT) do { unsigned a0 = cvtpk(P[BASE + 0], P[BASE + 1]), a1 = cvtpk(P[BASE + 2], P[BASE + 3]);   \
    unsigned b0 = cvtpk(P[BASE + 4], P[BASE + 5]), b1 = cvtpk(P[BASE + 6], P[BASE + 7]);                              \
    auto r0 = __builtin_amdgcn_permlane32_swap(a0, b0, false, false); auto r1 = __builtin_amdgcn_permlane32_swap(a1, b1, false, false); \
    u32x4 w = {r0[0], r1[0], r0[1], r1[1]}; OUT = *reinterpret_cast<bf16x8*>(&w); } while (0)
  PK4(p0, 0, pa0); PK4(p0, 8, pa1); PK4(p1, 0, pa2); PK4(p1, 8, pa3);
#undef PK4
}
__device__ __forceinline__ void qkt(f32x16& p0, f32x16& p1, const char* Ks, const bf16x8* qr, int r32, int hi) {
  p0 = f32x16{}; p1 = f32x16{};
#pragma unroll
  for (int d0 = 0; d0 < 4; ++d0) { const int ch = 2 * d0 + hi;
    bf16x8 b0 = *reinterpret_cast<const bf16x8*>(Ks + KSWZ64(r32, ch));
    bf16x8 b1 = *reinterpret_cast<const bf16x8*>(Ks + KSWZ64(32 + r32, ch));
    p0 = __builtin_amdgcn_mfma_f32_32x32x16_bf16(b0, qr[d0], p0, 0, 0, 0);
    p1 = __builtin_amdgcn_mfma_f32_32x32x16_bf16(b1, qr[d0], p1, 0, 0, 0); }
}
__device__ __forceinline__ int v_st(int k, int c) { const int kk = (k & ~0xC) | ((k & 4) << 1) | ((k & 8) >> 1); return ((kk >> 3) * 4 + (c >> 5)) * 512 + ((kk & 7) * 32 + (c & 31)) * 2; }
__device__ __forceinline__ int v_rd_base(int lane) { return ((lane & 3) << 3) | (((lane >> 2) & 3) << 6) | (((lane >> 4) & 1) << 5) | (((lane >> 5) & 1) << 8); }
constexpr int v_rd_off(int d0, int ks, int half) { return d0 * 512 + ks * 4096 + half * 2048; }
template <int OFF> __device__ __forceinline__ s16x4 tr_read(int vb) {
  s16x4 r; asm volatile("ds_read_b64_tr_b16 %0, %1 offset:%2" : "=&v"(r) : "v"(vb), "i"(OFF) : "memory"); return r;
}
template <int D0> __device__ __forceinline__ void pv_one(f32x16& od, int vb, bf16x8 pa0, bf16x8 pa1, bf16x8 pa2, bf16x8 pa3) {
  const s16x4 l0 = tr_read<v_rd_off(D0, 0, 0)>(vb), h0 = tr_read<v_rd_off(D0, 0, 1)>(vb), l1 = tr_read<v_rd_off(D0, 1, 0)>(vb), h1 = tr_read<v_rd_off(D0, 1, 1)>(vb);
  const s16x4 l2 = tr_read<v_rd_off(D0, 2, 0)>(vb), h2 = tr_read<v_rd_off(D0, 2, 1)>(vb), l3 = tr_read<v_rd_off(D0, 3, 0)>(vb), h3 = tr_read<v_rd_off(D0, 3, 1)>(vb);
  asm volatile("s_waitcnt lgkmcnt(0)" ::: "memory"); SBAR();
#define PK(L, H) (bf16x8){L[0], L[1], L[2], L[3], H[0], H[1], H[2], H[3]}
  od = __builtin_amdgcn_mfma_f32_32x32x16_bf16(pa0, PK(l0, h0), od, 0, 0, 0);
  od = __builtin_amdgcn_mfma_f32_32x32x16_bf16(pa1, PK(l1, h1), od, 0, 0, 0);
  od = __builtin_amdgcn_mfma_f32_32x32x16_bf16(pa2, PK(l2, h2), od, 0, 0, 0);
  od = __builtin_amdgcn_mfma_f32_32x32x16_bf16(pa3, PK(l3, h3), od, 0, 0, 0);
#undef PK
}
__device__ __forceinline__ void pv_d0(f32x16* o, int vb, bf16x8 pa0, bf16x8 pa1, bf16x8 pa2, bf16x8 pa3) {
  pv_one<0>(o[0], vb, pa0, pa1, pa2, pa3); pv_one<1>(o[1], vb, pa0, pa1, pa2, pa3); pv_one<2>(o[2], vb, pa0, pa1, pa2, pa3); pv_one<3>(o[3], vb, pa0, pa1, pa2, pa3);
}

template <int LD>
__device__ __forceinline__ void attn_sub(const bf16* __restrict__ Qb, const bf16* __restrict__ Kh, const bf16* __restrict__ Vh, int NT, char* lds, f32x16 (&o)[4], float (&rli)[16]) {
  int tid_ = threadIdx.x; asm volatile("" : "+v"(tid_));
  const int tid = tid_, wid = tid >> 6, lane = tid & 63, r32 = lane & 31, hi = lane >> 5;
  char* V_lds = lds; char* K_lds = lds + 2 * SHM_V;
  float* ws = (float*)(lds + 2 * SHM_V + 2 * SHM_K) + wid * 64; float* li_l = ws; float* al_l = ws + 32;
  float m_reg = -1e30f, l_reg = 0; bf16x8 qr[4];
#pragma unroll
  for (int d = 0; d < 4; ++d) o[d] = f32x16{};
  const bf16* Qw = Qb + (long)(wid * QBLK + r32) * LD + hi * 8;
#pragma unroll
  for (int d0 = 0; d0 < 4; ++d0) qr[d0] = *reinterpret_cast<const bf16x8*>(Qw + d0 * 16);
  const int sr = tid >> 4, sc = (tid & 15) * 8, vst0 = v_st(sr, sc), vst1 = v_st(32 + sr, sc);
  const int kr = tid >> 3, kc = tid & 7, kst = KSWZ64(kr, kc);
  const int vb0 = (int)(uintptr_t)V_lds + v_rd_base(lane);
  struct { bf16x8 vs0, vs1, ks0; } sr_[2];
#define SLOAD(i, k0) do { sr_[i].vs0 = *reinterpret_cast<const bf16x8*>(&Vh[(long)((k0) + sr) * LD + sc]); sr_[i].vs1 = *reinterpret_cast<const bf16x8*>(&Vh[(long)((k0) + 32 + sr) * LD + sc]); \
    sr_[i].ks0 = *reinterpret_cast<const bf16x8*>(&Kh[(long)((k0) + kr) * LD + kc * 8]); } while (0)
#define SWRITE(b, i) do { *(bf16x8*)(V_lds + (b) * SHM_V + vst0) = sr_[i].vs0; *(bf16x8*)(V_lds + (b) * SHM_V + vst1) = sr_[i].vs1; \
    *(bf16x8*)(K_lds + (b) * SHM_K + kst) = sr_[i].ks0; } while (0)
#define SWAIT() asm volatile("s_waitcnt vmcnt(3)" ::: "memory")
#define RESC(a) do { if (__any((a) < 1.f)) { if (hi == 0) al_l[r32] = (a); asm volatile("s_waitcnt lgkmcnt(0)" ::: "memory"); \
    _Pragma("unroll") for (int d = 0; d < 4; ++d) _Pragma("unroll") for (int r = 0; r < 16; ++r) o[d][r] *= al_l[crow(r, hi)]; } } while (0)
  f32x16 pA0, pA1, pB0, pB1; float mnA, mnB, alA, alB; bf16x8 pa0, pa1, pa2, pa3;
  constexpr int SE = 0, SO = 1;
  SLOAD(SE, 0); asm volatile("s_waitcnt vmcnt(0)" ::: "memory"); SWRITE(0, SE); __syncthreads();
  qkt(pA0, pA1, K_lds, qr, r32, hi); partialSM(pA0, pA1, m_reg, mnA, alA);
  SLOAD(SO, KVBLK); if (2 < NT) SLOAD(SE, 2 * KVBLK);
  SWAIT(); SWRITE(1, SO); __syncthreads();
  for (int j = 1; j + 1 < NT; j += 2) {
    SBAR(); qkt(pB0, pB1, K_lds + SHM_K, qr, r32, hi);
    finishSM(pA0, pA1, alA, l_reg, pa0, pa1, pa2, pa3); SBAR();
    SLOAD(SO, (j + 2) * KVBLK); SBAR();
    pv_d0(o, vb0, pa0, pa1, pa2, pa3); partialSM(pB0, pB1, m_reg, mnB, alB);
    __syncthreads(); SWAIT(); SWRITE(0, SE);
    RESC(alB); __syncthreads();
    SBAR(); qkt(pA0, pA1, K_lds, qr, r32, hi);
    finishSM(pB0, pB1, alB, l_reg, pa0, pa1, pa2, pa3); SBAR();
    if (j + 3 < NT) SLOAD(SE, (j + 3) * KVBLK); SBAR();
    pv_d0(o, vb0 + SHM_V, pa0, pa1, pa2, pa3); partialSM(pA0, pA1, m_reg, mnA, alA);
    __syncthreads(); SWAIT(); SWRITE(1, SO);
    RESC(alA); __syncthreads();
  }
  SBAR(); qkt(pB0, pB1, K_lds + SHM_K, qr, r32, hi);
  finishSM(pA0, pA1, alA, l_reg, pa0, pa1, pa2, pa3); SBAR();
  pv_d0(o, vb0, pa0, pa1, pa2, pa3); partialSM(pB0, pB1, m_reg, mnB, alB);
  __syncthreads(); RESC(alB);
  finishSM(pB0, pB1, alB, l_reg, pa0, pa1, pa2, pa3); SBAR();
  pv_d0(o, vb0 + SHM_V, pa0, pa1, pa2, pa3);
  if (hi == 0) li_l[r32] = l_reg; asm volatile("s_waitcnt lgkmcnt(0)" ::: "memory");
#pragma unroll
  for (int r = 0; r < 16; ++r) rli[r] = __builtin_amdgcn_rcpf(li_l[crow(r, hi)]);
  __syncthreads();
#undef SLOAD
#undef SWRITE
#undef SWAIT
#undef RESC
}
#undef SBAR
}

constexpr int BATCH = 2, SEQ = 8192, DM = 2048, CTX = 256;
constexpr int UROWS_B = CTX + SEQ;
constexpr int UROWS = BATCH * UROWS_B;
constexpr int LROWS = BATCH * SEQ;
constexpr int IN_COLS = 7200, NPAD = 7424, LDP = 7168;
constexpr int DFF = 5632, NUP = 2 * DFF;
constexpr int NMOD = 6 * DM;
constexpr int PC_MQ = 0, PC_MK = 1024, PC_MV = 2048, PC_MO = 3072, PC_DQ = 4096, PC_DK = 5120, PC_DV = 6144;
constexpr float EPS = 1e-6f;
constexpr int KSL = 8;

constexpr size_t MiB = 1u << 20;
constexpr size_t WS_CTL = 0, CTL_ZERO_BYTES = 1 * MiB;
constexpr size_t WS_MODP = 1 * MiB;
constexpr size_t WS_GATES = 3 * MiB;
constexpr size_t WS_WUP = 6 * MiB;
constexpr size_t WS_WDN = 50 * MiB;
constexpr size_t WS_XN = 72 * MiB;
constexpr size_t WS_ARENA = 138 * MiB;
constexpr size_t WS_WIN = WS_ARENA;
constexpr size_t WS_WOUT = WS_ARENA + 29 * MiB;
constexpr size_t WS_P = WS_ARENA + 37 * MiB;
constexpr size_t WS_MIX = WS_ARENA + 268 * MiB;
constexpr size_t WS_ASCR = WS_ARENA + 332 * MiB;
constexpr size_t WS_Y = WS_P;
constexpr size_t WS_EDGE = WS_ARENA;
constexpr size_t WS_HMID = WS_ARENA + 176 * MiB;
constexpr size_t WS_Y2 = WS_ARENA;
constexpr size_t WS_END = WS_ARENA + 364 * MiB;
static_assert(WS_HMID + (size_t)LROWS * DFF * 2 <= WS_END && WS_ASCR + 32 * MiB <= WS_END && WS_MIX >= WS_P + (size_t)UROWS * LDP * 2, "ws map");

constexpr int RING_BYTES = 131072, LDS_BYTES = 147456;
constexpr int LDSCTL_OFF = RING_BYTES, MISC_OFF = LDSCTL_OFF + 320;
constexpr int CW_BAR = 4096;
constexpr int NWAVES = 8;

#define LAS __attribute__((address_space(3)))
typedef unsigned short bf16;
typedef unsigned v4u __attribute__((ext_vector_type(4)));
typedef unsigned v2u __attribute__((ext_vector_type(2)));
typedef float f32x4 __attribute__((ext_vector_type(4)));
typedef short bf16x8 __attribute__((ext_vector_type(8)));

__device__ __forceinline__ unsigned f2bf(float f) { unsigned u = __builtin_bit_cast(unsigned, f); return (u + 0x7fffu + ((u >> 16) & 1u)) >> 16; }
__device__ __forceinline__ unsigned pk2(float lo, float hi) { return f2bf(lo) | (f2bf(hi) << 16); }
__device__ __forceinline__ float bf2f(unsigned short b) { return __builtin_bit_cast(float, (unsigned)b << 16); }
__device__ __forceinline__ float bflo(unsigned w) { return __builtin_bit_cast(float, w << 16); }
__device__ __forceinline__ float bfhi(unsigned w) { return __builtin_bit_cast(float, w & 0xffff0000u); }
__device__ __forceinline__ float wave_sum(float v) {
#pragma unroll
    for (int o = 1; o < 64; o <<= 1) v += __shfl_xor(v, o);
    return v;
}
__device__ __forceinline__ float silu_f(float x) { return x / (1.f + __expf(-x)); }
__device__ __forceinline__ float sigmoid_f(float x) { return 1.f / (1.f + __expf(-x)); }
__device__ __forceinline__ float logsigmoid_f(float x) { return fminf(x, 0.f) - log1pf(__expf(-fabsf(x))); }

struct Frame {
    unsigned char* lds;
    int tid, lane, wave, vcu, G;
    float* out; unsigned char* ws;
};
#define AS4 __attribute__((address_space(4)))
__device__ __forceinline__ const float* inptr(int k) {
    const AS4 char* kp = (const AS4 char*)__builtin_amdgcn_kernarg_segment_ptr();
    asm volatile("" : "+s"(kp));
    return *(const float* const AS4*)(kp + 8 * k);
}
enum { I_X = 0, I_C, I_CTX, I_CCTX, I_WMOD, I_BMOD, I_GPREMIX, I_GPOSTMIX, I_WIN, I_BGATE, I_CONVQKW, I_CONVQKB, I_GMLSTM, I_LQ1, I_LK1, I_LQ2, I_LK2, I_GDIFF, I_WOUT, I_GPREFFN, I_GPOSTFFN, I_WUP, I_CONVFFNW, I_CONVFFNB, I_WDOWN };

__device__ __forceinline__ void transpose_item(const float* W, int K, int N, bf16* WT, int dst_row0, int k0, int n0, float* scr, int lane) {
#pragma unroll 8
    for (int i = 0; i < 32; ++i) { const int kk = 2 * i + (lane >> 5); scr[kk * 33 + (lane & 31)] = W[(size_t)(k0 + kk) * N + n0 + (lane & 31)]; }
    asm volatile("s_waitcnt lgkmcnt(0)" ::: "memory");
    const int c = lane & 7;
#pragma unroll
    for (int j = 0; j < 4; ++j) { const int n = (lane >> 3) + 8 * j; const float* s = scr + (8 * c) * 33 + n;
        v4u o; o.x = pk2(s[0 * 33], s[1 * 33]); o.y = pk2(s[2 * 33], s[3 * 33]); o.z = pk2(s[4 * 33], s[5 * 33]); o.w = pk2(s[6 * 33], s[7 * 33]);
        *(v4u*)(WT + (size_t)(dst_row0 + n) * K + k0 + 8 * c) = o; }
    asm volatile("s_waitcnt lgkmcnt(0)" ::: "memory");
}
__device__ __forceinline__ int win_dst_row(int nb) { return nb < 128 ? 32 * nb : (nb == 128 ? 7168 : 4096 + 32 * (nb - 129)); }

constexpr int MOD_BLOCKS = 48;
__device__ __forceinline__ void p0_prologue(Frame& F) {
    const float* in_w_down = inptr(I_WDOWN); const float* in_c_ctx = inptr(I_CCTX); const float* in_w_mod = inptr(I_WMOD); const float* in_w_out = inptr(I_WOUT); const float* in_w_in = inptr(I_WIN); const float* in_w_up = inptr(I_WUP); const float* in_c = inptr(I_C);
    const int blk = blockIdx.x;
    if (blk < MOD_BLOCKS) {
        const int id = blk * 512 + F.tid;
        const int jq = id % 3072, ks = id / 3072;
        f32x4 a0 = {0, 0, 0, 0}, a1 = a0, a2 = a0;
        const float* wp = in_w_mod + (size_t)(ks * 256) * NMOD + 4 * jq;
#pragma unroll 8
        for (int k = 0; k < 256; ++k) {
            const f32x4 w = *(const f32x4*)(wp + (size_t)k * NMOD);
            const int kk = ks * 256 + k;
            const float s0 = silu_f(in_c[kk]), s1 = silu_f(in_c[DM + kk]), s2 = silu_f(in_c_ctx[kk]);
            a0 += w * s0; a1 += w * s1; a2 += w * s2;
        }
        float* mp = (float*)(F.ws + WS_MODP);
        *(f32x4*)(mp + (size_t)(ks * 3 + 0) * NMOD + 4 * jq) = a0;
        *(f32x4*)(mp + (size_t)(ks * 3 + 1) * NMOD + 4 * jq) = a1;
        *(f32x4*)(mp + (size_t)(ks * 3 + 2) * NMOD + 4 * jq) = a2;
        return;
    }
    float* scr = (float*)(F.lds) + F.wave * 2112;
    const int gw = (blk - MOD_BLOCKS) * NWAVES + F.wave, NGW = (F.G - MOD_BLOCKS) * NWAVES;
    constexpr int I_IN = (DM / 64) * (IN_COLS / 32), I_OUT = (DM / 64) * (DM / 32), I_UP = (DM / 64) * (NUP / 32), I_DN = (DFF / 64) * (DM / 32);
    bf16* win_t = (bf16*)(F.ws + WS_WIN); bf16* wout_t = (bf16*)(F.ws + WS_WOUT); bf16* wup_t = (bf16*)(F.ws + WS_WUP); bf16* wdn_t = (bf16*)(F.ws + WS_WDN);
    for (int it = gw; it < I_IN + I_OUT + I_UP + I_DN; it += NGW) {
        int r = it;
        if (r < I_IN) { const int nblk = IN_COLS / 32, kb = r / nblk, nb = r % nblk; transpose_item(in_w_in, DM, IN_COLS, win_t, win_dst_row(nb), 64 * kb, 32 * nb, scr, F.lane); continue; } r -= I_IN;
        if (r < I_OUT) { const int nblk = DM / 32, kb = r / nblk, nb = r % nblk; transpose_item(in_w_out, DM, DM, wout_t, 32 * nb, 64 * kb, 32 * nb, scr, F.lane); continue; } r -= I_OUT;
        if (r < I_UP) { const int nblk = NUP / 32, kb = r / nblk, nb = r % nblk; const int nbh = nb < DFF / 32 ? nb : nb - DFF / 32;
            transpose_item(in_w_up, DM, NUP, wup_t, 256 * (nbh >> 2) + (nb < DFF / 32 ? 0 : 128) + 32 * (nbh & 3), 64 * kb, 32 * nb, scr, F.lane); continue; } r -= I_UP;
        { const int nblk = DM / 32, kb = r / nblk, nb = r % nblk; transpose_item(in_w_down, DFF, DM, wdn_t, 32 * nb, 64 * kb, 32 * nb, scr, F.lane); }
    }
    { v4u* z = (v4u*)(win_t + (size_t)7200 * DM); const int n16 = 224 * DM * 2 / 16; const v4u zero = {0, 0, 0, 0};
      for (int i = (blk - MOD_BLOCKS) * 512 + F.tid; i < n16; i += (F.G - MOD_BLOCKS) * 512) z[i] = zero; }
}

__device__ __forceinline__ void load_mod(Frame& F, float* dst, int v, int col0, int n) {
    const float* in_b_mod = inptr(I_BMOD);
    const float* mp = (const float*)(F.ws + WS_MODP);
    for (int j = F.tid; j < n; j += 512) { float s = in_b_mod[col0 + j];
#pragma unroll
        for (int ks = 0; ks < KSL; ++ks) s += mp[(size_t)(ks * 3 + v) * NMOD + col0 + j];
        dst[j] = s; }
}

__device__ __forceinline__ void p1_xn(Frame& F) {
    const float* in_g_pre_mix = inptr(I_GPREMIX); const float* in_ctx = inptr(I_CTX); const float* in_x = inptr(I_X);
    float* modl = (float*)F.lds;
    for (int v = 0; v < 3; ++v) load_mod(F, modl + v * 4096, v, 0, 4096);
    __syncthreads();
    bf16* XN = (bf16*)(F.ws + WS_XN);
    const int gw = F.vcu * NWAVES + F.wave, NGW = F.G * NWAVES;
    for (int row = gw; row < UROWS; row += NGW) {
        const int b = row / UROWS_B, s = row % UROWS_B;
        const float* src = s < CTX ? in_ctx + ((size_t)b * CTX + s) * DM : in_x + ((size_t)b * SEQ + (s - CTX)) * DM;
        const float* mv = modl + (s < CTX ? 2 : b) * 4096;
        const f32x4* xr = (const f32x4*)src + F.lane;
        f32x4 v[8]; float ss = 0.f;
#pragma unroll
        for (int j = 0; j < 8; ++j) { v[j] = xr[64 * j]; ss += (v[j].x * v[j].x + v[j].y * v[j].y) + (v[j].z * v[j].z + v[j].w * v[j].w); }
        const float rstd = rsqrtf(wave_sum(ss) * (1.f / DM) + EPS);
        v2u* o8 = (v2u*)(XN + (size_t)row * DM) + F.lane;
#pragma unroll
        for (int j = 0; j < 8; ++j) { const int c0 = 4 * (64 * j + F.lane);
            const f32x4 g = *(const f32x4*)(in_g_pre_mix + c0), sh = *(const f32x4*)(mv + c0), sc = *(const f32x4*)(mv + 2048 + c0);
            const f32x4 y = (v[j] * rstd * g) * (sc + 1.f) + sh;
            v2u w; w.x = pk2(y.x, y.y); w.y = pk2(y.z, y.w); o8[64 * j] = w; }
    }
}

__device__ __forceinline__ void p3_rope(Frame& F) {
    float* ct = (float*)F.lds; float* st = ct + 2048;
    for (int i = F.tid; i < 2048; i += 512) { const int pos = i >> 4, f = i & 15; const float inv = powf(10000.f, -(float)f / 16.f); const float ang = (float)pos * inv; ct[i] = cosf(ang); st[i] = sinf(ang); }
    __syncthreads();
    bf16* P = (bf16*)(F.ws + WS_P);
    const int gw = F.vcu * NWAVES + F.wave, NGW = F.G * NWAVES;
    for (int lr = gw; lr < LROWS; lr += NGW) {
        const int b = lr / SEQ, t = lr % SEQ;
        const int pos = (F.lane & 1) ? (t & 63) : (t >> 6);
        bf16* p = P + (size_t)(b * UROWS_B + CTX + t) * LDP + PC_DQ + 32 * F.lane;
        v4u w[4];
#pragma unroll
        for (int i = 0; i < 4; ++i) w[i] = *(const v4u*)(p + 8 * i);
        v4u o[4];
#pragma unroll
        for (int q = 0; q < 2; ++q)
#pragma unroll
            for (int e = 0; e < 4; ++e) { const int f = 8 * q + 2 * e; const unsigned a = w[q][e], bb = w[2 + q][e];
                const float c0 = ct[pos * 16 + f], s0 = st[pos * 16 + f], c1 = ct[pos * 16 + f + 1], s1 = st[pos * 16 + f + 1];
                const float x0l = bflo(a), x0h = bfhi(a), x1l = bflo(bb), x1h = bfhi(bb);
                o[q][e] = pk2(x0l * c0 - x1l * s0, x0h * c1 - x1h * s1);
                o[2 + q][e] = pk2(x1l * c0 + x0l * s0, x1h * c1 + x0h * s1); }
#pragma unroll
        for (int i = 0; i < 4; ++i) *(v4u*)(p + 8 * i) = o[i];
    }
}

__device__ __forceinline__ void p5_attn(Frame& F) {
    const float* in_g_diff = inptr(I_GDIFF); const float* in_lq1 = inptr(I_LQ1); const float* in_lk1 = inptr(I_LK1); const float* in_lq2 = inptr(I_LQ2); const float* in_lk2 = inptr(I_LK2);
    using namespace attn;
    float lam;
    { float s1 = 0.f, s2 = 0.f; for (int i = 0; i < 64; ++i) { s1 += in_lq1[i] * in_lk1[i]; s2 += in_lq2[i] * in_lk2[i]; } lam = expf(s1) - expf(s2) + 0.2f; }
    const attn::bf16* P = (const attn::bf16*)(F.ws + WS_P); ::bf16* MIX = (::bf16*)(F.ws + WS_MIX);
    float* scr0 = (float*)(F.ws + WS_XN);
    const int tid = F.tid, wid = tid >> 6, lane = tid & 63, r32 = lane & 31, hi = lane >> 5;
#pragma unroll 1
    for (int u = blockIdx.x; u < BATCH * 8 * (SEQ / 256); u += F.G) {
        const int qb = u % (SEQ / 256), bh = u / (SEQ / 256), b = bh >> 3, h = bh & 7;
        const attn::bf16* Pb = P + (size_t)(b * UROWS_B) * LDP;
#pragma unroll 1
        for (int c = 0; c < 2; ++c) {
            f32x16 o[4]; float rli[16];
            attn_sub<LDP>(Pb + (size_t)(CTX + qb * 256) * LDP + PC_DQ + h * 128 + c * 64, Pb + PC_DK + h * 128 + c * 64, Pb + PC_DV + h * 128, UROWS_B / 64, (char*)F.lds, o, rli);
            for (int d0 = 0; d0 < 4; ++d0) for (int r = 0; r < 16; ++r) scr0[(d0 * 16 + r) * 512 + tid + blockIdx.x * 65536 + c * 32768] = o[d0][r] * rli[r];
        }
        const float* s1p = scr0 + (size_t)blockIdx.x * 65536 + tid; const float* s2p = s1p + 32768;
        ::bf16* mo = MIX + (size_t)(b * SEQ + qb * 256 + wid * 32) * DM + 1024 + h * 128 + r32;
        const float g0 = in_g_diff[r32] * 0.8f, g1 = in_g_diff[32 + r32] * 0.8f, g2 = in_g_diff[64 + r32] * 0.8f, g3 = in_g_diff[96 + r32] * 0.8f;
#pragma unroll 2
        for (int r = 0; r < 16; ++r) {
            const float v0 = s1p[(0 * 16 + r) * 512] - lam * s2p[(0 * 16 + r) * 512], v1 = s1p[(1 * 16 + r) * 512] - lam * s2p[(1 * 16 + r) * 512],
                        v2 = s1p[(2 * 16 + r) * 512] - lam * s2p[(2 * 16 + r) * 512], v3 = s1p[(3 * 16 + r) * 512] - lam * s2p[(3 * 16 + r) * 512];
            float ss = (v0 * v0 + v1 * v1) + (v2 * v2 + v3 * v3);
#pragma unroll
            for (int off = 1; off < 32; off <<= 1) ss += __shfl_xor(ss, off);
            const float rs = rsqrtf(ss * (1.f / 128.f) + EPS);
            ::bf16* mr = mo + (size_t)((r & 3) + 8 * (r >> 2) + 4 * hi) * DM;
            mr[0] = (::bf16)f2bf(v0 * rs * g0); mr[32] = (::bf16)f2bf(v1 * rs * g1); mr[64] = (::bf16)f2bf(v2 * rs * g2); mr[96] = (::bf16)f2bf(v3 * rs * g3);
        }
    }
}

__device__ __forceinline__ void p7_x1(Frame& F) {
    const float* in_g_post_mix = inptr(I_GPOSTMIX); const float* in_g_pre_ffn = inptr(I_GPREFFN); const float* in_x = inptr(I_X);
    float* modl = (float*)F.lds;
    for (int b = 0; b < 2; ++b) { load_mod(F, modl + (b * 3 + 0) * 2048, b, 2 * DM, 2048); load_mod(F, modl + (b * 3 + 1) * 2048, b, 3 * DM, 2048); load_mod(F, modl + (b * 3 + 2) * 2048, b, 4 * DM, 2048); }
    __syncthreads();
    const float* Y = (const float*)(F.ws + WS_Y); bf16* XN2 = (bf16*)(F.ws + WS_XN);
    const int gw = F.vcu * NWAVES + F.wave, NGW = F.G * NWAVES;
    for (int row = gw; row < LROWS; row += NGW) {
        const int b = row / SEQ; const float* mv = modl + b * 3 * 2048;
        const f32x4* yr = (const f32x4*)(Y + (size_t)row * DM) + F.lane; const f32x4* xr = (const f32x4*)(in_x + (size_t)row * DM) + F.lane;
        f32x4 v[8]; float ss = 0.f;
#pragma unroll
        for (int j = 0; j < 8; ++j) { v[j] = yr[64 * j]; ss += (v[j].x * v[j].x + v[j].y * v[j].y) + (v[j].z * v[j].z + v[j].w * v[j].w); }
        const float rstd = rsqrtf(wave_sum(ss) * (1.f / DM) + EPS);
        float s2 = 0.f; f32x4* orow = (f32x4*)(F.out + (size_t)row * DM) + F.lane;
#pragma unroll
        for (int j = 0; j < 8; ++j) { const int c0 = 4 * (64 * j + F.lane);
            const f32x4 g = *(const f32x4*)(in_g_post_mix + c0), ga = *(const f32x4*)(mv + c0);
            v[j] = xr[64 * j] + ga * (v[j] * rstd * g); orow[64 * j] = v[j];
            s2 += (v[j].x * v[j].x + v[j].y * v[j].y) + (v[j].z * v[j].z + v[j].w * v[j].w); }
        const float rstd2 = rsqrtf(wave_sum(s2) * (1.f / DM) + EPS);
        v2u* o8 = (v2u*)(XN2 + (size_t)row * DM) + F.lane;
#pragma unroll
        for (int j = 0; j < 8; ++j) { const int c0 = 4 * (64 * j + F.lane);
            const f32x4 g = *(const f32x4*)(in_g_pre_ffn + c0), sh = *(const f32x4*)(mv + 2048 + c0), sc = *(const f32x4*)(mv + 4096 + c0);
            const f32x4 y = (v[j] * rstd2 * g) * (sc + 1.f) + sh;
            v2u w; w.x = pk2(y.x, y.y); w.y = pk2(y.z, y.w); o8[64 * j] = w; }
    }
}

__device__ __forceinline__ void ffn_edge_fix(Frame& F) {
    const float* cw = inptr(I_CONVFFNW);
    const float* edge = (const float*)(F.ws + WS_EDGE); bf16* HM = (bf16*)(F.ws + WS_HMID);
    constexpr int NB = LROWS / 256 - BATCH;
    for (int it = blockIdx.x * 512 + F.tid; it < NB * DFF; it += F.G * 512) {
        const int bi = it / DFF, j = it % DFF, pm = bi + 1 + bi / (SEQ / 256 - 1);
        const int pn = j >> 7, c = j & 127;
        const float* eA = edge + (size_t)((pm - 1) * (NUP / 256) + pn) * 1024 + 512; const float* eB = edge + (size_t)(pm * (NUP / 256) + pn) * 1024;
        const float w0g = cw[j], w0v = cw[DFF + j], w2g = cw[2 * NUP + j], w2v = cw[2 * NUP + DFF + j];
        const float ag = eA[c] + w2g * eB[256 + c], av = eA[128 + c] + w2v * eB[384 + c];
        const float bg = eB[c] + w0g * eA[256 + c], bv = eB[128 + c] + w0v * eA[384 + c];
        HM[(size_t)(256 * pm - 1) * DFF + j] = (bf16)f2bf(silu_f(ag) * av);
        HM[(size_t)(256 * pm) * DFF + j] = (bf16)f2bf(silu_f(bg) * bv);
    }
}

__device__ __forceinline__ void p13_final(Frame& F) {
    const float* in_g_post_ffn = inptr(I_GPOSTFFN);
    float* modl = (float*)F.lds;
    for (int b = 0; b < 2; ++b) load_mod(F, modl + b * 2048, b, 5 * DM, 2048);
    __syncthreads();
    const float* Y2 = (const float*)(F.ws + WS_Y2);
    const int gw = F.vcu * NWAVES + F.wave, NGW = F.G * NWAVES;
    for (int row = gw; row < LROWS; row += NGW) {
        const int b = row / SEQ; const float* mv = modl + b * 2048;
        const f32x4* yr = (const f32x4*)(Y2 + (size_t)row * DM) + F.lane; f32x4* orow = (f32x4*)(F.out + (size_t)row * DM) + F.lane;
        f32x4 v[8]; float ss = 0.f;
#pragma unroll
        for (int j = 0; j < 8; ++j) { v[j] = yr[64 * j]; ss += (v[j].x * v[j].x + v[j].y * v[j].y) + (v[j].z * v[j].z + v[j].w * v[j].w); }
        const float rstd = rsqrtf(wave_sum(ss) * (1.f / DM) + EPS);
#pragma unroll
        for (int j = 0; j < 8; ++j) { const int c0 = 4 * (64 * j + F.lane);
            const f32x4 g = *(const f32x4*)(in_g_post_ffn + c0), ga = *(const f32x4*)(mv + c0);
            orow[64 * j] = orow[64 * j] + ga * (v[j] * rstd * g); }
    }
}


namespace ml {
using bf16x8 = __attribute__((ext_vector_type(8))) short;
using s16x4  = __attribute__((ext_vector_type(4))) short;
using f32x16 = __attribute__((ext_vector_type(16))) float;
using u32x4  = __attribute__((ext_vector_type(4))) unsigned;
typedef short v4i16_t __attribute__((ext_vector_type(4)));
#define MFMA32(a, b, c) __builtin_amdgcn_mfma_f32_32x32x16_bf16((a), (b), (c), 0, 0, 0)
__device__ __forceinline__ int crow(int r, int hi) { return (r & 3) + 8 * (r >> 2) + 4 * hi; }
__device__ __forceinline__ unsigned off_a(unsigned row, unsigned ch) { return 2048u * (row >> 3) + 512u * (ch >> 2) + 64u * (row & 7) + 16u * ((ch & 3) ^ ((row >> 2) & 3)); }
struct RdBase { unsigned r[2], t[2], p[2]; };
__device__ __forceinline__ RdBase rd_bases(unsigned lane) {
    const unsigned l31 = lane & 31, h = lane >> 5, y = (l31 >> 2) & 3, blk = (lane >> 4) & 1, q = (lane & 15) >> 2, p = lane & 3, cz = 2 * blk + (p >> 1);
    RdBase B;
    B.r[0] = 2048u * (l31 >> 3) + 64u * (l31 & 7) + 16u * ((0u | h) ^ y);
    B.r[1] = 2048u * (l31 >> 3) + 64u * (l31 & 7) + 16u * ((2u | h) ^ y);
    B.t[0] = 2048u * h + 64u * q + 8u * (p & 1) + 16u * (cz ^ (2 * h + 0));
    B.t[1] = 2048u * h + 64u * q + 8u * (p & 1) + 16u * (cz ^ (2 * h + 1));
    B.p[0] = 64u * (4 * h + q) + 8u * (p & 1) + 16u * (cz ^ (0 + h));
    B.p[1] = 64u * (4 * h + q) + 8u * (p & 1) + 16u * (cz ^ (2 + h));
    return B; }
#define ROW_OFF(rb, s) (8192u * (rb) + 512u * ((s) >> 1))
#define TR_OFF(c, ks, t) (4096u * (ks) + 512u * (c) + 256u * (t))
#define TRP_OFF(c, ks, t) (4096u * (ks) + 2048u * (t) + 512u * (c))
__device__ __forceinline__ bf16x8 ld_row(const LAS unsigned char* tile, unsigned a) { return *(const LAS bf16x8*)(tile + a); }
__device__ __forceinline__ bf16x8 ld_tr2(const LAS unsigned char* tile, unsigned a0, unsigned a1) {
    const s16x4 lo = __builtin_bit_cast(s16x4, __builtin_amdgcn_ds_read_tr16_b64_v4i16((LAS v4i16_t*)(tile + a0)));
    const s16x4 hi = __builtin_bit_cast(s16x4, __builtin_amdgcn_ds_read_tr16_b64_v4i16((LAS v4i16_t*)(tile + a1)));
    return (bf16x8){lo[0], lo[1], lo[2], lo[3], hi[0], hi[1], hi[2], hi[3]}; }
__device__ __forceinline__ unsigned cvtpk(float lo, float hi) { typedef float f2 __attribute__((ext_vector_type(2))); typedef __bf16 b2 __attribute__((ext_vector_type(2)));
    f2 v = {lo, hi}; b2 b = __builtin_convertvector(v, b2); return __builtin_bit_cast(unsigned, b); }

constexpr int SC_OFF = 132096;
constexpr int NCH = 66;
__device__ __forceinline__ int chunk_row0(int b, int jj) { return b * UROWS_B + (jj < 2 ? 128 * jj : CTX + 128 * (jj - 2)); }
constexpr size_t WS_CDC = WS_ASCR;
constexpr size_t WS_SCAL = WS_ASCR + 4 * MiB;
constexpr size_t WS_MST = WS_SCAL + 32 * 1024;
constexpr size_t WS_DN = WS_MST + 16 * 1024;

__device__ __forceinline__ void gate_scalars(const float* GT, const float* bgate, int b, int h, int dir, int jj, int lane, LAS float* gs, LAS float* bs, float& G, float& bL) {
    const int r0 = chunk_row0(b, jj);
    const float bi = bgate[(dir * 2) * 8 + h], bf = bgate[(dir * 2 + 1) * 8 + h];
    const float* g0 = GT + (size_t)(r0 + 2 * lane) * 32; const float* g1 = g0 + 32;
    const float i0 = g0[(dir * 2) * 8 + h] + bi, i1 = g1[(dir * 2) * 8 + h] + bi;
    const float f0 = logsigmoid_f(g0[(dir * 2 + 1) * 8 + h] + bf), f1 = logsigmoid_f(g1[(dir * 2 + 1) * 8 + h] + bf);
    float ps = f0 + f1;
#pragma unroll
    for (int o = 1; o < 64; o <<= 1) { const float y = __shfl_up(ps, o); if (lane >= o) ps += y; }
    const float tot = __shfl(ps, 63);
    float b0, b1;
    if (dir == 0) { b1 = ps; b0 = ps - f1; }
    else { const float excl = ps - (f0 + f1); b0 = tot - excl; b1 = b0 - f0; }
    const float ga = i0 - b0, gb = i1 - b1;
    float mx = fmaxf(ga, gb);
#pragma unroll
    for (int o = 1; o < 64; o <<= 1) mx = fmaxf(mx, __shfl_xor(mx, o));
    gs[2 * lane] = ga; gs[2 * lane + 1] = gb; bs[2 * lane] = b0; bs[2 * lane + 1] = b1;
    G = mx; bL = tot;
}

template <int MODE>
__device__ __forceinline__ void stage_tile(const bf16* P, int r0, int col0, LAS unsigned char* tile, int tid, const LAS float* rw, const float* cw, const float* cb, int cwoff, float scale, int seg0, int seg1) {
#pragma unroll 2
    for (int i = 0; i < 4; ++i) {
        const int id = tid + 512 * i, row = id >> 4, ch = id & 15; const int r = r0 + row;
        const bf16* p = P + (size_t)r * LDP + col0 + 8 * ch;
        const v4u x0 = *(const v4u*)p;
        float y[8];
        if (MODE == 0) { const float w = rw ? rw[row] : 1.f;
#pragma unroll
            for (int e = 0; e < 4; ++e) { y[2 * e] = bflo(x0[e]) * w; y[2 * e + 1] = bfhi(x0[e]) * w; }
        } else {
            v4u xm = {0, 0, 0, 0}, xp = {0, 0, 0, 0};
            if (r - 1 >= seg0) xm = *(const v4u*)(p - LDP);
            if (r + 1 < seg1) xp = *(const v4u*)(p + LDP);
            const float* w0 = cw + cwoff + 8 * ch; const float* bb = cb + cwoff + 8 * ch;
#pragma unroll
            for (int e = 0; e < 4; ++e) {
                const float a0 = w0[2 * e] * bflo(xm[e]) + w0[2048 + 2 * e] * bflo(x0[e]) + w0[4096 + 2 * e] * bflo(xp[e]) + bb[2 * e];
                const float a1 = w0[2 * e + 1] * bfhi(xm[e]) + w0[2048 + 2 * e + 1] * bfhi(x0[e]) + w0[4096 + 2 * e + 1] * bfhi(xp[e]) + bb[2 * e + 1];
                y[2 * e] = silu_f(a0) * scale; y[2 * e + 1] = silu_f(a1) * scale; }
        }
        v4u o; o.x = cvtpk(y[0], y[1]); o.y = cvtpk(y[2], y[3]); o.z = cvtpk(y[4], y[5]); o.w = cvtpk(y[6], y[7]);
        *(LAS v4u*)(tile + off_a(row, ch)) = o;
    }
}

__device__ __forceinline__ void stage1(Frame& F) {
    const float* in_b_gate = inptr(I_BGATE); const float* in_cw = inptr(I_CONVQKW); const float* in_cb = inptr(I_CONVQKB);
    const bf16* P = (const bf16*)(F.ws + WS_P); const float* GT = (const float*)(F.ws + WS_GATES);
    LAS unsigned char* L = (LAS unsigned char*)F.lds;
    LAS unsigned char* Kt = L; LAS unsigned char* Vf = L + 32768; LAS unsigned char* Vb = L + 65536;
    LAS float* sc = (LAS float*)(L + 98304);
    int tid_ = threadIdx.x; asm volatile("" : "+v"(tid_)); const int tid = tid_, lane = tid & 63, wid = __builtin_amdgcn_readfirstlane(tid >> 6);
    const RdBase RB = rd_bases(lane);
#pragma unroll 1
    for (int u = blockIdx.x; u < 16 * NCH; u += F.G) {
        const int bh = u / NCH, jj = u % NCH, b = bh >> 3, h = bh & 7, r0 = chunk_row0(b, jj);
        const int seg0 = b * UROWS_B + (jj < 2 ? 0 : CTX), seg1 = b * UROWS_B + (jj < 2 ? CTX : UROWS_B);
        __syncthreads();
        if (wid < 2) { float G, bL; gate_scalars(GT, in_b_gate, b, h, wid, jj, lane, sc + wid * 256, sc + wid * 256 + 128, G, bL);
            sc[512 + wid * 128 + 2 * lane] = __expf(sc[wid * 256 + 2 * lane] - G); sc[512 + wid * 128 + 2 * lane + 1] = __expf(sc[wid * 256 + 2 * lane + 1] - G);
            if (lane == 0) { float* s = (float*)(F.ws + WS_SCAL) + ((size_t)(bh * 2 + wid) * NCH + jj) * 2; s[0] = G; s[1] = bL; } }
        stage_tile<1>(P, r0, PC_MK + h * 128, Kt, tid, nullptr, in_cw, in_cb, 1024 + h * 128, 0.08838834764831845f, seg0, seg1);
        __syncthreads();
        stage_tile<0>(P, r0, PC_MV + h * 128, Vf, tid, sc + 512, nullptr, nullptr, 0, 1.f, 0, 0);
        stage_tile<0>(P, r0, PC_MV + h * 128, Vb, tid, sc + 640, nullptr, nullptr, 0, 1.f, 0, 0);
        __syncthreads();
        const int dir = wid >> 2, db = wid & 3; const LAS unsigned char* Vw = dir ? Vb : Vf;
        f32x16 acc[4];
#pragma unroll
        for (int c = 0; c < 4; ++c) acc[c] = f32x16{};
        const LAS unsigned char* Kd = Kt + 512 * db;
#pragma unroll
        for (int ks = 0; ks < 8; ++ks) {
            const bf16x8 a = ld_tr2(Kd, RB.t[0] + TR_OFF(0, ks, 0), RB.t[1] + TR_OFF(0, ks, 1));
#pragma unroll
            for (int c = 0; c < 4; ++c) { const bf16x8 bv = ld_tr2(Vw, RB.t[0] + TR_OFF(c, ks, 0), RB.t[1] + TR_OFF(c, ks, 1)); acc[c] = MFMA32(a, bv, acc[c]); }
        }
        if ((tid & 255) < 128) { const int d = tid & 127, dr = tid >> 8; const LAS float* w = sc + 512 + dr * 128; float s = 0.f;
#pragma unroll 8
            for (int r = 0; r < 128; ++r) s += w[r] * bf2f(*(const LAS unsigned short*)(Kt + off_a(r, d >> 3) + (d & 7) * 2));
            ((float*)(F.ws + WS_DN))[((size_t)(bh * 2 + dr) * NCH + jj) * 128 + d] = s; }
        float* dst = (jj < 2 ? (float*)(F.ws + WS_CDC) + ((size_t)(bh * 2 + dir) * 2 + jj) * 16384 : F.out + ((size_t)(bh * 2 + dir) * 64 + (jj - 2)) * 16384) + (32 * db) * 128 + (lane & 31);
        const int hi = lane >> 5;
#pragma unroll
        for (int c = 0; c < 4; ++c)
#pragma unroll
            for (int r = 0; r < 16; ++r) dst[crow(r, hi) * 128 + 32 * c] = acc[c][r];
    }
}

__device__ __forceinline__ void stage2(Frame& F) {
    const int g = blockIdx.x * 512 + F.tid;
    if (g >= 32 * 4096) return;
    const int chain = g >> 12, e4 = g & 4095, dir = chain & 1;
    const float* scal = (const float*)(F.ws + WS_SCAL) + (size_t)chain * NCH * 2;
    f32x4* lat = (f32x4*)(F.out + (size_t)chain * 64 * 16384) + e4; const f32x4* cdc = (const f32x4*)((const float*)(F.ws + WS_CDC) + (size_t)chain * 2 * 16384) + e4;
    f32x4* dn = (f32x4*)((float*)(F.ws + WS_DN) + (size_t)chain * NCH * 128) + e4;
    float* mst = (float*)(F.ws + WS_MST) + (size_t)chain * NCH;
    f32x4 C = {0.f, 0.f, 0.f, 0.f}, n = {0.f, 0.f, 0.f, 0.f}; float m = 0.f;
#pragma unroll
    for (int c = 0; c < 2; ++c) { const int jj = dir ? 1 - c : c; const float G = scal[2 * jj], bL = scal[2 * jj + 1];
        const float M = fmaxf(m, G), dec = __expf(m - M), sca = __expf(G - M);
        if (e4 == 0) mst[jj] = m;
        C = C * dec + cdc[(size_t)jj * 4096] * sca;
        if (e4 < 32) { const f32x4 d = dn[jj * 32]; dn[jj * 32] = n; n = n * dec + d * sca; }
        m = bL + M; }
#pragma unroll 1
    for (int c0 = 0; c0 < 64; c0 += 8) {
        f32x4 d[8];
#pragma unroll
        for (int i = 0; i < 8; ++i) { const int j = dir ? 63 - (c0 + i) : c0 + i; d[i] = lat[(size_t)j * 4096]; }
#pragma unroll
        for (int i = 0; i < 8; ++i) { const int j = dir ? 63 - (c0 + i) : c0 + i, jj = j + 2; const float G = scal[2 * jj], bL = scal[2 * jj + 1];
            const float M = fmaxf(m, G), dec = __expf(m - M), sca = __expf(G - M);
            if (e4 == 0) mst[jj] = m;
            lat[(size_t)j * 4096] = C; C = C * dec + d[i] * sca;
            if (e4 < 32) { const f32x4 dd = dn[jj * 32]; dn[jj * 32] = n; n = n * dec + dd * sca; }
            m = bL + M; }
    }
}

__device__ __forceinline__ void stage3(Frame& F) {
    const float* in_b_gate = inptr(I_BGATE); const float* in_cw = inptr(I_CONVQKW); const float* in_cb = inptr(I_CONVQKB); const float* in_gm = inptr(I_GMLSTM);
    const bf16* P = (const bf16*)(F.ws + WS_P); const float* GT = (const float*)(F.ws + WS_GATES); bf16* MIX = (bf16*)(F.ws + WS_MIX);
    LAS unsigned char* L = (LAS unsigned char*)F.lds;
    LAS unsigned char* Qt = L; LAS unsigned char* Kt = L + 32768; LAS unsigned char* Vt = L + 65536; LAS unsigned char* Ct = L + 98304;
    LAS float* sc = (LAS float*)(L + SC_OFF);
    int tid_ = threadIdx.x; asm volatile("" : "+v"(tid_)); const int tid = tid_, lane = tid & 63, wid = __builtin_amdgcn_readfirstlane(tid >> 6);
    const int tb = wid >> 1, eh = wid & 1, hi = lane >> 5, tl = lane & 31;
    const RdBase RB = rd_bases(lane);
#pragma unroll 1
    for (int u = blockIdx.x; u < 16 * 64; u += F.G) {
        const int bh = u >> 6, j = u & 63, jj = j + 2, b = bh >> 3, h = bh & 7, r0 = chunk_row0(b, jj);
        const int seg0 = b * UROWS_B + CTX, seg1 = (b + 1) * UROWS_B;
        __syncthreads();
        if (wid < 2) { float G, bL; gate_scalars(GT, in_b_gate, b, h, wid, jj, lane, sc + wid * 256, sc + wid * 256 + 128, G, bL);
            const float m0 = ((const float*)(F.ws + WS_MST))[(size_t)(bh * 2 + wid) * NCH + jj]; const float ML = fmaxf(m0, G);
#pragma unroll
            for (int q = 0; q < 2; ++q) { const int t = 2 * lane + q; sc[512 + wid * 128 + t] = __expf(sc[wid * 256 + t] - ML); sc[768 + wid * 128 + t] = __expf(-sc[wid * 256 + 128 + t] - ML); }
            if (lane == 0) sc[1920 + wid] = __expf(m0 - ML);
        } else if (wid < 4) { const int dr = wid - 2; const float* nv = (const float*)(F.ws + WS_DN) + ((size_t)(bh * 2 + dr) * NCH + jj) * 128; sc[1024 + dr * 128 + lane] = nv[lane]; sc[1024 + dr * 128 + 64 + lane] = nv[64 + lane]; }
        stage_tile<1>(P, r0, PC_MQ + h * 128, Qt, tid, nullptr, in_cw, in_cb, h * 128, 1.f, seg0, seg1);
        stage_tile<1>(P, r0, PC_MK + h * 128, Kt, tid, nullptr, in_cw, in_cb, 1024 + h * 128, 0.08838834764831845f, seg0, seg1);
        stage_tile<0>(P, r0, PC_MV + h * 128, Vt, tid, nullptr, nullptr, nullptr, 0, 1.f, 0, 0);
        __syncthreads();
        { const int t = tid & 127, part = tid >> 7; float s0 = 0.f, s1 = 0.f;
#pragma unroll
            for (int c4 = 0; c4 < 4; ++c4) { const v4u qv = *(const LAS v4u*)(Qt + off_a(t, 4 * part + c4)); const LAS float* n0 = sc + 1024 + 32 * part + 8 * c4; const LAS float* n1 = n0 + 128;
#pragma unroll
                for (int e = 0; e < 4; ++e) { const float ql = bflo(qv[e]), qh = bfhi(qv[e]); s0 += ql * n0[2 * e] + qh * n0[2 * e + 1]; s1 += ql * n1[2 * e] + qh * n1[2 * e + 1]; } }
            LAS float* qp = (LAS float*)(L + SC_OFF + 8192);
            qp[(0 * 4 + part) * 128 + t] = s0; qp[(1 * 4 + part) * 128 + t] = s1; }
        f32x16 hsum[2];
#pragma unroll
        for (int c = 0; c < 2; ++c) hsum[c] = f32x16{};
        bf16x8 qf[8];
        { const LAS unsigned char* Qw = Qt + 8192 * tb;
#pragma unroll
          for (int kd = 0; kd < 8; ++kd) qf[kd] = ld_row(Qw, RB.r[kd & 1] + ROW_OFF(0, kd)); }
#pragma unroll 1
        for (int dir = 0; dir < 2; ++dir) {
            __syncthreads();
            { const float* Cg = F.out + ((size_t)(bh * 2 + dir) * 64 + j) * 16384;
#pragma unroll 2
              for (int i = 0; i < 4; ++i) { const int id = tid + 512 * i, e = id & 127, dc = id >> 7;
                float y[8];
#pragma unroll
                for (int q = 0; q < 8; ++q) y[q] = Cg[(size_t)(8 * dc + q) * 128 + e];
                v4u o; o.x = cvtpk(y[0], y[1]); o.y = cvtpk(y[2], y[3]); o.z = cvtpk(y[4], y[5]); o.w = cvtpk(y[6], y[7]);
                *(LAS v4u*)(Ct + off_a(e, dc)) = o; } }
            __syncthreads();
            const LAS float* w = sc + 512 + dir * 128; const LAS float* fl = sc + 768 + dir * 128; const float dec = sc[1920 + dir];
            int tlm = tl; asm volatile("" : "+v"(tlm));
            const int t = 32 * tb + tl;
            bf16x8 pf[8]; float dsum = 0.f;
#pragma unroll
            for (int sb = 0; sb < 4; ++sb) {
                const bool live = dir ? (sb >= tb) : (sb <= tb);
                f32x16 s = f32x16{};
                if (live) {
#pragma unroll
                    for (int kd = 0; kd < 8; ++kd) s = MFMA32(ld_row(Kt, RB.r[kd & 1] + ROW_OFF(sb, kd)), qf[kd], s);
#pragma unroll
                    for (int g4 = 0; g4 < 4; ++g4) { const f32x4 wv = *(const LAS f32x4*)(w + 32 * sb + 8 * g4 + 4 * hi);
#pragma unroll
                        for (int q = 0; q < 4; ++q) s[4 * g4 + q] *= wv[q]; }
                    if (sb == tb) {
#pragma unroll
                        for (int g4 = 0; g4 < 4; ++g4)
#pragma unroll
                            for (int q = 0; q < 4; ++q) { const int sl = 8 * g4 + 4 * hi + q; const bool ok = dir ? (sl >= tlm) : (sl <= tlm); s[4 * g4 + q] = ok ? s[4 * g4 + q] : 0.f; } }
#pragma unroll
                    for (int r = 0; r < 16; ++r) dsum += s[r];
                }
#pragma unroll
                for (int sp = 0; sp < 2; ++sp) { u32x4 pw; pw.x = cvtpk(s[8 * sp + 0], s[8 * sp + 1]); pw.y = cvtpk(s[8 * sp + 2], s[8 * sp + 3]); pw.z = cvtpk(s[8 * sp + 4], s[8 * sp + 5]); pw.w = cvtpk(s[8 * sp + 6], s[8 * sp + 7]);
                    pf[2 * sb + sp] = __builtin_bit_cast(bf16x8, pw); }
            }
            { auto rr = __builtin_amdgcn_permlane32_swap(__float_as_uint(dsum), __float_as_uint(dsum), false, false); dsum = __uint_as_float(rr[0]) + __uint_as_float(rr[1]); }
            if (eh == 0 && hi == 0) { const LAS float* qp = (const LAS float*)(L + SC_OFF + 8192) + dir * 512 + t;
                sc[1536 + t] = dsum + dec * ((qp[0] + qp[128]) + (qp[256] + qp[384])); }
            f32x16 acc[2];
            const LAS unsigned char* Cw = Ct + 8192 * (2 * eh); const LAS unsigned char* Vw = Vt + 512 * (2 * eh);
#pragma unroll
            for (int c = 0; c < 2; ++c) { acc[c] = f32x16{};
#pragma unroll
                for (int kd = 0; kd < 8; ++kd) acc[c] = MFMA32(qf[kd], ld_row(Cw, RB.r[kd & 1] + ROW_OFF(c, kd)), acc[c]);
#pragma unroll
                for (int r = 0; r < 16; ++r) acc[c][r] *= dec; }
#pragma unroll
            for (int sb = 0; sb < 4; ++sb) {
                const bool live = dir ? (sb >= tb) : (sb <= tb);
                if (live) {
#pragma unroll
                    for (int sp = 0; sp < 2; ++sp)
#pragma unroll
                        for (int c = 0; c < 2; ++c) acc[c] = MFMA32(pf[2 * sb + sp], ld_tr2(Vw, RB.p[0] + TRP_OFF(c, 2 * sb + sp, 0), RB.p[1] + TRP_OFF(c, 2 * sb + sp, 1)), acc[c]);
                }
            }
            __syncthreads();
#pragma unroll
            for (int g4 = 0; g4 < 4; ++g4) { const f32x4 dv = *(const LAS f32x4*)(sc + 1536 + 32 * tb + 8 * g4 + 4 * hi), fv = *(const LAS f32x4*)(fl + 32 * tb + 8 * g4 + 4 * hi);
#pragma unroll
                for (int q = 0; q < 4; ++q) { const float inv = 1.f / fmaxf(fabsf(dv[q]), fv[q]);
                    hsum[0][4 * g4 + q] += acc[0][4 * g4 + q] * inv; hsum[1][4 * g4 + q] += acc[1][4 * g4 + q] * inv; } }
        }
        int lq = lane; asm volatile("" : "+v"(lq));
        const int hi2 = lq >> 5, tl2 = lq & 31;
        float ss[16];
#pragma unroll
        for (int r = 0; r < 16; ++r) { float v = hsum[0][r] * hsum[0][r] + hsum[1][r] * hsum[1][r];
#pragma unroll
            for (int o = 1; o < 32; o <<= 1) v += __shfl_xor(v, o);
            ss[r] = v; }
        if (tl2 == 0) {
#pragma unroll
            for (int r = 0; r < 16; ++r) sc[1664 + eh * 128 + 32 * tb + crow(r, hi2)] = ss[r]; }
        __syncthreads();
        bf16* mo = MIX + (size_t)(b * SEQ + 128 * j + 32 * tb + 4 * hi2) * DM + h * 128 + 64 * eh + tl2;
        const bf16* og = P + (size_t)(r0 + 32 * tb + 4 * hi2) * LDP + PC_MO + h * 128 + 64 * eh + tl2;
        const LAS float* sq = sc + 1664 + 32 * tb + 4 * hi2;
        const float g0 = in_gm[h * 128 + 64 * eh + tl2], g1 = in_gm[h * 128 + 64 * eh + 32 + tl2];
#pragma unroll
        for (int r = 0; r < 16; ++r) { const int row = (r & 3) + 8 * (r >> 2); const float rs = rsqrtf((sq[row] + sq[128 + row]) * (1.f / 128.f) + EPS);
            mo[(size_t)row * DM] = (bf16)f2bf(hsum[0][r] * rs * g0 * sigmoid_f(bf2f(og[(size_t)row * LDP])));
            mo[(size_t)row * DM + 32] = (bf16)f2bf(hsum[1][r] * rs * g1 * sigmoid_f(bf2f(og[(size_t)row * LDP + 32]))); }
    }
}
#undef MFMA32
}

#define GAS __attribute__((address_space(1)))
typedef GAS unsigned gu32;
#define RLX_AGENT __ATOMIC_RELAXED, __HIP_MEMORY_SCOPE_AGENT
#define XB_TMO      128
#define XB_XCNT(j)  (256  + 64 * (j))
#define XB_XSUB(j)  (1280 + 64 * (j))
#define XB_XGEN(j)  (2304 + 64 * (j))
#define XB_TOP      3328
#define XB_TOPGEN   3392
#define XCD_BAR_WORDS 3456
#define XB_SPIN_CAP (1u << 25)

__device__ __forceinline__ unsigned xb_ld(unsigned* p)              { return __hip_atomic_load(p, __ATOMIC_RELAXED, __HIP_MEMORY_SCOPE_AGENT); }
__device__ __forceinline__ unsigned xb_add(unsigned* p, unsigned v) { return __hip_atomic_fetch_add(p, v, __ATOMIC_RELAXED, __HIP_MEMORY_SCOPE_AGENT); }
__device__ __forceinline__ unsigned xb_xcc_id() { return (unsigned)__builtin_amdgcn_s_getreg((3 << 11) | 20) & 0xFu; }
#define XB_SPIN(cond, bar) do { unsigned _sp = 0; while (cond) { __builtin_amdgcn_s_sleep(1); \
    if ((++_sp & 255u) == 0u) { if (xb_ld(&(bar)[XB_TMO])) break; if (_sp > XB_SPIN_CAP) { atomicAdd(&(bar)[XB_TMO], 1u); break; } } } } while (0)

struct XcdBarrier {
    unsigned* bar; unsigned x;
    volatile LAS unsigned* st;
};

__device__ __forceinline__ XcdBarrier xcd_barrier_post(unsigned* bar, volatile LAS unsigned* st) {
    XcdBarrier b; b.bar = bar; b.x = xb_xcc_id(); b.st = st;
    if (threadIdx.x == 0) (void)xb_add(&bar[XB_XCNT(b.x)], 1u);
    return b;
}
__device__ __forceinline__ void xcd_barrier_complete(unsigned* bar, unsigned x, unsigned& nloc, unsigned& nx) {
    const unsigned G = gridDim.x * gridDim.y * gridDim.z;
    unsigned sum, cnt, mine, sp = 0u;
    for (;;) {
        sum = 0u; cnt = 0u; mine = 0u;
#pragma unroll
        for (unsigned j = 0; j < 16; ++j) { const unsigned c = xb_ld(&bar[XB_XCNT(j)]); sum += c; cnt += (c > 0u) ? 1u : 0u; mine = (j == x) ? c : mine; }
        if (sum == G) break;
        __builtin_amdgcn_s_sleep(1);
        if ((++sp & 255u) == 0u) { if (xb_ld(&bar[XB_TMO])) break; if (sp > XB_SPIN_CAP) { atomicAdd(&bar[XB_TMO], 1u); break; } }
    }
    nloc = mine > 0u ? mine : 1u; nx = cnt > 0u ? cnt : 1u;
}

__device__ __forceinline__ void xcd_barrier(const XcdBarrier& b) {
    asm volatile("s_waitcnt vmcnt(0)" ::: "memory");
    __syncthreads();
    if (threadIdx.x == 0) {
        unsigned* bar = b.bar;
        __builtin_amdgcn_s_waitcnt(0);
        unsigned nloc = b.st[0], nx = b.st[1];
        if (nloc == 0u) { xcd_barrier_complete(bar, b.x, nloc, nx); b.st[0] = nloc; b.st[1] = nx; }
        const unsigned old = xb_add(&bar[XB_XSUB(b.x)], 1u);
        const unsigned gen = old / nloc;
        if (old + 1u == (gen + 1u) * nloc) {
            __builtin_amdgcn_fence(__ATOMIC_RELEASE, "agent");
            asm volatile("s_waitcnt vmcnt(0)" ::: "memory");
            const unsigned og = xb_add(&bar[XB_TOP], 1u);
            const unsigned tg = og / nx;
            if (og + 1u == (tg + 1u) * nx) xb_add(&bar[XB_TOPGEN], 1u);
            else XB_SPIN(xb_ld(&bar[XB_TOPGEN]) == tg, bar);
            __builtin_amdgcn_fence(__ATOMIC_ACQUIRE, "agent");
            xb_add(&bar[XB_XGEN(b.x)], 1u);
            asm volatile("s_waitcnt vmcnt(0)" ::: "memory");
        } else {
            XB_SPIN(xb_ld(&bar[XB_XGEN(b.x)]) == gen, bar);
            __builtin_amdgcn_fence(__ATOMIC_ACQUIRE, "agent");
            asm volatile("s_waitcnt vmcnt(0)" ::: "memory");
        }
    }
    __syncthreads();
}


#ifndef MK_N_LAUNCHES
#define MK_N_LAUNCHES 1
#endif
constexpr int N_PHASES = 12;
struct Args { const float* in[25]; float* out; unsigned char* ws; int ph_lo, ph_hi; };
template <int PH_LO, int PH_HI>
__global__ void __launch_bounds__(NWAVES * 64, 2) fwd_kernel(Args args) {
    extern __shared__ __attribute__((aligned(16))) unsigned char lds[];
    Frame F;
    F.lds = lds; F.tid = threadIdx.x; F.lane = F.tid & 63; F.wave = __builtin_amdgcn_readfirstlane(F.tid >> 6);
    F.G = gridDim.x; { const int bx = blockIdx.x; F.vcu = (F.G % 8 == 0) ? (bx % 8) * (F.G / 8) + bx / 8 : bx; }
    F.out = args.out; F.ws = args.ws;
    constexpr int lo = PH_LO, hi = PH_HI;
    PG8_LAS unsigned char* ring = (PG8_LAS unsigned char*)lds;
    XcdBarrier bar; bar.bar = nullptr; bar.x = 0; bar.st = nullptr;
    if constexpr (hi - lo > 1) {
        for (int u = F.tid; u < (LDS_BYTES - LDSCTL_OFF) / 4; u += NWAVES * 64) ((LAS unsigned*)((LAS unsigned char*)lds + LDSCTL_OFF))[u] = 0u;
        __syncthreads();
        bar = xcd_barrier_post((unsigned*)(F.ws + WS_CTL) + CW_BAR, (volatile LAS unsigned*)((LAS unsigned char*)lds + MISC_OFF) + 8);
    }
#define IN(k) (lo <= (k) && (k) < hi)
#ifdef PROBE_PHASE
    volatile LAS unsigned long long* tsv = (volatile LAS unsigned long long*)((LAS unsigned char*)lds + 144512);
    if (blockIdx.x == 0 && threadIdx.x == 0) tsv[0] = __builtin_amdgcn_s_memrealtime();
#define SEAM(k) do { if constexpr (IN(k) && IN((k) + 1)) xcd_barrier(bar); if (blockIdx.x == 0 && threadIdx.x == 0) tsv[(k) + 1] = __builtin_amdgcn_s_memrealtime(); } while (0)
#else
#define SEAM(k) do { if constexpr (IN(k) && IN((k) + 1)) xcd_barrier(bar); } while (0)
#endif
    if constexpr (IN(0)) p0_prologue(F);
    SEAM(0);
    if constexpr (IN(1)) p1_xn(F);
    SEAM(1);
    if constexpr (IN(2)) { pg8::Gemm g{(const pg8::bf16_t*)(F.ws + WS_XN), (const pg8::bf16_t*)(F.ws + WS_WIN), UROWS, NPAD, DM}; pg8::StaticOrder S; S.init(UROWS, NPAD, F.G, (int)blockIdx.x);
        pg8::EpiBf16 E{(pg8::bf16_t*)(F.ws + WS_P), LDP, (float*)(F.ws + WS_GATES), LDP / 256};
        pg8::gemm_phase<pg8::EpiBf16, pg8::StaticOrder, true, true>(ring, g, S, E); }
    SEAM(2);
    if constexpr (IN(3)) { p3_rope(F); ml::stage1(F); }
    SEAM(3);
    if constexpr (IN(4)) ml::stage2(F);
    SEAM(4);
    if constexpr (IN(5)) { ml::stage3(F); p5_attn(F);
#if defined(PROBE_REPEAT) && PROBE_REPEAT == 5
        xcd_barrier(bar); p5_attn(F);
#endif
#if defined(PROBE_REPEAT) && PROBE_REPEAT == 53
        xcd_barrier(bar); ml::stage3(F);
#endif
    }
    SEAM(5);
    if constexpr (IN(6)) { pg8::Gemm g{(const pg8::bf16_t*)(F.ws + WS_MIX), (const pg8::bf16_t*)(F.ws + WS_WOUT), LROWS, DM, DM}; pg8::StaticOrder S; S.init(LROWS, DM, F.G, (int)blockIdx.x);
        pg8::EpiF32 E{(float*)(F.ws + WS_Y), DM};
        pg8::gemm_phase<pg8::EpiF32, pg8::StaticOrder, true, true>(ring, g, S, E); }
    SEAM(6);
    if constexpr (IN(7)) p7_x1(F);
    SEAM(7);
    if constexpr (IN(8)) { pg8::Gemm g{(const pg8::bf16_t*)(F.ws + WS_XN), (const pg8::bf16_t*)(F.ws + WS_WUP), LROWS, NUP, DM}; pg8::StaticOrder S; S.init(LROWS, NUP, F.G, (int)blockIdx.x);
        pg8::EpiFfn E{(pg8::bf16_t*)(F.ws + WS_HMID), DFF, inptr(I_CONVFFNW), inptr(I_CONVFFNB), NUP, DFF, (float*)(F.ws + WS_EDGE), (PG8_LAS float*)((PG8_LAS unsigned char*)lds + ml::SC_OFF)};
        pg8::gemm_phase<pg8::EpiFfn, pg8::StaticOrder, true, true>(ring, g, S, E); }
    SEAM(8);
    if constexpr (IN(9)) ffn_edge_fix(F);
    SEAM(9);
    if constexpr (IN(10)) { pg8::Gemm g{(const pg8::bf16_t*)(F.ws + WS_HMID), (const pg8::bf16_t*)(F.ws + WS_WDN), LROWS, DM, DFF}; pg8::StaticOrder S; S.init(LROWS, DM, F.G, (int)blockIdx.x);
        pg8::EpiF32 E{(float*)(F.ws + WS_Y2), DM};
        pg8::gemm_phase<pg8::EpiF32, pg8::StaticOrder, true, true>(ring, g, S, E); }
    SEAM(10);
    if constexpr (IN(11)) p13_final(F);
#ifdef PROBE_PHASE
    if (blockIdx.x == 0 && threadIdx.x == 0) { tsv[N_PHASES] = __builtin_amdgcn_s_memrealtime(); asm volatile("s_waitcnt vmcnt(0)" ::: "memory");
        F.out[0] += (float)(tsv[PROBE_PHASE_END + 1] - tsv[PROBE_PHASE]) * 0.01f; }
#endif
#undef IN
#undef SEAM
}

extern "C" void kernel_launch(void* const* d_in, const int* in_sizes, int n_in, void* d_out, int out_size, void* d_ws, size_t ws_size, hipStream_t stream) {
    static int grid = 0;
    if (grid == 0) {
        if (n_in != 25 || in_sizes[0] != LROWS * DM || out_size != LROWS * DM || ws_size < WS_END) { fprintf(stderr, "kernel_launch: unexpected shapes / workspace (n_in %d, ws %zu, need %zu)\n", n_in, ws_size, (size_t)WS_END); grid = -1; return; }
        bool ok = true;
#define SETATTR(a, b) ok = ok && (hipFuncSetAttribute((const void*)fwd_kernel<a, b>, hipFuncAttributeMaxDynamicSharedMemorySize, LDS_BYTES) == hipSuccess)
#if MK_N_LAUNCHES == 1
        SETATTR(0, N_PHASES);
#else
        SETATTR(0, 1); SETATTR(1, 2); SETATTR(2, 3); SETATTR(3, 4); SETATTR(4, 5); SETATTR(5, 6); SETATTR(6, 7); SETATTR(7, 8); SETATTR(8, 9); SETATTR(9, 10); SETATTR(10, 11); SETATTR(11, 12);
#endif
#undef SETATTR
        if (!ok) { fprintf(stderr, "kernel_launch: hipFuncSetAttribute failed\n"); grid = -1; return; }
        int dev = 0, cus = 0, per_cu = 0; (void)hipGetDevice(&dev); (void)hipDeviceGetAttribute(&cus, hipDeviceAttributeMultiprocessorCount, dev);
#if MK_N_LAUNCHES == 1
        if (hipOccupancyMaxActiveBlocksPerMultiprocessor(&per_cu, (const void*)fwd_kernel<0, N_PHASES>, NWAVES * 64, LDS_BYTES) != hipSuccess || per_cu < 1) { fprintf(stderr, "kernel_launch: occupancy query says %d blocks per CU\n", per_cu); (void)hipGetLastError(); }
#endif
        grid = cus > 0 ? cus : 256;
    }
    if (grid < 0) return;
    (void)hipMemsetAsync((char*)d_ws + WS_CTL, 0, CTL_ZERO_BYTES, stream);
    Args a{};
    for (int i = 0; i < 25; ++i) a.in[i] = (const float*)d_in[i];
    a.out = (float*)d_out; a.ws = (unsigned char*)d_ws;
#if MK_N_LAUNCHES == 1
    hipLaunchKernelGGL((fwd_kernel<0, N_PHASES>), dim3(grid), dim3(NWAVES * 64), LDS_BYTES, stream, a);
#else
#define LAUNCH(p) hipLaunchKernelGGL((fwd_kernel<p, p + 1>), dim3(grid), dim3(NWAVES * 64), LDS_BYTES, stream, a)
    LAUNCH(0); LAUNCH(1); LAUNCH(2); LAUNCH(3); LAUNCH(4); LAUNCH(5); LAUNCH(6); LAUNCH(7); LAUNCH(8); LAUNCH(9); LAUNCH(10); LAUNCH(11);
#undef LAUNCH
#endif
}
```

```cpp
#include <hip/hip_runtime.h>
#include <hip/hip_bf16.h>
#include <cstdio>
#include <cstdint>
#include <cmath>

namespace pg8 {
#define PG8_LAS __attribute__((address_space(3)))
typedef unsigned short bf16_t;
typedef short bf16x8 __attribute__((ext_vector_type(8)));
typedef float f32x4 __attribute__((ext_vector_type(4)));
typedef unsigned u32x4 __attribute__((ext_vector_type(4)));
typedef unsigned u32x2 __attribute__((ext_vector_type(2)));
typedef float f32x2 __attribute__((ext_vector_type(2)));
constexpr int BM = 256, BK = 64, HALF = 128, HTB = HALF * BK * 2  , STAGE_BYTES = 8 * HTB, NXCD = 8, WGM = 8;

__host__ __device__ __forceinline__ int lds_byte(int r, int c) { const int st = (r >> 4) * 2 + (c >> 5), rr = r & 15, cc = c & 31, ob = rr * 64 + cc * 2; return st * 1024 + (ob ^ (((ob >> 9) & 1) << 5)); }
__host__ __device__ __forceinline__ void stage_rc(int b, int& R, int& C) { const int st = b / 1024, sb = b % 1024, swz = sb ^ (((sb >> 9) & 1) << 5); R = (st >> 1) * 16 + swz / 64; C = (st & 1) * 32 + (swz % 64) / 2; }
__host__ __device__ __forceinline__ int perm32(int rho) { const int n = rho >> 4, i = rho & 15; return 8 * (i >> 2) + 4 * n + (i & 3); }

struct Unit { int pm, pn; };
struct Gemm { const bf16_t* A; const bf16_t* Bt; int M, N, K; };

struct StaticOrder {
    int nM, nN, nwg, G, c;
    __host__ __device__ void init(int M, int N, int G_, int c_) { nM = M / BM; nN = N / BM; nwg = nM * nN; G = G_; c = c_; }
    __host__ __device__ bool next(int i, Unit& u) const {
        const long L = (long)i * G + c; if (L >= nwg) return false;
        int wgid = (int)L; { const int q = nwg / NXCD, r = nwg % NXCD, xcd = wgid % NXCD, off = wgid / NXCD; wgid = (xcd < r ? xcd * (q + 1) : r * (q + 1) + (xcd - r) * q) + off; }
        const int nig = WGM * nN, gid = wgid / nig, fm = gid * WGM, gsz = (nM - fm) < WGM ? (nM - fm) : WGM;
        u.pm = fm + ((wgid % nig) % gsz); u.pn = (wgid % nig) / gsz; return true;
    }
    __device__ __forceinline__ void a_ready(const Unit&) const {}
    __device__ __forceinline__ void done(const Unit&) const {}
};


__device__ __forceinline__ unsigned cvt_pk_bf16(float lo, float hi) { unsigned r; asm volatile("v_cvt_pk_bf16_f32 %0, %1, %2" : "=v"(r) : "v"(lo), "v"(hi)); return r; }

struct EpiBf16 {
    static constexpr bool PERM = true, AFTER_DRAIN = false;
    bf16_t* O; int ldc; float* gates; int gate_tile;
    __device__ __forceinline__ void operator()(const f32x4 (&acc)[2][2][4][2], const Unit& u, int wr, int wc, int fr, int fq) const {
        const int row0 = u.pm * BM + wr * 64 + fr;
        if (u.pn == gate_tile) {
            if (wc == 0) {
#pragma unroll
                for (int ai = 0; ai < 2; ++ai)
#pragma unroll
                    for (int m = 0; m < 4; ++m) { float* g = gates + (size_t)(row0 + ai * HALF + m * 16) * 32 + 8 * fq;
                        *(f32x4*)(g) = acc[ai][0][m][0]; *(f32x4*)(g + 4) = acc[ai][0][m][1]; }
            }
            return;
        }
        const int col0 = u.pn * BM + wc * 32 + 8 * fq;
#pragma unroll
        for (int ai = 0; ai < 2; ++ai)
#pragma unroll
            for (int m = 0; m < 4; ++m) { bf16_t* rowp = O + (size_t)(row0 + ai * HALF + m * 16) * ldc + col0;
#pragma unroll
                for (int bj = 0; bj < 2; ++bj) { const f32x4 v0 = acc[ai][bj][m][0], v1 = acc[ai][bj][m][1];
                    u32x4 w; w.x = cvt_pk_bf16(v0[0], v0[1]); w.y = cvt_pk_bf16(v0[2], v0[3]); w.z = cvt_pk_bf16(v1[0], v1[1]); w.w = cvt_pk_bf16(v1[2], v1[3]);
                    *(u32x4*)(rowp + bj * HALF) = w; } }
    }
};
__device__ __forceinline__ float dpp_ror1(float v) { return __builtin_bit_cast(float, __builtin_amdgcn_update_dpp(0, __builtin_bit_cast(int, v), 0x121, 0xf, 0xf, false)); }
__device__ __forceinline__ float dpp_rol1(float v) { return __builtin_bit_cast(float, __builtin_amdgcn_update_dpp(0, __builtin_bit_cast(int, v), 0x12f, 0xf, 0xf, false)); }
__device__ __forceinline__ float silu_e(float x) { return x * __builtin_amdgcn_rcpf(1.f + __expf(-x)); }
struct EpiFfn {
    static constexpr bool PERM = true, AFTER_DRAIN = false;
    bf16_t* H; int ldh; const float* cw; const float* cb; int nup, dff; float* edge; PG8_LAS float* xl;
    __device__ __forceinline__ void operator()(const f32x4 (&acc)[2][2][4][2], const Unit& u, int wr, int wc, int fr, int fq) const {
#pragma unroll
        for (int ai = 0; ai < 2; ++ai) { const int sg = 2 * ai + wr;
#pragma unroll
            for (int bj = 0; bj < 2; ++bj)
#pragma unroll
                for (int n = 0; n < 2; ++n) { PG8_LAS f32x4* p = (PG8_LAS f32x4*)xl + ((((sg * 2) * 4 + wc) * 2 + bj) * 2 + n) * 4 + fq;
                    if (fr == 0) p[0] = acc[ai][bj][0][n];
                    if (fr == 15) p[64] = acc[ai][bj][3][n]; } }
        asm volatile("s_waitcnt lgkmcnt(0)" ::: "memory"); __builtin_amdgcn_s_barrier(); asm volatile("" ::: "memory");
        const int npn = nup / BM; const int colh = u.pn * HALF + wc * 32 + 8 * fq;
        float* eb = edge + (size_t)(u.pm * npn + u.pn) * 1024;
#pragma unroll
        for (int ai = 0; ai < 2; ++ai) { const int sg = 2 * ai + wr;
#pragma unroll
            for (int n = 0; n < 2; ++n) {
                unsigned hpk[4][2];
#pragma unroll
                for (int hf = 0; hf < 2; ++hf) {
                    f32x2 sgv[4];
#pragma unroll
                    for (int bj = 0; bj < 2; ++bj) {
                        const int wcol = bj * dff + colh + 4 * n + 2 * hf;
                        const f32x2 w0 = *(const f32x2*)(cw + wcol), w1 = *(const f32x2*)(cw + nup + wcol), w2 = *(const f32x2*)(cw + 2 * nup + wcol), bb = *(const f32x2*)(cb + wcol);
                        const PG8_LAS f32x2* xp = (const PG8_LAS f32x2*)xl + (((wc * 2 + bj) * 2 + n) * 4 + fq) * 2 + hf;
                        f32x2 rprev = {0.f, 0.f};
                        if (sg > 0) rprev = xp[((sg - 1) * 128 + 64) * 2];
#pragma unroll
                        for (int m = 0; m < 4; ++m) {
                            const f32x2 cur = {acc[ai][bj][m][n][2 * hf], acc[ai][bj][m][n][2 * hf + 1]}; f32x2 rr, rl, rn;
#pragma unroll
                            for (int i = 0; i < 2; ++i) { rr[i] = dpp_ror1(cur[i]); rl[i] = dpp_rol1(cur[i]); }
                            if (m < 3) {
#pragma unroll
                                for (int i = 0; i < 2; ++i) rn[i] = dpp_rol1(acc[ai][bj][m < 3 ? m + 1 : 3][n][2 * hf + i]);
                            } else { rn = (f32x2){0.f, 0.f}; if (sg < 3) rn = xp[((sg + 1) * 128) * 2]; }
                            const f32x2 pv = fr > 0 ? rr : rprev, nx = fr < 15 ? rl : rn;
                            const f32x2 c = w0 * pv + w1 * cur + w2 * nx + bb;
                            rprev = rr;
                            if (m == 0) { if (sg == 0 && fr == 0) { float* e = eb + bj * HALF + wc * 32 + 8 * fq + 4 * n + 2 * hf; *(f32x2*)e = c; *(f32x2*)(e + 256) = cur; } }
                            if (m == 3) { if (sg == 3 && fr == 15) { float* e = eb + 512 + bj * HALF + wc * 32 + 8 * fq + 4 * n + 2 * hf; *(f32x2*)e = c; *(f32x2*)(e + 256) = cur; } }
                            if (bj == 0) { sgv[m][0] = silu_e(c[0]); sgv[m][1] = silu_e(c[1]); } else sgv[m] = sgv[m] * c;
                        }
                    }
#pragma unroll
                    for (int m = 0; m < 4; ++m) hpk[m][hf] = cvt_pk_bf16(sgv[m][0], sgv[m][1]);
                }
#pragma unroll
                for (int m = 0; m < 4; ++m) { u32x2 w; w.x = hpk[m][0]; w.y = hpk[m][1];
                    *(u32x2*)(H + (size_t)(u.pm * BM + ai * HALF + wr * 64 + m * 16 + fr) * ldh + colh + 4 * n) = w; }
                asm volatile("" ::: "memory");
            }
        }
    }
};
struct EpiF32 {
    static constexpr bool PERM = false, AFTER_DRAIN = false;
    float* O; int ldc;
    __device__ __forceinline__ void operator()(const f32x4 (&acc)[2][2][4][2], const Unit& u, int wr, int wc, int fr, int fq) const {
        const int row0 = u.pm * BM + wr * 64 + fr, col0 = u.pn * BM + wc * 32 + 4 * fq;
#pragma unroll
        for (int ai = 0; ai < 2; ++ai)
#pragma unroll
            for (int m = 0; m < 4; ++m) { float* rowp = O + (size_t)(row0 + ai * HALF + m * 16) * ldc + col0;
#pragma unroll
                for (int bj = 0; bj < 2; ++bj)
#pragma unroll
                    for (int n = 0; n < 2; ++n) *(f32x4*)(rowp + bj * HALF + n * 16) = acc[ai][bj][m][n]; }
    }
};

template <class Epi, class Sched, bool ALIGN_EPI = false, bool SP2 = false>
__device__ __forceinline__ void gemm_phase(PG8_LAS unsigned char* lds, const Gemm g, const Sched& S, const Epi& E) {
    int tid_ = threadIdx.x; asm volatile("" : "+v"(tid_));
    const int tid = tid_, wid = __builtin_amdgcn_readfirstlane(tid >> 6), lane = tid & 63, wr = wid >> 2, wc = wid & 3, fr = lane & 15, fq = lane >> 4;
    const int K = g.K, nt = K / BK;
    unsigned voffA[2], voffB[2];
#pragma unroll
    for (int i = 0; i < 2; ++i) { int R, C; stage_rc(tid * 16 + i * 8192, R, C); const int Rb = Epi::PERM ? ((R & ~31) + perm32(R & 31)) : R;
        voffA[i] = (unsigned)(R * K + C) * 2u; voffB[i] = (unsigned)(Rb * K + C) * 2u; }
    const size_t kstep = (size_t)(BK * 2);
    const size_t hstep = (size_t)HALF * K * 2;
    const size_t tstep = 2 * hstep;
    const unsigned ldsw = (unsigned)wid * 1024u;
    const int aoff = lds_byte(wr * 64 + fr, fq * 8), boff = lds_byte(wc * 32 + fr, fq * 8);
#define PG8_SA(b, h) (((b) * 2 + (h)) * HTB)
#define PG8_SB(b, h) ((4 + (b) * 2 + (h)) * HTB)
#define PG8_STAGE(bufoff, gbase, voff) do { _Pragma("unroll") for (int _i = 0; _i < 2; ++_i) \
        __builtin_amdgcn_global_load_lds((const unsigned*)((const char*)(gbase) + (voff)[_i]), (PG8_LAS unsigned*)(lds + (bufoff) + ldsw + _i * 8192), 16, 0, 0); } while (0)
#define PG8_LDA(dst, b, h) do { _Pragma("unroll") for (int m = 0; m < 4; ++m) _Pragma("unroll") for (int k = 0; k < 2; ++k) dst[m][k] = *(const PG8_LAS bf16x8*)(lds + PG8_SA(b, h) + aoff + m * 2048 + k * 1024); } while (0)
#define PG8_LDB(dst, b, h) do { _Pragma("unroll") for (int n = 0; n < 2; ++n) _Pragma("unroll") for (int k = 0; k < 2; ++k) dst[n][k] = *(const PG8_LAS bf16x8*)(lds + PG8_SB(b, h) + boff + n * 2048 + k * 1024); } while (0)
#define PG8_MMA(ai, bj, At, Bt) do { __builtin_amdgcn_s_setprio(1); _Pragma("unroll") for (int m = 0; m < 4; ++m) _Pragma("unroll") for (int n = 0; n < 2; ++n) _Pragma("unroll") for (int k = 0; k < 2; ++k) \
        acc[ai][bj][m][n] = __builtin_amdgcn_mfma_f32_16x16x32_bf16(Bt[n][k], At[m][k], acc[ai][bj][m][n], 0, 0, 0); __builtin_amdgcn_s_setprio(0); } while (0)
#define PG8_WAIT_V(n) asm volatile("s_waitcnt vmcnt(" #n ")" ::: "memory")
#define PG8_WAIT_L(n) asm volatile("s_waitcnt lgkmcnt(" #n ")" ::: "memory")
#define PG8_BAR __builtin_amdgcn_s_barrier()
#define PG8_SCHED __builtin_amdgcn_sched_barrier(0)
    Unit cur, nxt; int ui = 0;
    if (!S.next(0, cur)) return;
    f32x4 acc[2][2][4][2];
#pragma unroll
    for (int a = 0; a < 2; ++a)
#pragma unroll
        for (int b = 0; b < 2; ++b)
#pragma unroll
            for (int m = 0; m < 4; ++m)
#pragma unroll
                for (int n = 0; n < 2; ++n) acc[a][b][m][n] = (f32x4){0.f, 0.f, 0.f, 0.f};
    bf16x8 At[4][2], B0[2][2], B1[2][2];
    const char* cA = (const char*)g.A + (size_t)cur.pm * tstep; const char* cB = (const char*)g.Bt + (size_t)cur.pn * tstep;
    S.a_ready(cur);
    if constexpr (SP2) {
        PG8_STAGE(PG8_SB(0, 0), cB, voffB); PG8_STAGE(PG8_SB(0, 1), cB + hstep, voffB); PG8_STAGE(PG8_SA(0, 0), cA, voffA); PG8_STAGE(PG8_SA(0, 1), cA + hstep, voffA);
        if (wr == 1) PG8_BAR;
        PG8_WAIT_V(2); PG8_BAR;
        PG8_STAGE(PG8_SB(1, 0), cB + kstep, voffB); PG8_STAGE(PG8_SA(1, 0), cA + kstep, voffA); PG8_STAGE(PG8_SB(1, 1), cB + hstep + kstep, voffB);
        PG8_WAIT_V(6); PG8_BAR;
    } else {
        PG8_STAGE(PG8_SB(0, 0), cB, voffB); PG8_STAGE(PG8_SA(0, 0), cA, voffA); PG8_STAGE(PG8_SB(0, 1), cB + hstep, voffB); PG8_STAGE(PG8_SA(0, 1), cA + hstep, voffA);
        if (wr == 1) PG8_BAR;
        PG8_WAIT_V(4); PG8_BAR;
        PG8_STAGE(PG8_SB(1, 0), cB + kstep, voffB); PG8_STAGE(PG8_SA(1, 0), cA + kstep, voffA); PG8_STAGE(PG8_SB(1, 1), cB + hstep + kstep, voffB);
        PG8_WAIT_V(6); PG8_BAR;
    }
    for (;;) {
        const bool has_next = S.next(ui + 1, nxt);
        const char* nA = has_next ? (const char*)g.A + (size_t)nxt.pm * tstep : cA; const char* nB = has_next ? (const char*)g.Bt + (size_t)nxt.pn * tstep : cB;
        for (int t = 0; t < nt; t += 2) {
            const bool last = (t == nt - 2);
            const char* a1 = cA + (size_t)(t + 1) * kstep;
            const char* a2 = last ? nA : cA + (size_t)(t + 2) * kstep; const char* b2 = last ? nB : cB + (size_t)(t + 2) * kstep;
            const char* a3 = a2 + kstep; const char* b3 = b2 + kstep;
            if (last && has_next) S.a_ready(nxt);
            if constexpr (SP2) {
            PG8_LDB(B0, 0, 0); PG8_LDB(B1, 0, 1); PG8_SCHED; PG8_LDA(At, 0, 0); PG8_STAGE(PG8_SA(1, 1), a1 + hstep, voffA);
            PG8_WAIT_V(8); PG8_WAIT_L(0); PG8_BAR; PG8_MMA(0, 0, At, B0); PG8_MMA(0, 1, At, B1); PG8_BAR; PG8_SCHED;
            PG8_LDA(At, 0, 1); PG8_STAGE(PG8_SB(0, 0), b2, voffB); PG8_STAGE(PG8_SB(0, 1), b2 + hstep, voffB); PG8_STAGE(PG8_SA(0, 0), a2, voffA);
            PG8_WAIT_V(8); PG8_WAIT_L(0); PG8_BAR; PG8_MMA(1, 0, At, B0); PG8_MMA(1, 1, At, B1); PG8_BAR; PG8_SCHED;
            PG8_LDB(B0, 1, 0); PG8_LDB(B1, 1, 1); PG8_SCHED; PG8_LDA(At, 1, 0); PG8_STAGE(PG8_SA(0, 1), a2 + hstep, voffA);
            PG8_WAIT_V(8); PG8_WAIT_L(0); PG8_BAR; PG8_MMA(0, 0, At, B0); PG8_MMA(0, 1, At, B1); PG8_BAR; PG8_SCHED;
            PG8_LDA(At, 1, 1); PG8_STAGE(PG8_SB(1, 0), b3, voffB); PG8_STAGE(PG8_SB(1, 1), b3 + hstep, voffB); PG8_STAGE(PG8_SA(1, 0), a3, voffA);
            PG8_WAIT_V(8); PG8_WAIT_L(0); PG8_BAR; PG8_MMA(1, 0, At, B0); PG8_MMA(1, 1, At, B1); PG8_BAR; PG8_SCHED;
            } else {
            PG8_LDB(B0, 0, 0); PG8_SCHED; PG8_LDA(At, 0, 0); PG8_STAGE(PG8_SA(1, 1), a1 + hstep, voffA);
            PG8_WAIT_L(8); PG8_BAR; PG8_WAIT_L(0); PG8_MMA(0, 0, At, B0); PG8_BAR; PG8_SCHED;
            PG8_LDB(B1, 0, 1); PG8_STAGE(PG8_SB(0, 0), b2, voffB);
            PG8_BAR; PG8_WAIT_L(0); PG8_MMA(0, 1, At, B1); PG8_BAR;
            PG8_LDA(At, 0, 1); PG8_STAGE(PG8_SA(0, 0), a2, voffA);
            PG8_BAR; PG8_WAIT_L(0); PG8_MMA(1, 0, At, B0); PG8_BAR; PG8_SCHED;
            PG8_STAGE(PG8_SB(0, 1), b2 + hstep, voffB);
            PG8_WAIT_V(6); PG8_BAR; PG8_MMA(1, 1, At, B1); PG8_BAR;
            PG8_LDB(B0, 1, 0); PG8_SCHED; PG8_LDA(At, 1, 0); PG8_STAGE(PG8_SA(0, 1), a2 + hstep, voffA);
            PG8_WAIT_L(8); PG8_BAR; PG8_WAIT_L(0); PG8_MMA(0, 0, At, B0); PG8_BAR; PG8_SCHED;
            PG8_LDB(B1, 1, 1); PG8_STAGE(PG8_SB(1, 0), b3, voffB);
            PG8_BAR; PG8_WAIT_L(0); PG8_MMA(0, 1, At, B1); PG8_BAR;
            PG8_LDA(At, 1, 1); PG8_STAGE(PG8_SA(1, 0), a3, voffA);
            PG8_BAR; PG8_WAIT_L(0); PG8_MMA(1, 0, At, B0); PG8_BAR; PG8_SCHED;
            PG8_STAGE(PG8_SB(1, 1), b3 + hstep, voffB);
            PG8_WAIT_V(6); PG8_BAR; PG8_MMA(1, 1, At, B1); PG8_BAR;
            }
        }
        if constexpr (ALIGN_EPI) { if (wr == 0) PG8_BAR; }
        if constexpr (!Epi::AFTER_DRAIN) { E(acc, cur, wr, wc, fr, fq); S.done(cur); }
        if (!has_next) break;
#pragma unroll
        for (int a = 0; a < 2; ++a)
#pragma unroll
            for (int b = 0; b < 2; ++b)
#pragma unroll
                for (int m = 0; m < 4; ++m)
#pragma unroll
                    for (int n = 0; n < 2; ++n) acc[a][b][m][n] = (f32x4){0.f, 0.f, 0.f, 0.f};
        cur = nxt; cA = nA; cB = nB; ++ui;
        if constexpr (ALIGN_EPI) { if (wr == 1) PG8_BAR; }
    }
    PG8_WAIT_V(0);
    if constexpr (!ALIGN_EPI) { if (wr == 0) PG8_BAR; }
    PG8_BAR;
    if constexpr (Epi::AFTER_DRAIN) { E.fused(acc, cur, wr, wc, fr, fq, lds, wid, lane); S.done(cur); }
#undef PG8_SA
#undef PG8_SB
#undef PG8_STAGE
#undef PG8_LDA
#undef PG8_LDB
#undef PG8_MMA
#undef PG8_WAIT_V
#undef PG8_WAIT_L
#undef PG8_BAR
#undef PG8_SCHED
}
}


namespace attn {
using bf16x8 = __attribute__((ext_vector_type(8))) short;
using s16x4  = __attribute__((ext_vector_type(4))) short;
using f32x16 = __attribute__((ext_vector_type(16))) float;
using u32x4  = __attribute__((ext_vector_type(4))) unsigned;
typedef unsigned short bf16;
constexpr int NW = 8, QBLK = 32, KVBLK = 64;
constexpr float SCALE = 0.125f;
constexpr float THR = 8.f;
constexpr int SHM_V = KVBLK * 128 * 2, SHM_K = KVBLK * 64 * 2, SHM_ATTN = 2 * SHM_V + 2 * SHM_K + NW * 64 * 4;
#define KSWZ64(row, ch) ((row) * 128 + ((((ch) ^ (((row) >> 1) & 7))) << 4))
#define SBAR() __builtin_amdgcn_sched_barrier(0)
__device__ __forceinline__ int crow(int r, int hi) { return (r & 3) + 8 * (r >> 2) + 4 * hi; }
__device__ __forceinline__ unsigned cvtpk(float lo, float hi) { unsigned r; asm volatile("v_cvt_pk_bf16_f32 %0, %1, %2" : "=v"(r) : "v"(lo), "v"(hi)); return r; }

__device__ __forceinline__ void partialSM(f32x16& p0, f32x16& p1, float& m_reg, float& mn, float& alpha) {
  constexpr float C = SCALE * 1.4426950408889634f;
  float pmax = p0[0];
#pragma unroll
  for (int r = 1; r < 16; ++r) pmax = fmaxf(pmax, p0[r]);
#pragma unroll
  for (int r = 0; r < 16; ++r) pmax = fmaxf(pmax, p1[r]);
  { auto rr = __builtin_amdgcn_permlane32_swap(__float_as_uint(pmax), __float_as_uint(pmax), false, false);
    pmax = fmaxf(__uint_as_float(rr[0]), __uint_as_float(rr[1])); }
  if (__builtin_expect(__all(pmax - m_reg <= THR / SCALE), 1)) { mn = m_reg; alpha = 1.f; }
  else { mn = fmaxf(m_reg, pmax); alpha = __builtin_amdgcn_exp2f((m_reg - mn) * C); m_reg = mn; }
  float mnC = -mn * C;
#pragma unroll
  for (int r = 0; r < 16; ++r) p0[r] = fmaf(p0[r], C, mnC);
#pragma unroll
  for (int r = 0; r < 16; ++r) p1[r] = fmaf(p1[r], C, mnC);
#pragma unroll
  for (int r = 0; r < 16; ++r) p0[r] = __builtin_amdgcn_exp2f(p0[r]);
}
__device__ __forceinline__ void finishSM(f32x16& p0, f32x16& p1, float alpha, float& l_reg, bf16x8& pa0, bf16x8& pa1, bf16x8& pa2, bf16x8& pa3) {
#pragma unroll
  for (int r = 0; r < 16; ++r) p1[r] = __builtin_amdgcn_exp2f(p1[r]);
  float ps = 0;
#pragma unroll
  for (int r = 0; r < 16; ++r) ps += p0[r];
#pragma unroll
  for (int r = 0; r < 16; ++r) ps += p1[r];
  { auto rr = __builtin_amdgcn_permlane32_swap(__float_as_uint(ps), __float_as_uint(ps), false, false);
    ps = __uint_as_float(rr[0]) + __uint_as_float(rr[1]); }
  l_reg = l_reg * alpha + ps;
#define PK4(P, BASE, OUT) do { unsigned a0 = cvtpk(P[BASE + 0], P[BASE + 1]), a1 = cvtpk(P[BASE + 2], P[BASE + 3]);   \
    unsigned b0 = cvtpk(P[BASE + 4], P[BASE + 5]), b1 = cvtpk(P[BASE + 6], P[BASE + 7]);                              \
    auto r0 = __builtin_amdgcn_permlane32_swap(a0, b0, false, false); auto r1 = __builtin_amdgcn_permlane32_swap(a1, b1, false, false); \
    u32x4 w = {r0[0], r1[0], r0[1], r1[1]}; OUT = *reinterpret_cast<bf16x8*>(&w); } while (0)
  PK4(p0, 0, pa0); PK4(p0, 8, pa1); PK4(p1, 0, pa2); PK4(p1, 8, pa3);
#undef PK4
}
__device__ __forceinline__ void qkt(f32x16& p0, f32x16& p1, const char* Ks, const bf16x8* qr, int r32, int hi) {
  p0 = f32x16{}; p1 = f32x16{};
#pragma unroll
  for (int d0 = 0; d0 < 4; ++d0) { const int ch = 2 * d0 + hi;
    bf16x8 b0 = *reinterpret_cast<const bf16x8*>(Ks + KSWZ64(r32, ch));
    bf16x8 b1 = *reinterpret_cast<const bf16x8*>(Ks + KSWZ64(32 + r32, ch));
    p0 = __builtin_amdgcn_mfma_f32_32x32x16_bf16(b0, qr[d0], p0, 0, 0, 0);
    p1 = __builtin_amdgcn_mfma_f32_32x32x16_bf16(b1, qr[d0], p1, 0, 0, 0); }
}
__device__ __forceinline__ int v_st(int k, int c) { const int kk = (k & ~0xC) | ((k & 4) << 1) | ((k & 8) >> 1); return ((kk >> 3) * 4 + (c >> 5)) * 512 + ((kk & 7) * 32 + (c & 31)) * 2; }
__device__ __forceinline__ int v_rd_base(int lane) { return ((lane & 3) << 3) | (((lane >> 2) & 3) << 6) | (((lane >> 4) & 1) << 5) | (((lane >> 5) & 1) << 8); }
constexpr int v_rd_off(int d0, int ks, int half) { return d0 * 512 + ks * 4096 + half * 2048; }
template <int OFF> __device__ __forceinline__ s16x4 tr_read(int vb) {
  s16x4 r; asm volatile("ds_read_b64_tr_b16 %0, %1 offset:%2" : "=&v"(r) : "v"(vb), "i"(OFF) : "memory"); return r;
}
template <int D0> __device__ __forceinline__ void pv_one(f32x16& od, int vb, bf16x8 pa0, bf16x8 pa1, bf16x8 pa2, bf16x8 pa3) {
  const s16x4 l0 = tr_read<v_rd_off(D0, 0, 0)>(vb), h0 = tr_read<v_rd_off(D0, 0, 1)>(vb), l1 = tr_read<v_rd_off(D0, 1, 0)>(vb), h1 = tr_read<v_rd_off(D0, 1, 1)>(vb);
  const s16x4 l2 = tr_read<v_rd_off(D0, 2, 0)>(vb), h2 = tr_read<v_rd_off(D0, 2, 1)>(vb), l3 = tr_read<v_rd_off(D0, 3, 0)>(vb), h3 = tr_read<v_rd_off(D0, 3, 1)>(vb);
  asm volatile("s_waitcnt lgkmcnt(0)" ::: "memory"); SBAR();
#define PK(L, H) (bf16x8){L[0], L[1], L[2], L[3], H[0], H[1], H[2], H[3]}
  od = __builtin_amdgcn_mfma_f32_32x32x16_bf16(pa0, PK(l0, h0), od, 0, 0, 0);
  od = __builtin_amdgcn_mfma_f32_32x32x16_bf16(pa1, PK(l1, h1), od, 0, 0, 0);
  od = __builtin_amdgcn_mfma_f32_32x32x16_bf16(pa2, PK(l2, h2), od, 0, 0, 0);
  od = __builtin_amdgcn_mfma_f32_32x32x16_bf16(pa3, PK(l3, h3), od, 0, 0, 0);
#undef PK
}
__device__ __forceinline__ void pv_d0(f32x16* o, int vb, bf16x8 pa0, bf16x8 pa1, bf16x8 pa2, bf16x8 pa3) {
  pv_one<0>(o[0], vb, pa0, pa1, pa2, pa3); pv_one<1>(o[1], vb, pa0, pa1, pa2, pa3); pv_one<2>(o[2], vb, pa0, pa1, pa2, pa3); pv_one<3>(o[3], vb, pa0, pa1, pa2, pa3);
}

template <int LD>
__device__ __forceinline__ void attn_sub(const bf16* __restrict__ Qb, const bf16* __restrict__ Kh, const bf16* __restrict__ Vh, int NT, char* lds, f32x16 (&o)[4], float (&rli)[16]) {
  int tid_ = threadIdx.x; asm volatile("" : "+v"(tid_));
  const int tid = tid_, wid = tid >> 6, lane = tid & 63, r32 = lane & 31, hi = lane >> 5;
  char* V_lds = lds; char* K_lds = lds + 2 * SHM_V;
  float* ws = (float*)(lds + 2 * SHM_V + 2 * SHM_K) + wid * 64; float* li_l = ws; float* al_l = ws + 32;
  float m_reg = -1e30f, l_reg = 0; bf16x8 qr[4];
#pragma unroll
  for (int d = 0; d < 4; ++d) o[d] = f32x16{};
  const bf16* Qw = Qb + (long)(wid * QBLK + r32) * LD + hi * 8;
#pragma unroll
  for (int d0 = 0; d0 < 4; ++d0) qr[d0] = *reinterpret_cast<const bf16x8*>(Qw + d0 * 16);
  const int sr = tid >> 4, sc = (tid & 15) * 8, vst0 = v_st(sr, sc), vst1 = v_st(32 + sr, sc);
  const int kr = tid >> 3, kc = tid & 7, kst = KSWZ64(kr, kc);
  const int vb0 = (int)(uintptr_t)V_lds + v_rd_base(lane);
  struct { bf16x8 vs0, vs1, ks0; } sr_[2];
#define SLOAD(i, k0) do { sr_[i].vs0 = *reinterpret_cast<const bf16x8*>(&Vh[(long)((k0) + sr) * LD + sc]); sr_[i].vs1 = *reinterpret_cast<const bf16x8*>(&Vh[(long)((k0) + 32 + sr) * LD + sc]); \
    sr_[i].ks0 = *reinterpret_cast<const bf16x8*>(&Kh[(long)((k0) + kr) * LD + kc * 8]); } while (0)
#define SWRITE(b, i) do { *(bf16x8*)(V_lds + (b) * SHM_V + vst0) = sr_[i].vs0; *(bf16x8*)(V_lds + (b) * SHM_V + vst1) = sr_[i].vs1; \
    *(bf16x8*)(K_lds + (b) * SHM_K + kst) = sr_[i].ks0; } while (0)
#define SWAIT() asm volatile("s_waitcnt vmcnt(3)" ::: "memory")
#define RESC(a) do { if (__any((a) < 1.f)) { if (hi == 0) al_l[r32] = (a); asm volatile("s_waitcnt lgkmcnt(0)" ::: "memory"); \
    _Pragma("unroll") for (int d = 0; d < 4; ++d) _Pragma("unroll") for (int r = 0; r < 16; ++r) o[d][r] *= al_l[crow(r, hi)]; } } while (0)
  f32x16 pA0, pA1, pB0, pB1; float mnA, mnB, alA, alB; bf16x8 pa0, pa1, pa2, pa3;
  constexpr int SE = 0, SO = 1;
  SLOAD(SE, 0); asm volatile("s_waitcnt vmcnt(0)" ::: "memory"); SWRITE(0, SE); __syncthreads();
  qkt(pA0, pA1, K_lds, qr, r32, hi); partialSM(pA0, pA1, m_reg, mnA, alA);
  SLOAD(SO, KVBLK); if (2 < NT) SLOAD(SE, 2 * KVBLK);
  SWAIT(); SWRITE(1, SO); __syncthreads();
  for (int j = 1; j + 1 < NT; j += 2) {
    SBAR(); qkt(pB0, pB1, K_lds + SHM_K, qr, r32, hi);
    finishSM(pA0, pA1, alA, l_reg, pa0, pa1, pa2, pa3); SBAR();
    SLOAD(SO, (j + 2) * KVBLK); SBAR();
    pv_d0(o, vb0, pa0, pa1, pa2, pa3); partialSM(pB0, pB1, m_reg, mnB, alB);
    __syncthreads(); SWAIT(); SWRITE(0, SE);
    RESC(alB); __syncthreads();
    SBAR(); qkt(pA0, pA1, K_lds, qr, r32, hi);
    finishSM(pB0, pB1, alB, l_reg, pa0, pa1, pa2, pa3); SBAR();
    if (j + 3 < NT) SLOAD(SE, (j + 3) * KVBLK); SBAR();
    pv_d0(o, vb0 + SHM_V, pa0, pa1, pa2, pa3); partialSM(pA0, pA1, m_reg, mnA, alA);
    __syncthreads(); SWAIT(); SWRITE(1, SO);
    RESC(alA); __syncthreads();
  }
  SBAR(); qkt(pB0, pB1, K_lds + SHM_K, qr, r32, hi);
  finishSM(pA0, pA1, alA, l_reg, pa0, pa1, pa2, pa3); SBAR();
  pv_d0(o, vb0, pa0, pa1, pa2, pa3); partialSM(pB0, pB1, m_reg, mnB, alB);
  __syncthreads(); RESC(alB);
  finishSM(pB0, pB1, alB, l_reg, pa0, pa1, pa2, pa3); SBAR();
  pv_d0(o, vb0 + SHM_V, pa0, pa1, pa2, pa3);
  if (hi == 0) li_l[r32] = l_reg; asm volatile("s_waitcnt lgkmcnt(0)" ::: "memory");
#pragma unroll
  for (int r = 0; r < 16; ++r) rli[r] = __builtin_amdgcn_rcpf(li_l[crow(r, hi)]);
  __syncthreads();
#undef SLOAD
#undef SWRITE
#undef SWAIT
#undef RESC
}
#undef SBAR
}

constexpr int BATCH = 2, SEQ = 8192, DM = 2048, CTX = 256;
constexpr int UROWS_B = CTX + SEQ;
constexpr int UROWS = BATCH * UROWS_B;
constexpr int LROWS = BATCH * SEQ;
constexpr int IN_COLS = 7200, NPAD = 7424, LDP = 7168;
constexpr int DFF = 5632, NUP = 2 * DFF;
constexpr int NMOD = 6 * DM;
constexpr int PC_MQ = 0, PC_MK = 1024, PC_MV = 2048, PC_MO = 3072, PC_DQ = 4096, PC_DK = 5120, PC_DV = 6144;
constexpr float EPS = 1e-6f;
constexpr int KSL = 8;

constexpr size_t MiB = 1u << 20;
constexpr size_t WS_CTL = 0, CTL_ZERO_BYTES = 1 * MiB;
constexpr size_t WS_MODP = 1 * MiB;
constexpr size_t WS_GATES = 3 * MiB;
constexpr size_t WS_WUP = 6 * MiB;
constexpr size_t WS_WDN = 50 * MiB;
constexpr size_t WS_XN = 72 * MiB;
constexpr size_t WS_ARENA = 138 * MiB;
constexpr size_t WS_WIN = WS_ARENA;
constexpr size_t WS_WOUT = WS_ARENA + 29 * MiB;
constexpr size_t WS_P = WS_ARENA + 37 * MiB;
constexpr size_t WS_MIX = WS_ARENA + 268 * MiB;
constexpr size_t WS_ASCR = WS_ARENA + 332 * MiB;
constexpr size_t WS_Y = WS_P;
constexpr size_t WS_EDGE = WS_ARENA;
constexpr size_t WS_HMID = WS_ARENA + 176 * MiB;
constexpr size_t WS_Y2 = WS_ARENA;
constexpr size_t WS_END = WS_ARENA + 364 * MiB;
static_assert(WS_HMID + (size_t)LROWS * DFF * 2 <= WS_END && WS_ASCR + 32 * MiB <= WS_END && WS_MIX >= WS_P + (size_t)UROWS * LDP * 2, "ws map");

constexpr int RING_BYTES = 131072, LDS_BYTES = 147456;
constexpr int LDSCTL_OFF = RING_BYTES, MISC_OFF = LDSCTL_OFF + 320;
constexpr int CW_BAR = 4096;
constexpr int NWAVES = 8;

#define LAS __attribute__((address_space(3)))
typedef unsigned short bf16;
typedef unsigned v4u __attribute__((ext_vector_type(4)));
typedef unsigned v2u __attribute__((ext_vector_type(2)));
typedef float f32x4 __attribute__((ext_vector_type(4)));
typedef short bf16x8 __attribute__((ext_vector_type(8)));

__device__ __forceinline__ unsigned f2bf(float f) { unsigned u = __builtin_bit_cast(unsigned, f); return (u + 0x7fffu + ((u >> 16) & 1u)) >> 16; }
__device__ __forceinline__ unsigned pk2(float lo, float hi) { return f2bf(lo) | (f2bf(hi) << 16); }
__device__ __forceinline__ float bf2f(unsigned short b) { return __builtin_bit_cast(float, (unsigned)b << 16); }
__device__ __forceinline__ float bflo(unsigned w) { return __builtin_bit_cast(float, w << 16); }
__device__ __forceinline__ float bfhi(unsigned w) { return __builtin_bit_cast(float, w & 0xffff0000u); }
__device__ __forceinline__ float wave_sum(float v) {
#pragma unroll
    for (int o = 1; o < 64; o <<= 1) v += __shfl_xor(v, o);
    return v;
}
__device__ __forceinline__ float silu_f(float x) { return x * __builtin_amdgcn_rcpf(1.f + __expf(-x)); }
__device__ __forceinline__ float sigmoid_f(float x) { return __builtin_amdgcn_rcpf(1.f + __expf(-x)); }
__device__ __forceinline__ float logsigmoid_f(float x) { return fminf(x, 0.f) - log1pf(__expf(-fabsf(x))); }

struct Frame {
    unsigned char* lds;
    int tid, lane, wave, vcu, G;
    float* out; unsigned char* ws;
};
#define AS4 __attribute__((address_space(4)))
__device__ __forceinline__ const float* inptr(int k) {
    const AS4 char* kp = (const AS4 char*)__builtin_amdgcn_kernarg_segment_ptr();
    asm volatile("" : "+s"(kp));
    return *(const float* const AS4*)(kp + 8 * k);
}
enum { I_X = 0, I_C, I_CTX, I_CCTX, I_WMOD, I_BMOD, I_GPREMIX, I_GPOSTMIX, I_WIN, I_BGATE, I_CONVQKW, I_CONVQKB, I_GMLSTM, I_LQ1, I_LK1, I_LQ2, I_LK2, I_GDIFF, I_WOUT, I_GPREFFN, I_GPOSTFFN, I_WUP, I_CONVFFNW, I_CONVFFNB, I_WDOWN };

__device__ __forceinline__ void transpose_item(const float* W, int K, int N, bf16* WT, int dst_row0, int k0, int n0, float* scr, int lane) {
#pragma unroll 8
    for (int i = 0; i < 32; ++i) { const int kk = 2 * i + (lane >> 5); scr[kk * 33 + (lane & 31)] = W[(size_t)(k0 + kk) * N + n0 + (lane & 31)]; }
    asm volatile("s_waitcnt lgkmcnt(0)" ::: "memory");
    const int c = lane & 7;
#pragma unroll
    for (int j = 0; j < 4; ++j) { const int n = (lane >> 3) + 8 * j; const float* s = scr + (8 * c) * 33 + n;
        v4u o; o.x = pk2(s[0 * 33], s[1 * 33]); o.y = pk2(s[2 * 33], s[3 * 33]); o.z = pk2(s[4 * 33], s[5 * 33]); o.w = pk2(s[6 * 33], s[7 * 33]);
        *(v4u*)(WT + (size_t)(dst_row0 + n) * K + k0 + 8 * c) = o; }
    asm volatile("s_waitcnt lgkmcnt(0)" ::: "memory");
}
__device__ __forceinline__ int win_dst_row(int nb) { return nb < 128 ? 32 * nb : (nb == 128 ? 7168 : 4096 + 32 * (nb - 129)); }

constexpr int MOD_BLOCKS = 48;
__device__ __forceinline__ void p0_prologue(Frame& F) {
    const float* in_w_down = inptr(I_WDOWN); const float* in_c_ctx = inptr(I_CCTX); const float* in_w_mod = inptr(I_WMOD); const float* in_w_out = inptr(I_WOUT); const float* in_w_in = inptr(I_WIN); const float* in_w_up = inptr(I_WUP); const float* in_c = inptr(I_C);
    const int blk = blockIdx.x;
    if (blk < MOD_BLOCKS) {
        const int id = blk * 512 + F.tid;
        const int jq = id % 3072, ks = id / 3072;
        f32x4 a0 = {0, 0, 0, 0}, a1 = a0, a2 = a0;
        const float* wp = in_w_mod + (size_t)(ks * 256) * NMOD + 4 * jq;
#pragma unroll 8
        for (int k = 0; k < 256; ++k) {
            const f32x4 w = *(const f32x4*)(wp + (size_t)k * NMOD);
            const int kk = ks * 256 + k;
            const float s0 = silu_f(in_c[kk]), s1 = silu_f(in_c[DM + kk]), s2 = silu_f(in_c_ctx[kk]);
            a0 += w * s0; a1 += w * s1; a2 += w * s2;
        }
        float* mp = (float*)(F.ws + WS_MODP);
        *(f32x4*)(mp + (size_t)(ks * 3 + 0) * NMOD + 4 * jq) = a0;
        *(f32x4*)(mp + (size_t)(ks * 3 + 1) * NMOD + 4 * jq) = a1;
        *(f32x4*)(mp + (size_t)(ks * 3 + 2) * NMOD + 4 * jq) = a2;
        return;
    }
    float* scr = (float*)(F.lds) + F.wave * 2112;
    const int gw = (blk - MOD_BLOCKS) * NWAVES + F.wave, NGW = (F.G - MOD_BLOCKS) * NWAVES;
    constexpr int I_IN = (DM / 64) * (IN_COLS / 32), I_OUT = (DM / 64) * (DM / 32), I_UP = (DM / 64) * (NUP / 32), I_DN = (DFF / 64) * (DM / 32);
    bf16* win_t = (bf16*)(F.ws + WS_WIN); bf16* wout_t = (bf16*)(F.ws + WS_WOUT); bf16* wup_t = (bf16*)(F.ws + WS_WUP); bf16* wdn_t = (bf16*)(F.ws + WS_WDN);
    for (int it = gw; it < I_IN + I_OUT + I_UP + I_DN; it += NGW) {
        int r = it;
        if (r < I_IN) { const int nblk = IN_COLS / 32, kb = r / nblk, nb = r % nblk; transpose_item(in_w_in, DM, IN_COLS, win_t, win_dst_row(nb), 64 * kb, 32 * nb, scr, F.lane); continue; } r -= I_IN;
        if (r < I_OUT) { const int nblk = DM / 32, kb = r / nblk, nb = r % nblk; transpose_item(in_w_out, DM, DM, wout_t, 32 * nb, 64 * kb, 32 * nb, scr, F.lane); continue; } r -= I_OUT;
        if (r < I_UP) { const int nblk = NUP / 32, kb = r / nblk, nb = r % nblk; const int nbh = nb < DFF / 32 ? nb : nb - DFF / 32;
            transpose_item(in_w_up, DM, NUP, wup_t, 256 * (nbh >> 2) + (nb < DFF / 32 ? 0 : 128) + 32 * (nbh & 3), 64 * kb, 32 * nb, scr, F.lane); continue; } r -= I_UP;
        { const int nblk = DM / 32, kb = r / nblk, nb = r % nblk; transpose_item(in_w_down, DFF, DM, wdn_t, 32 * nb, 64 * kb, 32 * nb, scr, F.lane); }
    }
    { v4u* z = (v4u*)(win_t + (size_t)7200 * DM); const int n16 = 224 * DM * 2 / 16; const v4u zero = {0, 0, 0, 0};
      for (int i = (blk - MOD_BLOCKS) * 512 + F.tid; i < n16; i += (F.G - MOD_BLOCKS) * 512) z[i] = zero; }
}

__device__ __forceinline__ void load_mod(Frame& F, float* dst, int v, int col0, int n) {
    const float* in_b_mod = inptr(I_BMOD);
    const float* mp = (const float*)(F.ws + WS_MODP);
    for (int j = F.tid; j < n; j += 512) { float s = in_b_mod[col0 + j];
#pragma unroll
        for (int ks = 0; ks < KSL; ++ks) s += mp[(size_t)(ks * 3 + v) * NMOD + col0 + j];
        dst[j] = s; }
}

__device__ __forceinline__ void p1_xn(Frame& F) {
    const float* in_g_pre_mix = inptr(I_GPREMIX); const float* in_ctx = inptr(I_CTX); const float* in_x = inptr(I_X);
    float* modl = (float*)F.lds;
    for (int v = 0; v < 3; ++v) load_mod(F, modl + v * 4096, v, 0, 4096);
    __syncthreads();
    bf16* XN = (bf16*)(F.ws + WS_XN);
    const int gw = F.vcu * NWAVES + F.wave, NGW = F.G * NWAVES;
    for (int row = gw; row < UROWS; row += NGW) {
        const int b = row / UROWS_B, s = row % UROWS_B;
        const float* src = s < CTX ? in_ctx + ((size_t)b * CTX + s) * DM : in_x + ((size_t)b * SEQ + (s - CTX)) * DM;
        const float* mv = modl + (s < CTX ? 2 : b) * 4096;
        const f32x4* xr = (const f32x4*)src + F.lane;
        f32x4 v[8]; float ss = 0.f;
#pragma unroll
        for (int j = 0; j < 8; ++j) { v[j] = xr[64 * j]; ss += (v[j].x * v[j].x + v[j].y * v[j].y) + (v[j].z * v[j].z + v[j].w * v[j].w); }
        const float rstd = rsqrtf(wave_sum(ss) * (1.f / DM) + EPS);
        v2u* o8 = (v2u*)(XN + (size_t)row * DM) + F.lane;
#pragma unroll
        for (int j = 0; j < 8; ++j) { const int c0 = 4 * (64 * j + F.lane);
            const f32x4 g = *(const f32x4*)(in_g_pre_mix + c0), sh = *(const f32x4*)(mv + c0), sc = *(const f32x4*)(mv + 2048 + c0);
            const f32x4 y = (v[j] * rstd * g) * (sc + 1.f) + sh;
            v2u w; w.x = pk2(y.x, y.y); w.y = pk2(y.z, y.w); o8[64 * j] = w; }
    }
}

__device__ __forceinline__ void p3_rope(Frame& F) {
    float* ct = (float*)F.lds; float* st = ct + 2048;
    for (int i = F.tid; i < 2048; i += 512) { const int pos = i >> 4, f = i & 15; const float inv = powf(10000.f, -(float)f / 16.f); const float ang = (float)pos * inv; ct[i] = cosf(ang); st[i] = sinf(ang); }
    __syncthreads();
    bf16* P = (bf16*)(F.ws + WS_P);
    const int gw = F.vcu * NWAVES + F.wave, NGW = F.G * NWAVES;
    for (int lr = gw; lr < LROWS; lr += NGW) {
        const int b = lr / SEQ, t = lr % SEQ;
        const int pos = (F.lane & 1) ? (t & 63) : (t >> 6);
        bf16* p = P + (size_t)(b * UROWS_B + CTX + t) * LDP + PC_DQ + 32 * F.lane;
        v4u w[4];
#pragma unroll
        for (int i = 0; i < 4; ++i) w[i] = *(const v4u*)(p + 8 * i);
        v4u o[4];
#pragma unroll
        for (int q = 0; q < 2; ++q)
#pragma unroll
            for (int e = 0; e < 4; ++e) { const int f = 8 * q + 2 * e; const unsigned a = w[q][e], bb = w[2 + q][e];
                const float c0 = ct[pos * 16 + f], s0 = st[pos * 16 + f], c1 = ct[pos * 16 + f + 1], s1 = st[pos * 16 + f + 1];
                const float x0l = bflo(a), x0h = bfhi(a), x1l = bflo(bb), x1h = bfhi(bb);
                o[q][e] = pk2(x0l * c0 - x1l * s0, x0h * c1 - x1h * s1);
                o[2 + q][e] = pk2(x1l * c0 + x0l * s0, x1h * c1 + x0h * s1); }
#pragma unroll
        for (int i = 0; i < 4; ++i) *(v4u*)(p + 8 * i) = o[i];
    }
}

__device__ __forceinline__ void p5_attn(Frame& F) {
    const float* in_g_diff = inptr(I_GDIFF); const float* in_lq1 = inptr(I_LQ1); const float* in_lk1 = inptr(I_LK1); const float* in_lq2 = inptr(I_LQ2); const float* in_lk2 = inptr(I_LK2);
    using namespace attn;
    float lam;
    { float s1 = 0.f, s2 = 0.f; for (int i = 0; i < 64; ++i) { s1 += in_lq1[i] * in_lk1[i]; s2 += in_lq2[i] * in_lk2[i]; } lam = expf(s1) - expf(s2) + 0.2f; }
    const attn::bf16* P = (const attn::bf16*)(F.ws + WS_P); ::bf16* MIX = (::bf16*)(F.ws + WS_MIX);
    float* scr0 = (float*)(F.ws + WS_XN);
    const int tid = F.tid, wid = tid >> 6, lane = tid & 63, r32 = lane & 31, hi = lane >> 5;
#pragma unroll 1
    for (int u = F.vcu; u < BATCH * 8 * (SEQ / 256); u += F.G) {
        const int qb = u % (SEQ / 256), bh = u / (SEQ / 256), b = bh >> 3, h = bh & 7;
        const attn::bf16* Pb = P + (size_t)(b * UROWS_B) * LDP;
#pragma unroll 1
        for (int c = 0; c < 2; ++c) {
            f32x16 o[4]; float rli[16];
            attn_sub<LDP>(Pb + (size_t)(CTX + qb * 256) * LDP + PC_DQ + h * 128 + c * 64, Pb + PC_DK + h * 128 + c * 64, Pb + PC_DV + h * 128, UROWS_B / 64, (char*)F.lds, o, rli);
            for (int d0 = 0; d0 < 4; ++d0) for (int r = 0; r < 16; ++r) scr0[(d0 * 16 + r) * 512 + tid + blockIdx.x * 65536 + c * 32768] = o[d0][r] * rli[r];
        }
        const float* s1p = scr0 + (size_t)blockIdx.x * 65536 + tid; const float* s2p = s1p + 32768;
        ::bf16* mo = MIX + (size_t)(b * SEQ + qb * 256 + wid * 32) * DM + 1024 + h * 128 + r32;
        const float g0 = in_g_diff[r32] * 0.8f, g1 = in_g_diff[32 + r32] * 0.8f, g2 = in_g_diff[64 + r32] * 0.8f, g3 = in_g_diff[96 + r32] * 0.8f;
#pragma unroll 2
        for (int r = 0; r < 16; ++r) {
            const float v0 = s1p[(0 * 16 + r) * 512] - lam * s2p[(0 * 16 + r) * 512], v1 = s1p[(1 * 16 + r) * 512] - lam * s2p[(1 * 16 + r) * 512],
                        v2 = s1p[(2 * 16 + r) * 512] - lam * s2p[(2 * 16 + r) * 512], v3 = s1p[(3 * 16 + r) * 512] - lam * s2p[(3 * 16 + r) * 512];
            float ss = (v0 * v0 + v1 * v1) + (v2 * v2 + v3 * v3);
#pragma unroll
            for (int off = 1; off < 32; off <<= 1) ss += __shfl_xor(ss, off);
            const float rs = rsqrtf(ss * (1.f / 128.f) + EPS);
            ::bf16* mr = mo + (size_t)((r & 3) + 8 * (r >> 2) + 4 * hi) * DM;
            mr[0] = (::bf16)f2bf(v0 * rs * g0); mr[32] = (::bf16)f2bf(v1 * rs * g1); mr[64] = (::bf16)f2bf(v2 * rs * g2); mr[96] = (::bf16)f2bf(v3 * rs * g3);
        }
    }
}

__device__ __forceinline__ void p7_x1(Frame& F) {
    const float* in_g_post_mix = inptr(I_GPOSTMIX); const float* in_g_pre_ffn = inptr(I_GPREFFN); const float* in_x = inptr(I_X);
    float* modl = (float*)F.lds;
    for (int b = 0; b < 2; ++b) { load_mod(F, modl + (b * 3 + 0) * 2048, b, 2 * DM, 2048); load_mod(F, modl + (b * 3 + 1) * 2048, b, 3 * DM, 2048); load_mod(F, modl + (b * 3 + 2) * 2048, b, 4 * DM, 2048); }
    __syncthreads();
    const bf16* Y = (const bf16*)(F.ws + WS_Y); bf16* XN2 = (bf16*)(F.ws + WS_XN);
    const int gw = F.vcu * NWAVES + F.wave, NGW = F.G * NWAVES;
    for (int row = gw; row < LROWS; row += NGW) {
        const int b = row / SEQ; const float* mv = modl + b * 3 * 2048;
        const v2u* yr = (const v2u*)(Y + (size_t)row * DM) + F.lane; const f32x4* xr = (const f32x4*)(in_x + (size_t)row * DM) + F.lane;
        f32x4 v[8]; float ss = 0.f;
#pragma unroll
        for (int j = 0; j < 8; ++j) { const v2u yw = yr[64 * j]; v[j] = (f32x4){bflo(yw.x), bfhi(yw.x), bflo(yw.y), bfhi(yw.y)}; ss += (v[j].x * v[j].x + v[j].y * v[j].y) + (v[j].z * v[j].z + v[j].w * v[j].w); }
        const float rstd = rsqrtf(wave_sum(ss) * (1.f / DM) + EPS);
        float s2 = 0.f; f32x4* orow = (f32x4*)(F.out + (size_t)row * DM) + F.lane;
#pragma unroll
        for (int j = 0; j < 8; ++j) { const int c0 = 4 * (64 * j + F.lane);
            const f32x4 g = *(const f32x4*)(in_g_post_mix + c0), ga = *(const f32x4*)(mv + c0);
            v[j] = xr[64 * j] + ga * (v[j] * rstd * g); orow[64 * j] = v[j];
            s2 += (v[j].x * v[j].x + v[j].y * v[j].y) + (v[j].z * v[j].z + v[j].w * v[j].w); }
        const float rstd2 = rsqrtf(wave_sum(s2) * (1.f / DM) + EPS);
        v2u* o8 = (v2u*)(XN2 + (size_t)row * DM) + F.lane;
#pragma unroll
        for (int j = 0; j < 8; ++j) { const int c0 = 4 * (64 * j + F.lane);
            const f32x4 g = *(const f32x4*)(in_g_pre_ffn + c0), sh = *(const f32x4*)(mv + 2048 + c0), sc = *(const f32x4*)(mv + 4096 + c0);
            const f32x4 y = (v[j] * rstd2 * g) * (sc + 1.f) + sh;
            v2u w; w.x = pk2(y.x, y.y); w.y = pk2(y.z, y.w); o8[64 * j] = w; }
    }
}

__device__ __forceinline__ void ffn_edge_fix(Frame& F) {
    const float* cw = inptr(I_CONVFFNW);
    const float* edge = (const float*)(F.ws + WS_EDGE); bf16* HM = (bf16*)(F.ws + WS_HMID);
    constexpr int NB = LROWS / 256 - BATCH;
    for (int it = blockIdx.x * 512 + F.tid; it < NB * DFF; it += F.G * 512) {
        const int bi = it / DFF, j = it % DFF, pm = bi + 1 + bi / (SEQ / 256 - 1);
        const int pn = j >> 7, c = j & 127;
        const float* eA = edge + (size_t)((pm - 1) * (NUP / 256) + pn) * 1024 + 512; const float* eB = edge + (size_t)(pm * (NUP / 256) + pn) * 1024;
        const float w0g = cw[j], w0v = cw[DFF + j], w2g = cw[2 * NUP + j], w2v = cw[2 * NUP + DFF + j];
        const float ag = eA[c] + w2g * eB[256 + c], av = eA[128 + c] + w2v * eB[384 + c];
        const float bg = eB[c] + w0g * eA[256 + c], bv = eB[128 + c] + w0v * eA[384 + c];
        HM[(size_t)(256 * pm - 1) * DFF + j] = (bf16)f2bf(silu_f(ag) * av);
        HM[(size_t)(256 * pm) * DFF + j] = (bf16)f2bf(silu_f(bg) * bv);
    }
}

__device__ __forceinline__ void p13_final(Frame& F) {
    const float* in_g_post_ffn = inptr(I_GPOSTFFN);
    float* modl = (float*)F.lds;
    for (int b = 0; b < 2; ++b) load_mod(F, modl + b * 2048, b, 5 * DM, 2048);
    __syncthreads();
    const bf16* Y2 = (const bf16*)(F.ws + WS_Y2);
    const int gw = F.vcu * NWAVES + F.wave, NGW = F.G * NWAVES;
    for (int row = gw; row < LROWS; row += NGW) {
        const int b = row / SEQ; const float* mv = modl + b * 2048;
        const v2u* yr = (const v2u*)(Y2 + (size_t)row * DM) + F.lane; f32x4* orow = (f32x4*)(F.out + (size_t)row * DM) + F.lane;
        f32x4 v[8]; float ss = 0.f;
#pragma unroll
        for (int j = 0; j < 8; ++j) { const v2u yw = yr[64 * j]; v[j] = (f32x4){bflo(yw.x), bfhi(yw.x), bflo(yw.y), bfhi(yw.y)}; ss += (v[j].x * v[j].x + v[j].y * v[j].y) + (v[j].z * v[j].z + v[j].w * v[j].w); }
        const float rstd = rsqrtf(wave_sum(ss) * (1.f / DM) + EPS);
#pragma unroll
        for (int j = 0; j < 8; ++j) { const int c0 = 4 * (64 * j + F.lane);
            const f32x4 g = *(const f32x4*)(in_g_post_ffn + c0), ga = *(const f32x4*)(mv + c0);
            orow[64 * j] = orow[64 * j] + ga * (v[j] * rstd * g); }
    }
}


namespace ml {
using bf16x8 = __attribute__((ext_vector_type(8))) short;
using s16x4  = __attribute__((ext_vector_type(4))) short;
using f32x16 = __attribute__((ext_vector_type(16))) float;
using u32x4  = __attribute__((ext_vector_type(4))) unsigned;
typedef short v4i16_t __attribute__((ext_vector_type(4)));
#define MFMA32(a, b, c) __builtin_amdgcn_mfma_f32_32x32x16_bf16((a), (b), (c), 0, 0, 0)
__device__ __forceinline__ int crow(int r, int hi) { return (r & 3) + 8 * (r >> 2) + 4 * hi; }
__device__ __forceinline__ unsigned off_a(unsigned row, unsigned ch) { return 2048u * (row >> 3) + 512u * (ch >> 2) + 64u * (row & 7) + 16u * ((ch & 3) ^ ((row >> 2) & 3)); }
struct RdBase { unsigned r[2], t[2], p[2]; };
__device__ __forceinline__ RdBase rd_bases(unsigned lane) {
    const unsigned l31 = lane & 31, h = lane >> 5, y = (l31 >> 2) & 3, blk = (lane >> 4) & 1, q = (lane & 15) >> 2, p = lane & 3, cz = 2 * blk + (p >> 1);
    RdBase B;
    B.r[0] = 2048u * (l31 >> 3) + 64u * (l31 & 7) + 16u * ((0u | h) ^ y);
    B.r[1] = 2048u * (l31 >> 3) + 64u * (l31 & 7) + 16u * ((2u | h) ^ y);
    B.t[0] = 2048u * h + 64u * q + 8u * (p & 1) + 16u * (cz ^ (2 * h + 0));
    B.t[1] = 2048u * h + 64u * q + 8u * (p & 1) + 16u * (cz ^ (2 * h + 1));
    B.p[0] = 64u * (4 * h + q) + 8u * (p & 1) + 16u * (cz ^ (0 + h));
    B.p[1] = 64u * (4 * h + q) + 8u * (p & 1) + 16u * (cz ^ (2 + h));
    return B; }
#define ROW_OFF(rb, s) (8192u * (rb) + 512u * ((s) >> 1))
#define TR_OFF(c, ks, t) (4096u * (ks) + 512u * (c) + 256u * (t))
#define TRP_OFF(c, ks, t) (4096u * (ks) + 2048u * (t) + 512u * (c))
__device__ __forceinline__ bf16x8 ld_row(const LAS unsigned char* tile, unsigned a) { return *(const LAS bf16x8*)(tile + a); }
__device__ __forceinline__ bf16x8 ld_tr2(const LAS unsigned char* tile, unsigned a0, unsigned a1) {
    const s16x4 lo = __builtin_bit_cast(s16x4, __builtin_amdgcn_ds_read_tr16_b64_v4i16((LAS v4i16_t*)(tile + a0)));
    const s16x4 hi = __builtin_bit_cast(s16x4, __builtin_amdgcn_ds_read_tr16_b64_v4i16((LAS v4i16_t*)(tile + a1)));
    return (bf16x8){lo[0], lo[1], lo[2], lo[3], hi[0], hi[1], hi[2], hi[3]}; }
__device__ __forceinline__ unsigned cvtpk(float lo, float hi) { typedef float f2 __attribute__((ext_vector_type(2))); typedef __bf16 b2 __attribute__((ext_vector_type(2)));
    f2 v = {lo, hi}; b2 b = __builtin_convertvector(v, b2); return __builtin_bit_cast(unsigned, b); }

constexpr int SC_OFF = 132096;
constexpr int NCH = 66;
__device__ __forceinline__ int chunk_row0(int b, int jj) { return b * UROWS_B + (jj < 2 ? 128 * jj : CTX + 128 * (jj - 2)); }
constexpr size_t WS_CDC = WS_ASCR;
constexpr size_t WS_SCAL = WS_ASCR + 4 * MiB;
constexpr size_t WS_MST = WS_SCAL + 32 * 1024;
constexpr size_t WS_DN = WS_MST + 16 * 1024;

__device__ __forceinline__ void gate_scalars(const float* GT, const float* bgate, int b, int h, int dir, int jj, int lane, LAS float* gs, LAS float* bs, float& G, float& bL) {
    const int r0 = chunk_row0(b, jj);
    const float bi = bgate[(dir * 2) * 8 + h], bf = bgate[(dir * 2 + 1) * 8 + h];
    const float* g0 = GT + (size_t)(r0 + 2 * lane) * 32; const float* g1 = g0 + 32;
    const float i0 = g0[(dir * 2) * 8 + h] + bi, i1 = g1[(dir * 2) * 8 + h] + bi;
    const float f0 = logsigmoid_f(g0[(dir * 2 + 1) * 8 + h] + bf), f1 = logsigmoid_f(g1[(dir * 2 + 1) * 8 + h] + bf);
    float ps = f0 + f1;
#pragma unroll
    for (int o = 1; o < 64; o <<= 1) { const float y = __shfl_up(ps, o); if (lane >= o) ps += y; }
    const float tot = __shfl(ps, 63);
    float b0, b1;
    if (dir == 0) { b1 = ps; b0 = ps - f1; }
    else { const float excl = ps - (f0 + f1); b0 = tot - excl; b1 = b0 - f0; }
    const float ga = i0 - b0, gb = i1 - b1;
    float mx = fmaxf(ga, gb);
#pragma unroll
    for (int o = 1; o < 64; o <<= 1) mx = fmaxf(mx, __shfl_xor(mx, o));
    gs[2 * lane] = ga; gs[2 * lane + 1] = gb; bs[2 * lane] = b0; bs[2 * lane + 1] = b1;
    G = mx; bL = tot;
}

template <int MODE>
__device__ __forceinline__ void stage_tile(const bf16* P, int r0, int col0, LAS unsigned char* tile, int tid, const LAS float* rw, const float* cw, const float* cb, int cwoff, float scale, int seg0, int seg1) {
#pragma unroll 2
    for (int i = 0; i < 4; ++i) {
        const int id = tid + 512 * i, row = id >> 4, ch = id & 15; const int r = r0 + row;
        const bf16* p = P + (size_t)r * LDP + col0 + 8 * ch;
        const v4u x0 = *(const v4u*)p;
        float y[8];
        if (MODE == 0) { const float w = rw ? rw[row] : 1.f;
#pragma unroll
            for (int e = 0; e < 4; ++e) { y[2 * e] = bflo(x0[e]) * w; y[2 * e + 1] = bfhi(x0[e]) * w; }
        } else {
            v4u xm = {0, 0, 0, 0}, xp = {0, 0, 0, 0};
            if (r - 1 >= seg0) xm = *(const v4u*)(p - LDP);
            if (r + 1 < seg1) xp = *(const v4u*)(p + LDP);
            const float* w0 = cw + cwoff + 8 * ch; const float* bb = cb + cwoff + 8 * ch;
#pragma unroll
            for (int e = 0; e < 4; ++e) {
                const float a0 = w0[2 * e] * bflo(xm[e]) + w0[2048 + 2 * e] * bflo(x0[e]) + w0[4096 + 2 * e] * bflo(xp[e]) + bb[2 * e];
                const float a1 = w0[2 * e + 1] * bfhi(xm[e]) + w0[2048 + 2 * e + 1] * bfhi(x0[e]) + w0[4096 + 2 * e + 1] * bfhi(xp[e]) + bb[2 * e + 1];
                y[2 * e] = silu_f(a0) * scale; y[2 * e + 1] = silu_f(a1) * scale; }
        }
        v4u o; o.x = cvtpk(y[0], y[1]); o.y = cvtpk(y[2], y[3]); o.z = cvtpk(y[4], y[5]); o.w = cvtpk(y[6], y[7]);
        *(LAS v4u*)(tile + off_a(row, ch)) = o;
    }
}

__device__ __forceinline__ void stage1(Frame& F) {
    const float* in_b_gate = inptr(I_BGATE); const float* in_cw = inptr(I_CONVQKW); const float* in_cb = inptr(I_CONVQKB);
    const bf16* P = (const bf16*)(F.ws + WS_P); const float* GT = (const float*)(F.ws + WS_GATES);
    LAS unsigned char* L = (LAS unsigned char*)F.lds;
    LAS unsigned char* Kt = L; LAS unsigned char* Vf = L + 32768; LAS unsigned char* Vb = L + 65536;
    LAS float* sc = (LAS float*)(L + 98304);
    int tid_ = threadIdx.x; asm volatile("" : "+v"(tid_)); const int tid = tid_, lane = tid & 63, wid = __builtin_amdgcn_readfirstlane(tid >> 6);
    const RdBase RB = rd_bases(lane);
#pragma unroll 1
    for (int u = blockIdx.x; u < 16 * NCH; u += F.G) {
        const int bh = u / NCH, jj = u % NCH, b = bh >> 3, h = bh & 7, r0 = chunk_row0(b, jj);
        const int seg0 = b * UROWS_B + (jj < 2 ? 0 : CTX), seg1 = b * UROWS_B + (jj < 2 ? CTX : UROWS_B);
        __syncthreads();
        if (wid < 2) { float G, bL; gate_scalars(GT, in_b_gate, b, h, wid, jj, lane, sc + wid * 256, sc + wid * 256 + 128, G, bL);
            sc[512 + wid * 128 + 2 * lane] = __expf(sc[wid * 256 + 2 * lane] - G); sc[512 + wid * 128 + 2 * lane + 1] = __expf(sc[wid * 256 + 2 * lane + 1] - G);
            if (lane == 0) { float* s = (float*)(F.ws + WS_SCAL) + ((size_t)(bh * 2 + wid) * NCH + jj) * 2; s[0] = G; s[1] = bL; } }
        stage_tile<1>(P, r0, PC_MK + h * 128, Kt, tid, nullptr, in_cw, in_cb, 1024 + h * 128, 0.08838834764831845f, seg0, seg1);
        __syncthreads();
        stage_tile<0>(P, r0, PC_MV + h * 128, Vf, tid, sc + 512, nullptr, nullptr, 0, 1.f, 0, 0);
        stage_tile<0>(P, r0, PC_MV + h * 128, Vb, tid, sc + 640, nullptr, nullptr, 0, 1.f, 0, 0);
        __syncthreads();
        const int dir = wid >> 2, db = wid & 3; const LAS unsigned char* Vw = dir ? Vb : Vf;
        f32x16 acc[4];
#pragma unroll
        for (int c = 0; c < 4; ++c) acc[c] = f32x16{};
        const LAS unsigned char* Kd = Kt + 512 * db;
#pragma unroll
        for (int ks = 0; ks < 8; ++ks) {
            const bf16x8 a = ld_tr2(Kd, RB.t[0] + TR_OFF(0, ks, 0), RB.t[1] + TR_OFF(0, ks, 1));
#pragma unroll
            for (int c = 0; c < 4; ++c) { const bf16x8 bv = ld_tr2(Vw, RB.t[0] + TR_OFF(c, ks, 0), RB.t[1] + TR_OFF(c, ks, 1)); acc[c] = MFMA32(a, bv, acc[c]); }
        }
        if ((tid & 255) < 128) { const int d = tid & 127, dr = tid >> 8; const LAS float* w = sc + 512 + dr * 128; float s = 0.f;
#pragma unroll 8
            for (int r = 0; r < 128; ++r) s += w[r] * bf2f(*(const LAS unsigned short*)(Kt + off_a(r, d >> 3) + (d & 7) * 2));
            ((float*)(F.ws + WS_DN))[((size_t)(bh * 2 + dr) * NCH + jj) * 128 + d] = s; }
        float* dst = (jj < 2 ? (float*)(F.ws + WS_CDC) + ((size_t)(bh * 2 + dir) * 2 + jj) * 16384 : F.out + ((size_t)(bh * 2 + dir) * 64 + (jj - 2)) * 16384) + (32 * db) * 128 + (lane & 31);
        const int hi = lane >> 5;
#pragma unroll
        for (int c = 0; c < 4; ++c)
#pragma unroll
            for (int r = 0; r < 16; ++r) dst[crow(r, hi) * 128 + 32 * c] = acc[c][r];
    }
}

__device__ __forceinline__ void stage2(Frame& F) {
    const int g = blockIdx.x * 512 + F.tid;
    if (g >= 32 * 4096) return;
    const int chain = g >> 12, e4 = g & 4095, dir = chain & 1;
    const float* scal = (const float*)(F.ws + WS_SCAL) + (size_t)chain * NCH * 2;
    f32x4* lat = (f32x4*)(F.out + (size_t)chain * 64 * 16384) + e4; const f32x4* cdc = (const f32x4*)((const float*)(F.ws + WS_CDC) + (size_t)chain * 2 * 16384) + e4;
    f32x4* dn = (f32x4*)((float*)(F.ws + WS_DN) + (size_t)chain * NCH * 128) + e4;
    float* mst = (float*)(F.ws + WS_MST) + (size_t)chain * NCH;
    f32x4 C = {0.f, 0.f, 0.f, 0.f}, n = {0.f, 0.f, 0.f, 0.f}; float m = 0.f;
#pragma unroll
    for (int c = 0; c < 2; ++c) { const int jj = dir ? 1 - c : c; const float G = scal[2 * jj], bL = scal[2 * jj + 1];
        const float M = fmaxf(m, G), dec = __expf(m - M), sca = __expf(G - M);
        if (e4 == 0) mst[jj] = m;
        C = C * dec + cdc[(size_t)jj * 4096] * sca;
        if (e4 < 32) { const f32x4 d = dn[jj * 32]; dn[jj * 32] = n; n = n * dec + d * sca; }
        m = bL + M; }
#pragma unroll 1
    for (int c0 = 0; c0 < 64; c0 += 8) {
        f32x4 d[8];
#pragma unroll
        for (int i = 0; i < 8; ++i) { const int j = dir ? 63 - (c0 + i) : c0 + i; d[i] = lat[(size_t)j * 4096]; }
#pragma unroll
        for (int i = 0; i < 8; ++i) { const int j = dir ? 63 - (c0 + i) : c0 + i, jj = j + 2; const float G = scal[2 * jj], bL = scal[2 * jj + 1];
            const float M = fmaxf(m, G), dec = __expf(m - M), sca = __expf(G - M);
            if (e4 == 0) mst[jj] = m;
            lat[(size_t)j * 4096] = C; C = C * dec + d[i] * sca;
            if (e4 < 32) { const f32x4 dd = dn[jj * 32]; dn[jj * 32] = n; n = n * dec + dd * sca; }
            m = bL + M; }
    }
}

__device__ __forceinline__ void stage3(Frame& F) {
    const float* in_b_gate = inptr(I_BGATE); const float* in_cw = inptr(I_CONVQKW); const float* in_cb = inptr(I_CONVQKB); const float* in_gm = inptr(I_GMLSTM);
    const bf16* P = (const bf16*)(F.ws + WS_P); const float* GT = (const float*)(F.ws + WS_GATES); bf16* MIX = (bf16*)(F.ws + WS_MIX);
    LAS unsigned char* L = (LAS unsigned char*)F.lds;
    LAS unsigned char* Qt = L; LAS unsigned char* Kt = L + 32768; LAS unsigned char* Vt = L + 65536; LAS unsigned char* Ct = L + 98304;
    LAS float* sc = (LAS float*)(L + SC_OFF);
    int tid_ = threadIdx.x; asm volatile("" : "+v"(tid_)); const int tid = tid_, lane = tid & 63, wid = __builtin_amdgcn_readfirstlane(tid >> 6);
    const int tb = wid >> 1, eh = wid & 1, hi = lane >> 5, tl = lane & 31;
    const RdBase RB = rd_bases(lane);
#pragma unroll 1
    for (int u = blockIdx.x; u < 16 * 64; u += F.G) {
        const int bh = u >> 6, j = u & 63, jj = j + 2, b = bh >> 3, h = bh & 7, r0 = chunk_row0(b, jj);
        const int seg0 = b * UROWS_B + CTX, seg1 = (b + 1) * UROWS_B;
        __syncthreads();
        int tu = tid; asm volatile("" : "+v"(tu));
        const int crw = tu >> 4, cch = tu & 15;
        const int e4 = tu & 31, dq = tu >> 5;
        f32x4 cf[8], cbk[8]; v4u xq[4], xk[4], xv[4], xh = {0, 0, 0, 0};
        { const float* Cf = F.out + ((size_t)(bh * 2 + 0) * 64 + j) * 16384 + (size_t)(8 * dq) * 128 + 4 * e4; const float* Cb = Cf + (size_t)64 * 16384;
#pragma unroll
          for (int q = 0; q < 8; ++q) { cf[q] = *(const f32x4*)(Cf + q * 128); cbk[q] = *(const f32x4*)(Cb + q * 128); }
          const bf16* pr = P + (size_t)(r0 + crw) * LDP + h * 128 + 8 * cch;
#pragma unroll
          for (int i = 0; i < 4; ++i) { xq[i] = *(const v4u*)(pr + (size_t)(32 * i) * LDP + PC_MQ); xk[i] = *(const v4u*)(pr + (size_t)(32 * i) * LDP + PC_MK); xv[i] = *(const v4u*)(pr + (size_t)(32 * i) * LDP + PC_MV); }
          if (tu < 64) { const int tq = tu >> 5, wh = (tu >> 4) & 1; const int rr = wh ? r0 + 128 : r0 - 1;
              if (rr >= seg0 && rr < seg1) xh = *(const v4u*)(P + (size_t)rr * LDP + (tq ? PC_MK : PC_MQ) + h * 128 + 8 * cch); } }
        if (wid < 2) { float G, bL; gate_scalars(GT, in_b_gate, b, h, wid, jj, lane, sc + wid * 256, sc + wid * 256 + 128, G, bL);
            const float m0 = ((const float*)(F.ws + WS_MST))[(size_t)(bh * 2 + wid) * NCH + jj]; const float ML = fmaxf(m0, G);
#pragma unroll
            for (int q = 0; q < 2; ++q) { const int t = 2 * lane + q; sc[512 + wid * 128 + t] = __expf(sc[wid * 256 + t] - ML); sc[768 + wid * 128 + t] = __expf(-sc[wid * 256 + 128 + t] - ML); }
            if (lane == 0) sc[1920 + wid] = __expf(m0 - ML);
        } else if (wid < 4) { const int dr = wid - 2; const float* nv = (const float*)(F.ws + WS_DN) + ((size_t)(bh * 2 + dr) * NCH + jj) * 128; const int ln = tu & 63; sc[1024 + dr * 128 + ln] = nv[ln]; sc[1024 + dr * 128 + 64 + ln] = nv[64 + ln]; }
        LAS v4u* halo = (LAS v4u*)(L + SC_OFF + 12288);
#pragma unroll
        for (int i = 0; i < 4; ++i) { const unsigned o = off_a(crw + 32 * i, cch); *(LAS v4u*)(Qt + o) = xq[i]; *(LAS v4u*)(Kt + o) = xk[i]; *(LAS v4u*)(Vt + o) = xv[i]; }
        if (tu < 64) halo[tu] = xh;
        v4u cbp[4];
#pragma unroll
        for (int e = 0; e < 4; ++e) { v4u o; o.x = cvtpk(cf[0][e], cf[1][e]); o.y = cvtpk(cf[2][e], cf[3][e]); o.z = cvtpk(cf[4][e], cf[5][e]); o.w = cvtpk(cf[6][e], cf[7][e]);
            *(LAS v4u*)(Ct + off_a(4 * e4 + e, dq)) = o;
            cbp[e].x = cvtpk(cbk[0][e], cbk[1][e]); cbp[e].y = cvtpk(cbk[2][e], cbk[3][e]); cbp[e].z = cvtpk(cbk[4][e], cbk[5][e]); cbp[e].w = cvtpk(cbk[6][e], cbk[7][e]); }
        __syncthreads();
        v4u qm[4], qp_[4], km[4], kp[4];
#pragma unroll
        for (int i = 0; i < 4; ++i) { const int row = crw + 32 * i;
            if (row > 0) { const unsigned o = off_a(row - 1, cch); qm[i] = *(const LAS v4u*)(Qt + o); km[i] = *(const LAS v4u*)(Kt + o); } else { qm[i] = halo[cch]; km[i] = halo[32 + cch]; }
            if (row < 127) { const unsigned o = off_a(row + 1, cch); qp_[i] = *(const LAS v4u*)(Qt + o); kp[i] = *(const LAS v4u*)(Kt + o); } else { qp_[i] = halo[16 + cch]; kp[i] = halo[48 + cch]; } }
        __syncthreads();
#pragma unroll
        for (int tq = 0; tq < 2; ++tq) {
            f32x4 wt[8];
            { const float* w0 = in_cw + tq * 1024 + h * 128 + 8 * cch; const float* b0 = in_cb + tq * 1024 + h * 128 + 8 * cch;
#pragma unroll
              for (int tp = 0; tp < 3; ++tp) { wt[2 * tp] = *(const f32x4*)(w0 + 2048 * tp); wt[2 * tp + 1] = *(const f32x4*)(w0 + 2048 * tp + 4); }
              wt[6] = *(const f32x4*)(b0); wt[7] = *(const f32x4*)(b0 + 4); }
            const float osc = tq ? 0.08838834764831845f : 1.f;
#pragma unroll
            for (int i = 0; i < 4; ++i) { const unsigned o = off_a(crw + 32 * i, cch); v4u ov;
                const v4u vm = tq ? km[i] : qm[i], v0 = tq ? xk[i] : xq[i], vp = tq ? kp[i] : qp_[i];
#pragma unroll
                for (int e = 0; e < 4; ++e) {
                    const float a0 = wt[e >> 1][2 * (e & 1)] * bflo(vm[e]) + wt[2 + (e >> 1)][2 * (e & 1)] * bflo(v0[e]) + wt[4 + (e >> 1)][2 * (e & 1)] * bflo(vp[e]) + wt[6 + (e >> 1)][2 * (e & 1)];
                    const float a1 = wt[e >> 1][2 * (e & 1) + 1] * bfhi(vm[e]) + wt[2 + (e >> 1)][2 * (e & 1) + 1] * bfhi(v0[e]) + wt[4 + (e >> 1)][2 * (e & 1) + 1] * bfhi(vp[e]) + wt[6 + (e >> 1)][2 * (e & 1) + 1];
                    ov[e] = cvtpk(silu_f(a0) * osc, silu_f(a1) * osc); }
                *(LAS v4u*)((tq ? Kt : Qt) + o) = ov; }
        }
        __syncthreads();
        { const int t = tu & 127, part = tu >> 7; float s0 = 0.f, s1 = 0.f;
#pragma unroll
            for (int c4 = 0; c4 < 4; ++c4) { const v4u qv = *(const LAS v4u*)(Qt + off_a(t, 4 * part + c4)); const LAS float* n0 = sc + 1024 + 32 * part + 8 * c4; const LAS float* n1 = n0 + 128;
#pragma unroll
                for (int e = 0; e < 4; ++e) { const float ql = bflo(qv[e]), qh = bfhi(qv[e]); s0 += ql * n0[2 * e] + qh * n0[2 * e + 1]; s1 += ql * n1[2 * e] + qh * n1[2 * e + 1]; } }
            LAS float* qp = (LAS float*)(L + SC_OFF + 8192);
            qp[(0 * 4 + part) * 128 + t] = s0; qp[(1 * 4 + part) * 128 + t] = s1; }
        f32x16 hsum[2];
#pragma unroll
        for (int c = 0; c < 2; ++c) hsum[c] = f32x16{};
        bf16x8 qf[8];
        { const LAS unsigned char* Qw = Qt + 8192 * tb;
#pragma unroll
          for (int kd = 0; kd < 8; ++kd) qf[kd] = ld_row(Qw, RB.r[kd & 1] + ROW_OFF(0, kd)); }
        __syncthreads();
#pragma unroll
        for (int e = 0; e < 4; ++e) *(LAS v4u*)(Qt + off_a(4 * e4 + e, dq)) = cbp[e];
#pragma unroll 1
        for (int dir = 0; dir < 2; ++dir) {
            const LAS unsigned char* Cs = dir ? Qt : Ct;
            const LAS float* w = sc + 512 + dir * 128; const LAS float* fl = sc + 768 + dir * 128; const float dec = sc[1920 + dir];
            int tlm = tl; asm volatile("" : "+v"(tlm));
            const int t = 32 * tb + tl;
            bf16x8 pf[8]; float dsum = 0.f;
#pragma unroll
            for (int sb = 0; sb < 4; ++sb) {
                const bool live = dir ? (sb >= tb) : (sb <= tb);
                f32x16 s = f32x16{};
                if (live) {
#pragma unroll
                    for (int kd = 0; kd < 8; ++kd) s = MFMA32(ld_row(Kt, RB.r[kd & 1] + ROW_OFF(sb, kd)), qf[kd], s);
#pragma unroll
                    for (int g4 = 0; g4 < 4; ++g4) { const f32x4 wv = *(const LAS f32x4*)(w + 32 * sb + 8 * g4 + 4 * hi);
#pragma unroll
                        for (int q = 0; q < 4; ++q) s[4 * g4 + q] *= wv[q]; }
                    if (sb == tb) {
#pragma unroll
                        for (int g4 = 0; g4 < 4; ++g4)
#pragma unroll
                            for (int q = 0; q < 4; ++q) { const int sl = 8 * g4 + 4 * hi + q; const bool ok = dir ? (sl >= tlm) : (sl <= tlm); s[4 * g4 + q] = ok ? s[4 * g4 + q] : 0.f; } }
#pragma unroll
                    for (int r = 0; r < 16; ++r) dsum += s[r];
                }
#pragma unroll
                for (int sp = 0; sp < 2; ++sp) { u32x4 pw; pw.x = cvtpk(s[8 * sp + 0], s[8 * sp + 1]); pw.y = cvtpk(s[8 * sp + 2], s[8 * sp + 3]); pw.z = cvtpk(s[8 * sp + 4], s[8 * sp + 5]); pw.w = cvtpk(s[8 * sp + 6], s[8 * sp + 7]);
                    pf[2 * sb + sp] = __builtin_bit_cast(bf16x8, pw); }
            }
            { auto rr = __builtin_amdgcn_permlane32_swap(__float_as_uint(dsum), __float_as_uint(dsum), false, false); dsum = __uint_as_float(rr[0]) + __uint_as_float(rr[1]); }
            if (eh == 0 && hi == 0) { const LAS float* qp = (const LAS float*)(L + SC_OFF + 8192) + dir * 512 + t;
                sc[1280 + dir * 128 + t] = dsum + dec * ((qp[0] + qp[128]) + (qp[256] + qp[384])); }
            f32x16 acc[2];
            const LAS unsigned char* Cw = Cs + 8192 * (2 * eh); const LAS unsigned char* Vw = Vt + 512 * (2 * eh);
#pragma unroll
            for (int c = 0; c < 2; ++c) { acc[c] = f32x16{};
#pragma unroll
                for (int kd = 0; kd < 8; ++kd) acc[c] = MFMA32(qf[kd], ld_row(Cw, RB.r[kd & 1] + ROW_OFF(c, kd)), acc[c]);
#pragma unroll
                for (int r = 0; r < 16; ++r) acc[c][r] *= dec; }
#pragma unroll
            for (int sb = 0; sb < 4; ++sb) {
                const bool live = dir ? (sb >= tb) : (sb <= tb);
                if (live) {
#pragma unroll
                    for (int sp = 0; sp < 2; ++sp)
#pragma unroll
                        for (int c = 0; c < 2; ++c) acc[c] = MFMA32(pf[2 * sb + sp], ld_tr2(Vw, RB.p[0] + TRP_OFF(c, 2 * sb + sp, 0), RB.p[1] + TRP_OFF(c, 2 * sb + sp, 1)), acc[c]);
                }
            }
            __syncthreads();
#pragma unroll
            for (int g4 = 0; g4 < 4; ++g4) { const f32x4 dv = *(const LAS f32x4*)(sc + 1280 + dir * 128 + 32 * tb + 8 * g4 + 4 * hi), fv = *(const LAS f32x4*)(fl + 32 * tb + 8 * g4 + 4 * hi);
#pragma unroll
                for (int q = 0; q < 4; ++q) { const float inv = __builtin_amdgcn_rcpf(fmaxf(fabsf(dv[q]), fv[q]));
                    hsum[0][4 * g4 + q] += acc[0][4 * g4 + q] * inv; hsum[1][4 * g4 + q] += acc[1][4 * g4 + q] * inv; } }
        }
        int lq = lane; asm volatile("" : "+v"(lq));
        const int hi2 = lq >> 5, tl2 = lq & 31;
        float ss[16];
#pragma unroll
        for (int r = 0; r < 16; ++r) { float v = hsum[0][r] * hsum[0][r] + hsum[1][r] * hsum[1][r];
#pragma unroll
            for (int o = 1; o < 32; o <<= 1) v += __shfl_xor(v, o);
            ss[r] = v; }
        if (tl2 == 0) {
#pragma unroll
            for (int r = 0; r < 16; ++r) sc[1664 + eh * 128 + 32 * tb + crow(r, hi2)] = ss[r]; }
        __syncthreads();
        bf16* mo = MIX + (size_t)(b * SEQ + 128 * j + 32 * tb + 4 * hi2) * DM + h * 128 + 64 * eh + tl2;
        const bf16* og = P + (size_t)(r0 + 32 * tb + 4 * hi2) * LDP + PC_MO + h * 128 + 64 * eh + tl2;
        const LAS float* sq = sc + 1664 + 32 * tb + 4 * hi2;
        const float g0 = in_gm[h * 128 + 64 * eh + tl2], g1 = in_gm[h * 128 + 64 * eh + 32 + tl2];
#pragma unroll
        for (int r = 0; r < 16; ++r) { const int row = (r & 3) + 8 * (r >> 2); const float rs = rsqrtf((sq[row] + sq[128 + row]) * (1.f / 128.f) + EPS);
            mo[(size_t)row * DM] = (bf16)f2bf(hsum[0][r] * rs * g0 * sigmoid_f(bf2f(og[(size_t)row * LDP])));
            mo[(size_t)row * DM + 32] = (bf16)f2bf(hsum[1][r] * rs * g1 * sigmoid_f(bf2f(og[(size_t)row * LDP + 32]))); }
    }
}
#undef MFMA32
}

#define GAS __attribute__((address_space(1)))
typedef GAS unsigned gu32;
#define RLX_AGENT __ATOMIC_RELAXED, __HIP_MEMORY_SCOPE_AGENT
#define XB_TMO      128
#define XB_XCNT(j)  (256  + 64 * (j))
#define XB_XSUB(j)  (1280 + 64 * (j))
#define XB_XGEN(j)  (2304 + 64 * (j))
#define XB_TOP      3328
#define XB_TOPGEN   3392
#define XCD_BAR_WORDS 3456
#define XB_SPIN_CAP (1u << 25)

__device__ __forceinline__ unsigned xb_ld(unsigned* p)              { return __hip_atomic_load(p, __ATOMIC_RELAXED, __HIP_MEMORY_SCOPE_AGENT); }
__device__ __forceinline__ unsigned xb_add(unsigned* p, unsigned v) { return __hip_atomic_fetch_add(p, v, __ATOMIC_RELAXED, __HIP_MEMORY_SCOPE_AGENT); }
__device__ __forceinline__ unsigned xb_xcc_id() { return (unsigned)__builtin_amdgcn_s_getreg((3 << 11) | 20) & 0xFu; }
#define XB_SPIN(cond, bar) do { unsigned _sp = 0; while (cond) { __builtin_amdgcn_s_sleep(1); \
    if ((++_sp & 255u) == 0u) { if (xb_ld(&(bar)[XB_TMO])) break; if (_sp > XB_SPIN_CAP) { atomicAdd(&(bar)[XB_TMO], 1u); break; } } } } while (0)

struct XcdBarrier {
    unsigned* bar; unsigned x;
    volatile LAS unsigned* st;
};

__device__ __forceinline__ XcdBarrier xcd_barrier_post(unsigned* bar, volatile LAS unsigned* st) {
    XcdBarrier b; b.bar = bar; b.x = xb_xcc_id(); b.st = st;
    if (threadIdx.x == 0) (void)xb_add(&bar[XB_XCNT(b.x)], 1u);
    return b;
}
__device__ __forceinline__ void xcd_barrier_complete(unsigned* bar, unsigned x, unsigned& nloc, unsigned& nx) {
    const unsigned G = gridDim.x * gridDim.y * gridDim.z;
    unsigned sum, cnt, mine, sp = 0u;
    for (;;) {
        sum = 0u; cnt = 0u; mine = 0u;
#pragma unroll
        for (unsigned j = 0; j < 16; ++j) { const unsigned c = xb_ld(&bar[XB_XCNT(j)]); sum += c; cnt += (c > 0u) ? 1u : 0u; mine = (j == x) ? c : mine; }
        if (sum == G) break;
        __builtin_amdgcn_s_sleep(1);
        if ((++sp & 255u) == 0u) { if (xb_ld(&bar[XB_TMO])) break; if (sp > XB_SPIN_CAP) { atomicAdd(&bar[XB_TMO], 1u); break; } }
    }
    nloc = mine > 0u ? mine : 1u; nx = cnt > 0u ? cnt : 1u;
}

__device__ __forceinline__ void xcd_barrier(const XcdBarrier& b) {
    asm volatile("s_waitcnt vmcnt(0)" ::: "memory");
    __syncthreads();
    if (threadIdx.x == 0) {
        unsigned* bar = b.bar;
        __builtin_amdgcn_s_waitcnt(0);
        unsigned nloc = b.st[0], nx = b.st[1];
        if (nloc == 0u) { xcd_barrier_complete(bar, b.x, nloc, nx); b.st[0] = nloc; b.st[1] = nx; }
        const unsigned old = xb_add(&bar[XB_XSUB(b.x)], 1u);
        const unsigned gen = old / nloc;
        if (old + 1u == (gen + 1u) * nloc) {
            __builtin_amdgcn_fence(__ATOMIC_RELEASE, "agent");
            asm volatile("s_waitcnt vmcnt(0)" ::: "memory");
            const unsigned og = xb_add(&bar[XB_TOP], 1u);
            const unsigned tg = og / nx;
            if (og + 1u == (tg + 1u) * nx) xb_add(&bar[XB_TOPGEN], 1u);
            else XB_SPIN(xb_ld(&bar[XB_TOPGEN]) == tg, bar);
            __builtin_amdgcn_fence(__ATOMIC_ACQUIRE, "agent");
            xb_add(&bar[XB_XGEN(b.x)], 1u);
            asm volatile("s_waitcnt vmcnt(0)" ::: "memory");
        } else {
            XB_SPIN(xb_ld(&bar[XB_XGEN(b.x)]) == gen, bar);
            __builtin_amdgcn_fence(__ATOMIC_ACQUIRE, "agent");
            asm volatile("s_waitcnt vmcnt(0)" ::: "memory");
        }
    }
    __syncthreads();
}


#ifndef MK_N_LAUNCHES
#define MK_N_LAUNCHES 1
#endif
constexpr int N_PHASES = 12;
struct Args { const float* in[25]; float* out; unsigned char* ws; int ph_lo, ph_hi; };
template <int PH_LO, int PH_HI>
__global__ void __launch_bounds__(NWAVES * 64, 2) fwd_kernel(Args args) {
    extern __shared__ __attribute__((aligned(16))) unsigned char lds[];
    Frame F;
    F.lds = lds; F.tid = threadIdx.x; F.lane = F.tid & 63; F.wave = __builtin_amdgcn_readfirstlane(F.tid >> 6);
    F.G = gridDim.x; { const int bx = blockIdx.x; F.vcu = (F.G % 8 == 0) ? (bx % 8) * (F.G / 8) + bx / 8 : bx; }
    F.out = args.out; F.ws = args.ws;
    constexpr int lo = PH_LO, hi = PH_HI;
    PG8_LAS unsigned char* ring = (PG8_LAS unsigned char*)lds;
    XcdBarrier bar; bar.bar = nullptr; bar.x = 0; bar.st = nullptr;
    if constexpr (hi - lo > 1) {
        for (int u = F.tid; u < (LDS_BYTES - LDSCTL_OFF) / 4; u += NWAVES * 64) ((LAS unsigned*)((LAS unsigned char*)lds + LDSCTL_OFF))[u] = 0u;
        __syncthreads();
        bar = xcd_barrier_post((unsigned*)(F.ws + WS_CTL) + CW_BAR, (volatile LAS unsigned*)((LAS unsigned char*)lds + MISC_OFF) + 8);
    }
#define IN(k) (lo <= (k) && (k) < hi)
#ifdef PROBE_PHASE
    volatile LAS unsigned long long* tsv = (volatile LAS unsigned long long*)((LAS unsigned char*)lds + 144512);
    if (blockIdx.x == 0 && threadIdx.x == 0) tsv[0] = __builtin_amdgcn_s_memrealtime();
#define SEAM(k) do { if constexpr (IN(k) && IN((k) + 1)) xcd_barrier(bar); if (blockIdx.x == 0 && threadIdx.x == 0) tsv[(k) + 1] = __builtin_amdgcn_s_memrealtime(); } while (0)
#else
#define SEAM(k) do { if constexpr (IN(k) && IN((k) + 1)) xcd_barrier(bar); } while (0)
#endif
    if constexpr (IN(0)) p0_prologue(F);
    SEAM(0);
#if defined(PROBE_REPEAT) && PROBE_REPEAT == 100
    for (int i = 0; i < 10; ++i) xcd_barrier(bar);
#endif
    if constexpr (IN(1)) p1_xn(F);
    SEAM(1);
    if constexpr (IN(2)) { pg8::Gemm g{(const pg8::bf16_t*)(F.ws + WS_XN), (const pg8::bf16_t*)(F.ws + WS_WIN), UROWS, NPAD, DM}; pg8::StaticOrder S; S.init(UROWS, NPAD, F.G, (int)blockIdx.x);
        pg8::EpiBf16 E{(pg8::bf16_t*)(F.ws + WS_P), LDP, (float*)(F.ws + WS_GATES), LDP / 256};
        pg8::gemm_phase<pg8::EpiBf16, pg8::StaticOrder, true, true>(ring, g, S, E); }
    SEAM(2);
    if constexpr (IN(3)) { p3_rope(F); ml::stage1(F);
#if defined(PROBE_REPEAT) && PROBE_REPEAT == 3
        xcd_barrier(bar); ml::stage1(F);
#endif
    }
    SEAM(3);
    if constexpr (IN(4)) ml::stage2(F);
    SEAM(4);
    if constexpr (IN(5)) { ml::stage3(F); p5_attn(F);
#if defined(PROBE_REPEAT) && PROBE_REPEAT == 5
        xcd_barrier(bar); p5_attn(F);
#endif
#if defined(PROBE_REPEAT) && PROBE_REPEAT == 53
        xcd_barrier(bar); ml::stage3(F);
#endif
    }
    SEAM(5);
    if constexpr (IN(6)) { pg8::Gemm g{(const pg8::bf16_t*)(F.ws + WS_MIX), (const pg8::bf16_t*)(F.ws + WS_WOUT), LROWS, DM, DM}; pg8::StaticOrder S; S.init(LROWS, DM, F.G, (int)blockIdx.x);
        pg8::EpiBf16 E{(pg8::bf16_t*)(F.ws + WS_Y), DM, nullptr, -1};
        pg8::gemm_phase<pg8::EpiBf16, pg8::StaticOrder, true, true>(ring, g, S, E);
    }
    SEAM(6);
    if constexpr (IN(7)) p7_x1(F);
    SEAM(7);
    if constexpr (IN(8)) { pg8::Gemm g{(const pg8::bf16_t*)(F.ws + WS_XN), (const pg8::bf16_t*)(F.ws + WS_WUP), LROWS, NUP, DM}; pg8::StaticOrder S; S.init(LROWS, NUP, F.G, (int)blockIdx.x);
        pg8::EpiFfn E{(pg8::bf16_t*)(F.ws + WS_HMID), DFF, inptr(I_CONVFFNW), inptr(I_CONVFFNB), NUP, DFF, (float*)(F.ws + WS_EDGE), (PG8_LAS float*)((PG8_LAS unsigned char*)lds + ml::SC_OFF)};
        pg8::gemm_phase<pg8::EpiFfn, pg8::StaticOrder, true, true>(ring, g, S, E); }
    SEAM(8);
    if constexpr (IN(9)) ffn_edge_fix(F);
    SEAM(9);
    if constexpr (IN(10)) { pg8::Gemm g{(const pg8::bf16_t*)(F.ws + WS_HMID), (const pg8::bf16_t*)(F.ws + WS_WDN), LROWS, DM, DFF}; pg8::StaticOrder S; S.init(LROWS, DM, F.G, (int)blockIdx.x);
        pg8::EpiBf16 E{(pg8::bf16_t*)(F.ws + WS_Y2), DM, nullptr, -1};
        pg8::gemm_phase<pg8::EpiBf16, pg8::StaticOrder, true, true>(ring, g, S, E); }
    SEAM(10);
    if constexpr (IN(11)) p13_final(F);
#ifdef PROBE_PHASE
    if (blockIdx.x == 0 && threadIdx.x == 0) { tsv[N_PHASES] = __builtin_amdgcn_s_memrealtime(); asm volatile("s_waitcnt vmcnt(0)" ::: "memory");
        F.out[0] += (float)(tsv[PROBE_PHASE_END + 1] - tsv[PROBE_PHASE]) * 0.01f; }
#endif
#undef IN
#undef SEAM
}

extern "C" void kernel_launch(void* const* d_in, const int* in_sizes, int n_in, void* d_out, int out_size, void* d_ws, size_t ws_size, hipStream_t stream) {
    static int grid = 0;
    if (grid == 0) {
        if (n_in != 25 || in_sizes[0] != LROWS * DM || out_size != LROWS * DM || ws_size < WS_END) { fprintf(stderr, "kernel_launch: unexpected shapes / workspace (n_in %d, ws %zu, need %zu)\n", n_in, ws_size, (size_t)WS_END); grid = -1; return; }
        bool ok = true;
#define SETATTR(a, b) ok = ok && (hipFuncSetAttribute((const void*)fwd_kernel<a, b>, hipFuncAttributeMaxDynamicSharedMemorySize, LDS_BYTES) == hipSuccess)
#if MK_N_LAUNCHES == 1
        SETATTR(0, N_PHASES);
#else
        SETATTR(0, 1); SETATTR(1, 2); SETATTR(2, 3); SETATTR(3, 4); SETATTR(4, 5); SETATTR(5, 6); SETATTR(6, 7); SETATTR(7, 8); SETATTR(8, 9); SETATTR(9, 10); SETATTR(10, 11); SETATTR(11, 12);
#endif
#undef SETATTR
        if (!ok) { fprintf(stderr, "kernel_launch: hipFuncSetAttribute failed\n"); grid = -1; return; }
        int dev = 0, cus = 0, per_cu = 0; (void)hipGetDevice(&dev); (void)hipDeviceGetAttribute(&cus, hipDeviceAttributeMultiprocessorCount, dev);
#if MK_N_LAUNCHES == 1
        if (hipOccupancyMaxActiveBlocksPerMultiprocessor(&per_cu, (const void*)fwd_kernel<0, N_PHASES>, NWAVES * 64, LDS_BYTES) != hipSuccess || per_cu < 1) { fprintf(stderr, "kernel_launch: occupancy query says %d blocks per CU\n", per_cu); (void)hipGetLastError(); }
#endif
        grid = cus > 0 ? cus : 256;
    }
    if (grid < 0) return;
    (void)hipMemsetAsync((char*)d_ws + WS_CTL, 0, CTL_ZERO_BYTES, stream);
    Args a{};
    for (int i = 0; i < 25; ++i) a.in[i] = (const float*)d_in[i];
    a.out = (float*)d_out; a.ws = (unsigned char*)d_ws;
#if MK_N_LAUNCHES == 1
    hipLaunchKernelGGL((fwd_kernel<0, N_PHASES>), dim3(grid), dim3(NWAVES * 64), LDS_BYTES, stream, a);
#else
#define LAUNCH(p) hipLaunchKernelGGL((fwd_kernel<p, p + 1>), dim3(grid), dim3(NWAVES * 64), LDS_BYTES, stream, a)
    LAUNCH(0); LAUNCH(1); LAUNCH(2); LAUNCH(3); LAUNCH(4); LAUNCH(5); LAUNCH(6); LAUNCH(7); LAUNCH(8); LAUNCH(9); LAUNCH(10); LAUNCH(11);
#undef LAUNCH
#endif
}
```
